# Optimizing an MI355X kernel written in HIP

```python
import math
import jax, jax.numpy as jnp
from jax import lax
import numpy as np

D_MODEL = 1024
BATCH = 4
SEQ = 4096
DEPTH = 2

CONV_WIDTH = 3
A_WIDTH = D_MODEL // 2
A_HEADS = 8
B_WIDTH = D_MODEL // 2
POOL_WINDOWS = (2, 4, 8, 16)
N_POOL_GROUPS = len(POOL_WINDOWS)
POOL_GROUP = B_WIDTH // N_POOL_GROUPS
EVEN_IN = 3 * A_WIDTH + B_WIDTH
HEAD_DIM = 64
N_HEADS = D_MODEL // HEAD_DIM
DILATED_PAIRS = ((128, 1), (512, 4), (2048, 16))
N_REL_BUCKETS = 32
REL_MAX_DISTANCE = 2048
D_FF = 2816
EPS = 1e-6
MASK_VALUE = -1e30
N_EVEN = (DEPTH + 1) // 2
N_ODD = DEPTH // 2

kernel_name = "hybrid_conv_pool_dilated_attn_trunk"


def rmsnorm(x, g):
    x32 = x.astype(jnp.float32)
    y = x32 * lax.rsqrt(jnp.mean(x32 * x32, axis=-1, keepdims=True) + EPS)
    return (y * g.astype(jnp.float32)).astype(x.dtype)


def causal_dwconv3(x, w):
    S = x.shape[1]
    xp = jnp.pad(x, ((0, 0), (CONV_WIDTH - 1, 0), (0, 0)))
    y = xp[:, 0:S] * w[0]
    for i in range(1, CONV_WIDTH):
        y = y + xp[:, i:i + S] * w[i]
    return y


def causal_window_mean(p, k):
    S = p.shape[1]
    cs = jnp.cumsum(p, axis=1)
    cs_prev = jnp.pad(cs, ((0, 0), (k, 0), (0, 0)))[:, :S]
    cnt = jnp.minimum(jnp.arange(1, S + 1), k).astype(jnp.float32)[None, :, None]
    return (cs - cs_prev) / cnt


def t5_causal_bucket(dist):
    max_exact = N_REL_BUCKETS // 2
    d = jnp.maximum(dist, 1).astype(jnp.float32)
    large = max_exact + (jnp.log(d / max_exact) / math.log(REL_MAX_DISTANCE / max_exact)
                         * (N_REL_BUCKETS - max_exact)).astype(jnp.int32)
    large = jnp.minimum(large, N_REL_BUCKETS - 1)
    return jnp.where(dist < max_exact, dist, large)


def conv_pool_mixer(xn, w_in, conv_w, pool_w, pool_scale, w_out):
    B, S, _ = xn.shape
    proj = xn @ w_in
    h, gate_b, gate_c, pin = jnp.split(proj, [A_WIDTH, 2 * A_WIDTH, 3 * A_WIDTH], axis=-1)
    ya = gate_b * causal_dwconv3(gate_c * h, conv_w)
    p32 = pin.astype(jnp.float32).reshape(B, S, N_POOL_GROUPS, POOL_GROUP)
    pooled = jnp.stack([causal_window_mean(p32[:, :, g], k)
                        for g, k in enumerate(POOL_WINDOWS)], axis=2) - p32
    yb = jnp.einsum('bsgc,gcd->bsgd', pooled, pool_w.astype(jnp.float32))
    yb = (yb.reshape(B, S, B_WIDTH) * pool_scale.astype(jnp.float32)).astype(xn.dtype)
    return jnp.concatenate([ya, yb], axis=-1) @ w_out


def dilated_branch(q, k, v, rel_table, window, dil):
    B, S, H, E = q.shape
    n = window // dil
    QB = n
    L = S // dil
    nb = -(-L // QB)
    Lp = nb * QB

    def residues(t):
        return jnp.swapaxes(t.reshape(B, L, dil, H, E), 1, 2)

    qr = jnp.pad(residues(q), ((0, 0), (0, 0), (0, Lp - L), (0, 0), (0, 0)))
    kp = jnp.pad(residues(k), ((0, 0), (0, 0), (n, Lp - L), (0, 0), (0, 0)))
    vp = jnp.pad(residues(v), ((0, 0), (0, 0), (n, Lp - L), (0, 0), (0, 0)))

    def key_blocks(t):
        prev = t[:, :, :Lp].reshape(B, dil, nb, QB, H, E)
        cur = t[:, :, n:].reshape(B, dil, nb, QB, H, E)
        return jnp.concatenate([prev, cur], axis=3)

    qb = qr.reshape(B, dil, nb, QB, H, E)
    kb = key_blocks(kp)
    vb = key_blocks(vp)

    a = jnp.arange(QB)[:, None]
    c = jnp.arange(2 * QB)[None, :]
    rel = a + n - c
    key_pos = jnp.arange(nb)[:, None] * QB - n + jnp.arange(2 * QB)[None, :]
    valid = ((rel >= 0) & (rel <= n))[None] & (key_pos >= 0)[:, None, :]
    bias = rel_table.astype(jnp.float32)[t5_causal_bucket(jnp.clip(rel, 0, n) * dil)]
    bias = jnp.transpose(bias, (2, 0, 1))

    s = jnp.einsum('bdnqhe,bdnkhe->bdnhqk', qb, kb) * (HEAD_DIM ** -0.5) + bias
    s = jnp.where(valid[None, None, :, None], s, MASK_VALUE)
    m = jnp.max(s, axis=-1)
    p = jnp.exp(s - m[..., None])
    den = jnp.sum(p, axis=-1)
    m = jnp.swapaxes(m, 3, 4)
    den = jnp.swapaxes(den, 3, 4)
    o = jnp.einsum('bdnhqk,bdnkhe->bdnqhe', p, vb) / den[..., None]

    def from_blocks(t):
        rest = t.shape[5:]
        t = t.reshape((B, dil, Lp, H) + rest)[:, :, :L]
        return jnp.swapaxes(t, 1, 2).reshape((B, S, H) + rest)

    return from_blocks(o), from_blocks(m), from_blocks(den)


def dilated_attention(xn, w_qkv, g_q, g_k, w_o, rel_table):
    B, S, D = xn.shape
    qkv = (xn @ w_qkv).reshape(B, S, 3, N_HEADS, HEAD_DIM).astype(jnp.float32)
    q = rmsnorm(qkv[:, :, 0], g_q)
    k = rmsnorm(qkv[:, :, 1], g_k)
    v = qkv[:, :, 2]
    outs, maxes, dens = [], [], []
    for window, dil in DILATED_PAIRS:
        o, m, den = dilated_branch(q, k, v, rel_table, window, dil)
        outs.append(o)
        maxes.append(m)
        dens.append(den)
    outs = jnp.stack(outs)
    maxes = jnp.stack(maxes)
    dens = jnp.stack(dens)
    wts = dens * jnp.exp(maxes - jnp.max(maxes, axis=0, keepdims=True))
    o = jnp.sum(wts[..., None] * outs, axis=0) / jnp.sum(wts, axis=0)[..., None]
    return o.reshape(B, S, D).astype(xn.dtype) @ w_o


def conv_glu_ffn(xn, w_up, conv_w, conv_b, w_down):
    u = causal_dwconv3(xn @ w_up, conv_w) + conv_b
    gate, up = jnp.split(u, 2, axis=-1)
    return (jax.nn.silu(gate) * up) @ w_down


def setup_inputs(seed: int = 0) -> dict:
    key = jax.random.key(seed)
    ks = jax.random.split(key, 20)
    f32 = jnp.float32

    def nrm(k, shape, scale):
        return jax.random.normal(k, shape, f32) * scale

    return {
        "x": nrm(ks[0], (BATCH, SEQ, D_MODEL), 1.0),
        "rel_bias": nrm(ks[1], (N_REL_BUCKETS, N_HEADS), 0.5),
        "even_norm": 1.0 + nrm(ks[2], (N_EVEN, D_MODEL), 0.02),
        "even_w_in": nrm(ks[3], (N_EVEN, D_MODEL, EVEN_IN), D_MODEL ** -0.5),
        "even_conv_w": nrm(ks[4], (N_EVEN, CONV_WIDTH, A_WIDTH), CONV_WIDTH ** -0.5),
        "even_pool_w": nrm(ks[5], (N_EVEN, N_POOL_GROUPS, POOL_GROUP, POOL_GROUP), POOL_GROUP ** -0.5),
        "even_pool_scale": 1.0 + nrm(ks[6], (N_EVEN, B_WIDTH), 0.02),
        "even_w_out": nrm(ks[7], (N_EVEN, D_MODEL, D_MODEL), D_MODEL ** -0.5),
        "odd_norm": 1.0 + nrm(ks[8], (N_ODD, D_MODEL), 0.02),
        "odd_w_qkv": nrm(ks[9], (N_ODD, D_MODEL, 3 * D_MODEL), D_MODEL ** -0.5),
        "odd_q_norm": 1.0 + nrm(ks[10], (N_ODD, HEAD_DIM), 0.02),
        "odd_k_norm": 1.0 + nrm(ks[11], (N_ODD, HEAD_DIM), 0.02),
        "odd_w_o": nrm(ks[12], (N_ODD, D_MODEL, D_MODEL), D_MODEL ** -0.5),
        "ffn_norm": 1.0 + nrm(ks[13], (DEPTH, D_MODEL), 0.02),
        "ffn_w_up": nrm(ks[14], (DEPTH, D_MODEL, 2 * D_FF), D_MODEL ** -0.5),
        "ffn_conv_w": nrm(ks[15], (DEPTH, CONV_WIDTH, 2 * D_FF), CONV_WIDTH ** -0.5),
        "ffn_conv_b": nrm(ks[16], (DEPTH, 2 * D_FF), 0.02),
        "ffn_w_down": nrm(ks[17], (DEPTH, D_FF, D_MODEL), D_FF ** -0.5),
    }


def reference(x, rel_bias, even_norm, even_w_in, even_conv_w, even_pool_w, even_pool_scale,
              even_w_out, odd_norm, odd_w_qkv, odd_q_norm, odd_k_norm, odd_w_o,
              ffn_norm, ffn_w_up, ffn_conv_w, ffn_conv_b, ffn_w_down):
    for layer in range(DEPTH):
        i = layer // 2
        if layer % 2 == 0:
            x = x + conv_pool_mixer(rmsnorm(x, even_norm[i]), even_w_in[i], even_conv_w[i],
                                    even_pool_w[i], even_pool_scale[i], even_w_out[i])
        else:
            x = x + dilated_attention(rmsnorm(x, odd_norm[i]), odd_w_qkv[i], odd_q_norm[i],
                                      odd_k_norm[i], odd_w_o[i], rel_bias)
        x = x + conv_glu_ffn(rmsnorm(x, ffn_norm[layer]), ffn_w_up[layer], ffn_conv_w[layer],
                             ffn_conv_b[layer], ffn_w_down[layer])
    return x
```

```cpp
#include <hip/hip_runtime.h>
#include <cstdio>
#include <cstdint>

typedef unsigned short bf16_t;
constexpr int BATCH = 4, SEQ = 4096, D = 1024, T = BATCH * SEQ;
constexpr int EVEN_IN = 2048, AW = 512, DFF = 2816, DFF2 = 5632, NH = 16, HD = 64, NQKV = 3072;
constexpr float EPS = 1e-6f;
constexpr float LOG2E = 1.4426950408889634f;

__device__ __forceinline__ float bf2f(bf16_t v) { return __uint_as_float((unsigned)v << 16); }
__device__ __forceinline__ bf16_t f2bf(float f) { unsigned u = __float_as_uint(f); return (bf16_t)((u + 0x7fffu + ((u >> 16) & 1u)) >> 16); }
__device__ __forceinline__ float wave_sum(float v) {
#pragma unroll
    for (int o = 1; o < 64; o <<= 1) v += __shfl_xor(v, o);
    return v;
}

constexpr size_t MiB = 1u << 20;
constexpr size_t WS_CTL = 0;
constexpr size_t WS_SSQ = 64 * 1024;
constexpr size_t WS_BIAS = 512 * 1024;
constexpr size_t WS_XB = 50 * MiB;
constexpr size_t WS_R = 84 * MiB;
constexpr size_t WS_PROJ = WS_R;
constexpr size_t WS_MIX = WS_R + 96 * MiB;
constexpr size_t WS_QKV = WS_R;
constexpr size_t WS_AO = WS_R + 96 * MiB;
constexpr size_t WS_ACT = WS_R;
constexpr size_t WS_END = WS_R + 128 * MiB;

__global__ void __launch_bounds__(256) n_prologue(const float* __restrict__ x, float* ssq, bf16_t* xb) {
    const int wave = (blockIdx.x * 256 + threadIdx.x) >> 6, lane = threadIdx.x & 63;
    if (wave >= T) return;
    const float* xr = x + (size_t)wave * D; float s = 0.f;
    for (int j = lane; j < D; j += 64) { float v = xr[j]; s += v * v; xb[(size_t)wave * D + j] = f2bf(v); }
    s = wave_sum(s);
    if (lane == 0) ssq[wave] = s;
}
__global__ void n_bias(const float* __restrict__ rel, float* bias) {
    const int i = blockIdx.x * blockDim.x + threadIdx.x;
    if (i >= 3 * 129 * 16) return;
    const int h = i % 16, j = (i / 16) % 129, br = i / (16 * 129);
    const int dil = br == 0 ? 1 : (br == 1 ? 4 : 16);
    const int dist = j * dil; int b;
    if (dist < 16) b = dist; else { int l = 16 + (int)(log((double)dist / 16.0) / log(128.0) * 16.0); b = l < 31 ? l : 31; }
    bias[i] = rel[b * 16 + h] * LOG2E;
}

template <int NR>
__device__ __forceinline__ void naive_tile(const bf16_t* __restrict__ A, int K, const int* rows, const float* __restrict__ g,
                                           const float* __restrict__ W, int N, int col, float* acc, float* sA  ) {
    for (int r = 0; r < NR; ++r) acc[r] = 0.f;
    for (int k0 = 0; k0 < K; k0 += 1024) {
        const int kc = (K - k0) < 1024 ? (K - k0) : 1024;
        __syncthreads();
        for (int i = threadIdx.x; i < NR * kc; i += 256) { const int r = i / kc, k = i % kc; const int row = rows[r];
            float v = row >= 0 ? bf2f(A[(size_t)row * K + k0 + k]) : 0.f; if (g) v *= g[k0 + k]; sA[r * 1024 + k] = v; }
        __syncthreads();
        for (int k = 0; k < kc; k += 4) {
            const float w0 = W[(size_t)(k0 + k) * N + col], w1 = W[(size_t)(k0 + k + 1) * N + col], w2 = W[(size_t)(k0 + k + 2) * N + col], w3 = W[(size_t)(k0 + k + 3) * N + col];
#pragma unroll
            for (int r = 0; r < NR; ++r) { const float4 a = *(const float4*)(sA + r * 1024 + k); acc[r] += a.x * w0 + a.y * w1 + a.z * w2 + a.w * w3; }
        }
    }
}

__global__ void __launch_bounds__(256) n_gemm_rowscale(const bf16_t* __restrict__ A, const float* __restrict__ g, const float* __restrict__ W, int N, int K,
                                                        const float* __restrict__ ssq, bf16_t* out) {
    extern __shared__ float sA[];
    __shared__ int rows[16];
    const int row0 = blockIdx.y * 16, col = blockIdx.x * 256 + threadIdx.x;
    if (threadIdx.x < 16) rows[threadIdx.x] = row0 + threadIdx.x;
    __syncthreads();
    float acc[16];
    naive_tile<16>(A, K, rows, g, W, N, col, acc, sA);
    for (int r = 0; r < 16; ++r) { const float rs = rsqrtf(ssq[row0 + r] * (1.f / D) + EPS); out[(size_t)(row0 + r) * N + col] = f2bf(acc[r] * rs); }
}
__global__ void __launch_bounds__(256) n_gemm_residual(const bf16_t* __restrict__ A, const float* __restrict__ W, int K,
                                                        const float* base, float* out, bf16_t* xb, float* ssq_next) {
    extern __shared__ float sA[];
    __shared__ int rows[16];
    const int row0 = blockIdx.y * 16, col = blockIdx.x * 256 + threadIdx.x;
    if (threadIdx.x < 16) rows[threadIdx.x] = row0 + threadIdx.x;
    __syncthreads();
    float acc[16];
    naive_tile<16>(A, K, rows, nullptr, W, D, col, acc, sA);
    for (int r = 0; r < 16; ++r) { const size_t o = (size_t)(row0 + r) * D + col; const float v = base[o] + acc[r]; out[o] = v;
        if (xb) xb[o] = f2bf(v);
        if (ssq_next) { const float s = wave_sum(v * v); if ((threadIdx.x & 63) == 0) atomicAdd(ssq_next + row0 + r, s); } }
}
__global__ void __launch_bounds__(256) n_ffn_up(const bf16_t* __restrict__ A, const float* __restrict__ g, const float* __restrict__ W,
                                                 const float* __restrict__ ssq, const float* __restrict__ cw, const float* __restrict__ cb, bf16_t* act) {
    extern __shared__ float sA[];
    __shared__ int rows[18];
    const int row0 = blockIdx.y * 16, c = blockIdx.x * 256 + threadIdx.x;
    if (threadIdx.x < 18) { const int r = row0 - 2 + threadIdx.x; rows[threadIdx.x] = ((row0 % SEQ) == 0 && threadIdx.x < 2) ? -1 : r; }
    __syncthreads();
    float ag[18], au[18];
    naive_tile<18>(A, D, rows, g, W, DFF2, c, ag, sA);
    naive_tile<18>(A, D, rows, g, W, DFF2, c + DFF, au, sA);
    for (int r = 0; r < 18; ++r) { const float rs = rows[r] >= 0 ? rsqrtf(ssq[rows[r]] * (1.f / D) + EPS) : 0.f; ag[r] *= rs; au[r] *= rs; }
    const float g0 = cw[c], g1 = cw[DFF2 + c], g2 = cw[2 * DFF2 + c], gb = cb[c];
    const float u0 = cw[c + DFF], u1 = cw[DFF2 + c + DFF], u2 = cw[2 * DFF2 + c + DFF], ub = cb[c + DFF];
    for (int r = 0; r < 16; ++r) {
        const float gt = g0 * ag[r] + g1 * ag[r + 1] + g2 * ag[r + 2] + gb;
        const float ut = u0 * au[r] + u1 * au[r + 1] + u2 * au[r + 2] + ub;
        const float s = gt / (1.f + __expf(-gt));
        act[(size_t)(row0 + r) * DFF + c] = f2bf(s * ut);
    }
}
__global__ void __launch_bounds__(256) n_qkv(const bf16_t* __restrict__ A, const float* __restrict__ g, const float* __restrict__ W,
                                              const float* __restrict__ ssq, const float* __restrict__ gq, const float* __restrict__ gk, bf16_t* qkv) {
    extern __shared__ float sA[];
    __shared__ int rows[16];
    const int row0 = blockIdx.y * 16, col = blockIdx.x * 256 + threadIdx.x;
    if (threadIdx.x < 16) rows[threadIdx.x] = row0 + threadIdx.x;
    __syncthreads();
    float acc[16];
    naive_tile<16>(A, D, rows, g, W, NQKV, col, acc, sA);
    const int part = col / D;
    for (int r = 0; r < 16; ++r) {
        const float rs = rsqrtf(ssq[row0 + r] * (1.f / D) + EPS); float y = acc[r] * rs;
        if (part < 2) { const float ms = wave_sum(y * y) * (1.f / HD); y = y * rsqrtf(ms + EPS) * (part == 0 ? gq[col & 63] * (0.125f * LOG2E) : gk[col & 63]); }
        qkv[(size_t)(row0 + r) * NQKV + col] = f2bf(y);
    }
}
__global__ void __launch_bounds__(512) n_mixer(const bf16_t* __restrict__ proj, const float* __restrict__ cw, const float* __restrict__ pw,
                                                const float* __restrict__ ps, bf16_t* mix) {
    __shared__ float pooled[16][512];
    const int t0 = blockIdx.x * 16, c = threadIdx.x;
    for (int r = 0; r < 16; ++r) {
        const int t = t0 + r, tl = t % SEQ;
        float conv = 0.f;
        for (int i = 0; i < 3; ++i) { const int tt = tl - 2 + i; if (tt >= 0) { const size_t o = (size_t)(t - 2 + i) * EVEN_IN; conv += cw[i * AW + c] * (bf2f(proj[o + 2 * AW + c]) * bf2f(proj[o + c])); } }
        const float ya = bf2f(proj[(size_t)t * EVEN_IN + AW + c]) * conv;
        mix[(size_t)t * D + c] = f2bf(ya);
        const int gI = c >> 7, k = 2 << gI; const int cnt = (tl + 1) < k ? (tl + 1) : k; float s = 0.f;
        for (int j = 0; j < cnt; ++j) s += bf2f(proj[(size_t)(t - j) * EVEN_IN + 3 * AW + c]);
        pooled[r][c] = s / (float)cnt - bf2f(proj[(size_t)t * EVEN_IN + 3 * AW + c]);
    }
    __syncthreads();
    const int gI = c >> 7, d = c & 127;
    float acc[16];
    for (int r = 0; r < 16; ++r) acc[r] = 0.f;
    for (int cc = 0; cc < 128; ++cc) { const float w = pw[(size_t)(gI * 128 + cc) * 128 + d];
        for (int r = 0; r < 16; ++r) acc[r] += pooled[r][gI * 128 + cc] * w; }
    for (int r = 0; r < 16; ++r) mix[(size_t)(t0 + r) * D + AW + c] = f2bf(acc[r] * ps[c]);
}
__global__ void __launch_bounds__(256) n_attn(const bf16_t* __restrict__ qkv, const float* __restrict__ bias, bf16_t* ao) {
    __shared__ float sp[4][3 * 129 + 5];
    __shared__ float sq[4][64];
    const int w = threadIdx.x >> 6, lane = threadIdx.x & 63;
    const int item = blockIdx.x * 4 + w; const int t = item / NH, h = item % NH; const int tl = t % SEQ;
    sq[w][lane] = bf2f(qkv[(size_t)t * NQKV + h * HD + lane]);
    __syncthreads();
    float mx = -1e30f;
    for (int i = lane; i < 3 * 129; i += 64) {
        const int br = i / 129, j = i % 129, dil = br == 0 ? 1 : (br == 1 ? 4 : 16); const int tk = tl - j * dil;
        float s = -1e30f;
        if (tk >= 0) { const bf16_t* kr = qkv + (size_t)(t - j * dil) * NQKV + D + h * HD; float a = 0.f;
            for (int e = 0; e < 64; ++e) a += sq[w][e] * bf2f(kr[e]);
            s = a + bias[(br * 129 + j) * 16 + h]; }
        sp[w][i] = s; mx = fmaxf(mx, s);
    }
#pragma unroll
    for (int o = 1; o < 64; o <<= 1) mx = fmaxf(mx, __shfl_xor(mx, o));
    __syncthreads();
    float l = 0.f, o = 0.f;
    for (int i = 0; i < 3 * 129; ++i) {
        const float s = sp[w][i]; if (s < -1e29f) continue;
        const int br = i / 129, j = i % 129, dil = br == 0 ? 1 : (br == 1 ? 4 : 16);
        const float p = exp2f(s - mx); l += p;
        o += p * bf2f(qkv[(size_t)(t - j * dil) * NQKV + 2 * D + h * HD + lane]);
    }
    ao[(size_t)t * D + h * HD + lane] = f2bf(o / l);
}

extern "C" void kernel_launch(void* const* d_in, const int* in_sizes, int n_in, void* d_out, int out_size, void* d_ws, size_t ws_size, hipStream_t stream) {
    static int inited = 0;
    if (!inited) {
        if (n_in != 18 || out_size != T * D || ws_size < WS_END) { fprintf(stderr, "kernel_launch: unexpected shapes n_in %d out %d ws %zu\n", n_in, out_size, ws_size); inited = -1; return; }
        hipFuncSetAttribute((const void*)n_gemm_rowscale, hipFuncAttributeMaxDynamicSharedMemorySize, 18 * 4096);
        hipFuncSetAttribute((const void*)n_gemm_residual, hipFuncAttributeMaxDynamicSharedMemorySize, 18 * 4096);
        hipFuncSetAttribute((const void*)n_ffn_up, hipFuncAttributeMaxDynamicSharedMemorySize, 18 * 4096);
        hipFuncSetAttribute((const void*)n_qkv, hipFuncAttributeMaxDynamicSharedMemorySize, 18 * 4096);
        inited = 1;
    }
    if (inited < 0) return;
    const float* x = (const float*)d_in[0]; const float* rel = (const float*)d_in[1];
    const float* even_norm = (const float*)d_in[2]; const float* w_in = (const float*)d_in[3]; const float* even_cw = (const float*)d_in[4];
    const float* pool_w = (const float*)d_in[5]; const float* pool_s = (const float*)d_in[6]; const float* w_out = (const float*)d_in[7];
    const float* odd_norm = (const float*)d_in[8]; const float* w_qkv = (const float*)d_in[9]; const float* gq = (const float*)d_in[10]; const float* gk = (const float*)d_in[11];
    const float* w_o = (const float*)d_in[12]; const float* ffn_norm = (const float*)d_in[13]; const float* w_up = (const float*)d_in[14];
    const float* ffn_cw = (const float*)d_in[15]; const float* ffn_cb = (const float*)d_in[16]; const float* w_dn = (const float*)d_in[17];
    unsigned char* ws = (unsigned char*)d_ws; float* out = (float*)d_out;
    float* ssq = (float*)(ws + WS_SSQ); float* bias = (float*)(ws + WS_BIAS);
    bf16_t* xb = (bf16_t*)(ws + WS_XB); bf16_t* proj = (bf16_t*)(ws + WS_PROJ); bf16_t* mix = (bf16_t*)(ws + WS_MIX);
    bf16_t* qkv = (bf16_t*)(ws + WS_QKV); bf16_t* ao = (bf16_t*)(ws + WS_AO); bf16_t* act = (bf16_t*)(ws + WS_ACT);
    const size_t LDSB = 18 * 4096;
    hipMemsetAsync(ws + WS_CTL, 0, 1 * MiB, stream);
    n_prologue<<<T / 4, 256, 0, stream>>>(x, ssq, xb);
    n_bias<<<(3 * 129 * 16 + 255) / 256, 256, 0, stream>>>(rel, bias);
    n_gemm_rowscale<<<dim3(EVEN_IN / 256, T / 16), 256, LDSB, stream>>>(xb, even_norm, w_in, EVEN_IN, D, ssq, proj);
    n_mixer<<<T / 16, 512, 0, stream>>>(proj, even_cw, pool_w, pool_s, mix);
    n_gemm_residual<<<dim3(D / 256, T / 16), 256, LDSB, stream>>>(mix, w_out, D, x, out, xb, ssq + T);
    n_ffn_up<<<dim3(DFF / 256, T / 16), 256, LDSB, stream>>>(xb, ffn_norm, w_up, ssq + T, ffn_cw, ffn_cb, act);
    n_gemm_residual<<<dim3(D / 256, T / 16), 256, LDSB, stream>>>(act, w_dn, DFF, out, out, xb, ssq + 2 * T);
    n_qkv<<<dim3(NQKV / 256, T / 16), 256, LDSB, stream>>>(xb, odd_norm, w_qkv, ssq + 2 * T, gq, gk, qkv);
    n_attn<<<T * NH / 4, 256, 0, stream>>>(qkv, bias, ao);
    n_gemm_residual<<<dim3(D / 256, T / 16), 256, LDSB, stream>>>(ao, w_o, D, out, out, xb, ssq + 3 * T);
    n_ffn_up<<<dim3(DFF / 256, T / 16), 256, LDSB, stream>>>(xb, ffn_norm + D, w_up + (size_t)D * DFF2, ssq + 3 * T, ffn_cw + 3 * DFF2, ffn_cb + DFF2, act);
    n_gemm_residual<<<dim3(D / 256, T / 16), 256, LDSB, stream>>>(act, w_dn + (size_t)DFF * D, DFF, out, out, nullptr, nullptr);
}
```

```cpp
#include <hip/hip_runtime.h>
#include <cstdio>
#include <cstdint>

typedef unsigned short bf16_t;
constexpr int BATCH = 4, SEQ = 4096, D = 1024, T = BATCH * SEQ;
constexpr int EVEN_IN = 2048, AW = 512, DFF = 2816, DFF2 = 5632, NH = 16, HD = 64, NQKV = 3072;
constexpr float EPS = 1e-6f;
constexpr float LOG2E = 1.4426950408889634f;

__device__ __forceinline__ float bf2f(bf16_t v) { return __uint_as_float((unsigned)v << 16); }
__device__ __forceinline__ bf16_t f2bf(float f) { unsigned u = __float_as_uint(f); return (bf16_t)((u + 0x7fffu + ((u >> 16) & 1u)) >> 16); }
__device__ __forceinline__ float wave_sum(float v) {
#pragma unroll
    for (int o = 1; o < 64; o <<= 1) v += __shfl_xor(v, o);
    return v;
}

constexpr size_t MiB = 1u << 20;
constexpr size_t WS_CTL = 0;
constexpr size_t WS_SSQ = 64 * 1024;
constexpr size_t WS_BIAS = 512 * 1024;
constexpr size_t WS_XB = 50 * MiB;
constexpr size_t WS_R = 84 * MiB;
constexpr size_t WS_PROJ = WS_R;
constexpr size_t WS_MIX = WS_R + 96 * MiB;
constexpr size_t WS_QKV = WS_R;
constexpr size_t WS_AO = WS_R + 96 * MiB;
constexpr size_t WS_ACT = WS_R;
constexpr size_t WS_END = WS_R + 128 * MiB;

__global__ void __launch_bounds__(256) n_prologue(const float* __restrict__ x, float* ssq, bf16_t* xb) {
    const int wave = (blockIdx.x * 256 + threadIdx.x) >> 6, lane = threadIdx.x & 63;
    if (wave >= T) return;
    const float* xr = x + (size_t)wave * D; float s = 0.f;
    for (int j = lane; j < D; j += 64) { float v = xr[j]; s += v * v; xb[(size_t)wave * D + j] = f2bf(v); }
    s = wave_sum(s);
    if (lane == 0) ssq[wave] = s;
}
__global__ void n_bias(const float* __restrict__ rel, float* bias) {
    const int i = blockIdx.x * blockDim.x + threadIdx.x;
    if (i >= 3 * 129 * 16) return;
    const int h = i % 16, j = (i / 16) % 129, br = i / (16 * 129);
    const int dil = br == 0 ? 1 : (br == 1 ? 4 : 16);
    const int dist = j * dil; int b;
    if (dist < 16) b = dist; else { int l = 16 + (int)(log((double)dist / 16.0) / log(128.0) * 16.0); b = l < 31 ? l : 31; }
    bias[i] = rel[b * 16 + h] * LOG2E;
}

template <int NR>
__device__ __forceinline__ void naive_tile(const bf16_t* __restrict__ A, int K, const int* rows, const float* __restrict__ g,
                                           const float* __restrict__ W, int N, int col, float* acc, float* sA  ) {
    for (int r = 0; r < NR; ++r) acc[r] = 0.f;
    for (int k0 = 0; k0 < K; k0 += 1024) {
        const int kc = (K - k0) < 1024 ? (K - k0) : 1024;
        __syncthreads();
        for (int i = threadIdx.x; i < NR * kc; i += 256) { const int r = i / kc, k = i % kc; const int row = rows[r];
            float v = row >= 0 ? bf2f(A[(size_t)row * K + k0 + k]) : 0.f; if (g) v *= g[k0 + k]; sA[r * 1024 + k] = v; }
        __syncthreads();
        for (int k = 0; k < kc; k += 4) {
            const float w0 = W[(size_t)(k0 + k) * N + col], w1 = W[(size_t)(k0 + k + 1) * N + col], w2 = W[(size_t)(k0 + k + 2) * N + col], w3 = W[(size_t)(k0 + k + 3) * N + col];
#pragma unroll
            for (int r = 0; r < NR; ++r) { const float4 a = *(const float4*)(sA + r * 1024 + k); acc[r] += a.x * w0 + a.y * w1 + a.z * w2 + a.w * w3; }
        }
    }
}

__global__ void __launch_bounds__(256) n_gemm_rowscale(const bf16_t* __restrict__ A, const float* __restrict__ g, const float* __restrict__ W, int N, int K,
                                                        const float* __restrict__ ssq, bf16_t* out) {
    extern __shared__ float sA[];
    __shared__ int rows[16];
    const int row0 = blockIdx.y * 16, col = blockIdx.x * 256 + threadIdx.x;
    if (threadIdx.x < 16) rows[threadIdx.x] = row0 + threadIdx.x;
    __syncthreads();
    float acc[16];
    naive_tile<16>(A, K, rows, g, W, N, col, acc, sA);
    for (int r = 0; r < 16; ++r) { const float rs = rsqrtf(ssq[row0 + r] * (1.f / D) + EPS); out[(size_t)(row0 + r) * N + col] = f2bf(acc[r] * rs); }
}
__global__ void __launch_bounds__(256) n_gemm_residual(const bf16_t* __restrict__ A, const float* __restrict__ W, int K,
                                                        const float* base, float* out, bf16_t* xb, float* ssq_next) {
    extern __shared__ float sA[];
    __shared__ int rows[16];
    const int row0 = blockIdx.y * 16, col = blockIdx.x * 256 + threadIdx.x;
    if (threadIdx.x < 16) rows[threadIdx.x] = row0 + threadIdx.x;
    __syncthreads();
    float acc[16];
    naive_tile<16>(A, K, rows, nullptr, W, D, col, acc, sA);
    for (int r = 0; r < 16; ++r) { const size_t o = (size_t)(row0 + r) * D + col; const float v = base[o] + acc[r]; out[o] = v;
        if (xb) xb[o] = f2bf(v);
        if (ssq_next) { const float s = wave_sum(v * v); if ((threadIdx.x & 63) == 0) atomicAdd(ssq_next + row0 + r, s); } }
}
__global__ void __launch_bounds__(256) n_ffn_up(const bf16_t* __restrict__ A, const float* __restrict__ g, const float* __restrict__ W,
                                                 const float* __restrict__ ssq, const float* __restrict__ cw, const float* __restrict__ cb, bf16_t* act) {
    extern __shared__ float sA[];
    __shared__ int rows[18];
    const int row0 = blockIdx.y * 16, c = blockIdx.x * 256 + threadIdx.x;
    if (threadIdx.x < 18) { const int r = row0 - 2 + threadIdx.x; rows[threadIdx.x] = ((row0 % SEQ) == 0 && threadIdx.x < 2) ? -1 : r; }
    __syncthreads();
    float ag[18], au[18];
    naive_tile<18>(A, D, rows, g, W, DFF2, c, ag, sA);
    naive_tile<18>(A, D, rows, g, W, DFF2, c + DFF, au, sA);
    for (int r = 0; r < 18; ++r) { const float rs = rows[r] >= 0 ? rsqrtf(ssq[rows[r]] * (1.f / D) + EPS) : 0.f; ag[r] *= rs; au[r] *= rs; }
    const float g0 = cw[c], g1 = cw[DFF2 + c], g2 = cw[2 * DFF2 + c], gb = cb[c];
    const float u0 = cw[c + DFF], u1 = cw[DFF2 + c + DFF], u2 = cw[2 * DFF2 + c + DFF], ub = cb[c + DFF];
    for (int r = 0; r < 16; ++r) {
        const float gt = g0 * ag[r] + g1 * ag[r + 1] + g2 * ag[r + 2] + gb;
        const float ut = u0 * au[r] + u1 * au[r + 1] + u2 * au[r + 2] + ub;
        const float s = gt / (1.f + __expf(-gt));
        act[(size_t)(row0 + r) * DFF + c] = f2bf(s * ut);
    }
}
__global__ void __launch_bounds__(256) n_qkv(const bf16_t* __restrict__ A, const float* __restrict__ g, const float* __restrict__ W,
                                              const float* __restrict__ ssq, const float* __restrict__ gq, const float* __restrict__ gk, bf16_t* qkv) {
    extern __shared__ float sA[];
    __shared__ int rows[16];
    const int row0 = blockIdx.y * 16, col = blockIdx.x * 256 + threadIdx.x;
    if (threadIdx.x < 16) rows[threadIdx.x] = row0 + threadIdx.x;
    __syncthreads();
    float acc[16];
    naive_tile<16>(A, D, rows, g, W, NQKV, col, acc, sA);
    const int part = col / D;
    for (int r = 0; r < 16; ++r) {
        const float rs = rsqrtf(ssq[row0 + r] * (1.f / D) + EPS); float y = acc[r] * rs;
        if (part < 2) { const float ms = wave_sum(y * y) * (1.f / HD); y = y * rsqrtf(ms + EPS) * (part == 0 ? gq[col & 63] * (0.125f * LOG2E) : gk[col & 63]); }
        qkv[(size_t)(row0 + r) * NQKV + col] = f2bf(y);
    }
}
__global__ void __launch_bounds__(512) n_mixer(const bf16_t* __restrict__ proj, const float* __restrict__ cw, const float* __restrict__ pw,
                                                const float* __restrict__ ps, bf16_t* mix) {
    __shared__ float pooled[16][512];
    const int t0 = blockIdx.x * 16, c = threadIdx.x;
    for (int r = 0; r < 16; ++r) {
        const int t = t0 + r, tl = t % SEQ;
        float conv = 0.f;
        for (int i = 0; i < 3; ++i) { const int tt = tl - 2 + i; if (tt >= 0) { const size_t o = (size_t)(t - 2 + i) * EVEN_IN; conv += cw[i * AW + c] * (bf2f(proj[o + 2 * AW + c]) * bf2f(proj[o + c])); } }
        const float ya = bf2f(proj[(size_t)t * EVEN_IN + AW + c]) * conv;
        mix[(size_t)t * D + c] = f2bf(ya);
        const int gI = c >> 7, k = 2 << gI; const int cnt = (tl + 1) < k ? (tl + 1) : k; float s = 0.f;
        for (int j = 0; j < cnt; ++j) s += bf2f(proj[(size_t)(t - j) * EVEN_IN + 3 * AW + c]);
        pooled[r][c] = s / (float)cnt - bf2f(proj[(size_t)t * EVEN_IN + 3 * AW + c]);
    }
    __syncthreads();
    const int gI = c >> 7, d = c & 127;
    float acc[16];
    for (int r = 0; r < 16; ++r) acc[r] = 0.f;
    for (int cc = 0; cc < 128; ++cc) { const float w = pw[(size_t)(gI * 128 + cc) * 128 + d];
        for (int r = 0; r < 16; ++r) acc[r] += pooled[r][gI * 128 + cc] * w; }
    for (int r = 0; r < 16; ++r) mix[(size_t)(t0 + r) * D + AW + c] = f2bf(acc[r] * ps[c]);
}
__global__ void __launch_bounds__(256) n_attn(const bf16_t* __restrict__ qkv, const float* __restrict__ bias, bf16_t* ao) {
    __shared__ float sp[4][3 * 129 + 5];
    __shared__ float sq[4][64];
    const int w = threadIdx.x >> 6, lane = threadIdx.x & 63;
    const int item = blockIdx.x * 4 + w; const int t = item / NH, h = item % NH; const int tl = t % SEQ;
    sq[w][lane] = bf2f(qkv[(size_t)t * NQKV + h * HD + lane]);
    __syncthreads();
    float mx = -1e30f;
    for (int i = lane; i < 3 * 129; i += 64) {
        const int br = i / 129, j = i % 129, dil = br == 0 ? 1 : (br == 1 ? 4 : 16); const int tk = tl - j * dil;
        float s = -1e30f;
        if (tk >= 0) { const bf16_t* kr = qkv + (size_t)(t - j * dil) * NQKV + D + h * HD; float a = 0.f;
            for (int e = 0; e < 64; ++e) a += sq[w][e] * bf2f(kr[e]);
            s = a + bias[(br * 129 + j) * 16 + h]; }
        sp[w][i] = s; mx = fmaxf(mx, s);
    }
#pragma unroll
    for (int o = 1; o < 64; o <<= 1) mx = fmaxf(mx, __shfl_xor(mx, o));
    __syncthreads();
    float l = 0.f, o = 0.f;
    for (int i = 0; i < 3 * 129; ++i) {
        const float s = sp[w][i]; if (s < -1e29f) continue;
        const int br = i / 129, j = i % 129, dil = br == 0 ? 1 : (br == 1 ? 4 : 16);
        const float p = exp2f(s - mx); l += p;
        o += p * bf2f(qkv[(size_t)(t - j * dil) * NQKV + 2 * D + h * HD + lane]);
    }
    ao[(size_t)t * D + h * HD + lane] = f2bf(o / l);
}


namespace pg8 {
#define PG8_LAS __attribute__((address_space(3)))
typedef unsigned short bf16_t;
typedef short bf16x8 __attribute__((ext_vector_type(8)));
typedef float f32x4 __attribute__((ext_vector_type(4)));
typedef unsigned u32x4 __attribute__((ext_vector_type(4)));
constexpr int BM = 256, BK = 64, HALF = 128, HTB = HALF * BK * 2  , STAGE_BYTES = 8 * HTB, NXCD = 8, WGM = 8;

__host__ __device__ __forceinline__ int lds_byte(int r, int c) { const int st = (r >> 4) * 2 + (c >> 5), rr = r & 15, cc = c & 31, ob = rr * 64 + cc * 2; return st * 1024 + (ob ^ (((ob >> 9) & 1) << 5)); }
__host__ __device__ __forceinline__ void stage_rc(int b, int& R, int& C) { const int st = b / 1024, sb = b % 1024, swz = sb ^ (((sb >> 9) & 1) << 5); R = (st >> 1) * 16 + swz / 64; C = (st & 1) * 32 + (swz % 64) / 2; }
__host__ __device__ __forceinline__ int perm32(int rho) { const int n = rho >> 4, i = rho & 15; return 8 * (i >> 2) + 4 * n + (i & 3); }

struct Unit { int pm, pn; };
struct Gemm { const bf16_t* A; const bf16_t* Bt; int M, N, K; };

struct StaticOrder {
    int nM, nN, nwg, G, c;
    __host__ __device__ void init(int M, int N, int G_, int c_) { nM = M / BM; nN = N / BM; nwg = nM * nN; G = G_; c = c_; }
    __host__ __device__ bool next(int i, Unit& u) const {
        const long L = (long)i * G + c; if (L >= nwg) return false;
        int wgid = (int)L; { const int q = nwg / NXCD, r = nwg % NXCD, xcd = wgid % NXCD, off = wgid / NXCD; wgid = (xcd < r ? xcd * (q + 1) : r * (q + 1) + (xcd - r) * q) + off; }
        const int nig = WGM * nN, gid = wgid / nig, fm = gid * WGM, gsz = (nM - fm) < WGM ? (nM - fm) : WGM;
        u.pm = fm + ((wgid % nig) % gsz); u.pn = (wgid % nig) / gsz; return true;
    }
    __device__ __forceinline__ long a_row(const Unit& u) const { return (long)u.pm * BM; }
    __device__ __forceinline__ void a_ready(const Unit&) const {}
    __device__ __forceinline__ void done(const Unit&) const {}
};

typedef float f32x2c_t __attribute__((ext_vector_type(2))); typedef __bf16 bf16x2c_t __attribute__((ext_vector_type(2)));
__device__ __forceinline__ unsigned cvt_pk_bf16(float lo, float hi) { f32x2c_t v = {lo, hi}; bf16x2c_t b = __builtin_convertvector(v, bf16x2c_t); return __builtin_bit_cast(unsigned, b); }
typedef unsigned u32x2 __attribute__((ext_vector_type(2)));
__device__ __forceinline__ float row_rs(const float* ssq, int row) { return rsqrtf(ssq[row] * (1.0f / 1024.0f) + 1e-6f); }

struct EpiRowScale {
    static constexpr bool PERM = true, AFTER_DRAIN = false, PREFETCH = false;
    bf16_t* O; int ldc; const float* ssq;
    __device__ __forceinline__ void operator()(const f32x4 (&acc)[2][2][4][2], const Unit& u, int wr, int wc, int fr, int fq) const {
        const int row0 = u.pm * BM + wr * 64 + fr, col0 = u.pn * BM + wc * 32 + 8 * fq;
        float rsv[2][4];
#pragma unroll
        for (int ai = 0; ai < 2; ++ai)
#pragma unroll
            for (int m = 0; m < 4; ++m) rsv[ai][m] = ssq[row0 + ai * HALF + m * 16];
#pragma unroll
        for (int ai = 0; ai < 2; ++ai)
#pragma unroll
            for (int m = 0; m < 4; ++m) { const int row = row0 + ai * HALF + m * 16; const float rs = rsqrtf(rsv[ai][m] * (1.0f / 1024.0f) + 1e-6f); bf16_t* rowp = O + (size_t)row * ldc + col0;
#pragma unroll
                for (int bj = 0; bj < 2; ++bj) { const f32x4 v0 = acc[ai][bj][m][0] * rs, v1 = acc[ai][bj][m][1] * rs;
                    u32x4 w; w.x = cvt_pk_bf16(v0[0], v0[1]); w.y = cvt_pk_bf16(v0[2], v0[3]); w.z = cvt_pk_bf16(v1[0], v1[1]); w.w = cvt_pk_bf16(v1[2], v1[3]);
                    *(u32x4*)(rowp + bj * HALF) = w; } }
    }
};

template <bool BASE_F32, bool OUT_F32, bool OUT_XB, bool SSQ>
struct EpiResidual {
    static constexpr bool PERM = true, AFTER_DRAIN = false, PREFETCH = false;
    const float* basef; const bf16_t* baseb; float* outf; bf16_t* xbo; float* ssq_next;
    __device__ __forceinline__ void operator()(const f32x4 (&acc)[2][2][4][2], const Unit& u, int wr, int wc, int fr, int fq) const {
        const int row0 = u.pm * BM + wr * 64 + fr, col0 = u.pn * BM + wc * 32 + 8 * fq;
        if constexpr (!BASE_F32) {
            u32x4 bw[2][4][2]; float ss[2][4];
#pragma unroll
            for (int ai = 0; ai < 2; ++ai)
#pragma unroll
                for (int m = 0; m < 4; ++m)
#pragma unroll
                    for (int bj = 0; bj < 2; ++bj) bw[ai][m][bj] = *(const u32x4*)(baseb + (size_t)(row0 + ai * HALF + m * 16) * 1024 + col0 + bj * HALF);
#pragma unroll
            for (int ai = 0; ai < 2; ++ai)
#pragma unroll
                for (int m = 0; m < 4; ++m) { const int row = row0 + ai * HALF + m * 16; const size_t off = (size_t)row * 1024 + col0; float s = 0.f;
#pragma unroll
                    for (int bj = 0; bj < 2; ++bj) { const size_t o = off + bj * HALF; const u32x4 w = bw[ai][m][bj];
                        f32x4 v0 = (f32x4){__uint_as_float(w.x << 16), __uint_as_float(w.x & 0xffff0000u), __uint_as_float(w.y << 16), __uint_as_float(w.y & 0xffff0000u)};
                        f32x4 v1 = (f32x4){__uint_as_float(w.z << 16), __uint_as_float(w.z & 0xffff0000u), __uint_as_float(w.w << 16), __uint_as_float(w.w & 0xffff0000u)};
                        v0 = v0 + acc[ai][bj][m][0]; v1 = v1 + acc[ai][bj][m][1];
                        if (OUT_F32) { *(f32x4*)(outf + o) = v0; *(f32x4*)(outf + o + 4) = v1; }
                        if (OUT_XB) { u32x4 wo; wo.x = cvt_pk_bf16(v0[0], v0[1]); wo.y = cvt_pk_bf16(v0[2], v0[3]); wo.z = cvt_pk_bf16(v1[0], v1[1]); wo.w = cvt_pk_bf16(v1[2], v1[3]); *(u32x4*)(xbo + o) = wo; }
                        s += (v0[0] * v0[0] + v0[1] * v0[1]) + (v0[2] * v0[2] + v0[3] * v0[3]) + (v1[0] * v1[0] + v1[1] * v1[1]) + (v1[2] * v1[2] + v1[3] * v1[3]); }
                    if (SSQ) { s += __shfl_xor(s, 16); s += __shfl_xor(s, 32); }
                    ss[ai][m] = s; }
            if (SSQ) { if (fq == 0) {
#pragma unroll
                for (int ai = 0; ai < 2; ++ai)
#pragma unroll
                    for (int m = 0; m < 4; ++m) atomicAdd(ssq_next + row0 + ai * HALF + m * 16, ss[ai][m]); } }
        } else {
#pragma unroll
        for (int ai = 0; ai < 2; ++ai)
#pragma unroll
            for (int m = 0; m < 4; ++m) { const int row = row0 + ai * HALF + m * 16; const size_t off = (size_t)row * 1024 + col0; float s = 0.f;
#pragma unroll
                for (int bj = 0; bj < 2; ++bj) { const size_t o = off + bj * HALF; f32x4 v0, v1;
                    v0 = *(const f32x4*)(basef + o); v1 = *(const f32x4*)(basef + o + 4);
                    v0 = v0 + acc[ai][bj][m][0]; v1 = v1 + acc[ai][bj][m][1];
                    if (OUT_F32) { *(f32x4*)(outf + o) = v0; *(f32x4*)(outf + o + 4) = v1; }
                    if (OUT_XB) { u32x4 w; w.x = cvt_pk_bf16(v0[0], v0[1]); w.y = cvt_pk_bf16(v0[2], v0[3]); w.z = cvt_pk_bf16(v1[0], v1[1]); w.w = cvt_pk_bf16(v1[2], v1[3]); *(u32x4*)(xbo + o) = w; }
                    s += (v0[0] * v0[0] + v0[1] * v0[1]) + (v0[2] * v0[2] + v0[3] * v0[3]) + (v1[0] * v1[0] + v1[1] * v1[1]) + (v1[2] * v1[2] + v1[3] * v1[3]); }
                if (SSQ) { s += __shfl_xor(s, 16); s += __shfl_xor(s, 32); if (fq == 0) atomicAdd(ssq_next + row, s); }
                if (m & 1) asm volatile("" ::: "memory"); }
        }
    }
};

struct EpiQkv {
    static constexpr bool PERM = true, AFTER_DRAIN = false, PREFETCH = false;
    bf16_t* O; const float* ssq; const float* gq; const float* gk;
    __device__ __forceinline__ void operator()(const f32x4 (&acc)[2][2][4][2], const Unit& u, int wr, int wc, int fr, int fq) const {
        const int row0 = u.pm * BM + wr * 64 + fr; const int part = (u.pn * BM) >> 10;
        float rsv[2][4];
#pragma unroll
        for (int ai = 0; ai < 2; ++ai)
#pragma unroll
            for (int m = 0; m < 4; ++m) rsv[ai][m] = ssq[row0 + ai * HALF + m * 16];
        const float* gp = (part == 1 ? gk : gq) + 8 * fq; const float sc0 = part == 0 ? 0.125f * 1.4426950408889634f : 1.0f; const bool nrm = part < 2;
        f32x4 gv[2][2];
#pragma unroll
        for (int bj = 0; bj < 2; ++bj)
#pragma unroll
            for (int n = 0; n < 2; ++n) gv[bj][n] = *(const f32x4*)(gp + 32 * bj + 4 * n);
#pragma unroll
        for (int bj = 0; bj < 2; ++bj)
#pragma unroll
            for (int n = 0; n < 2; ++n)
#pragma unroll
                for (int j = 0; j < 4; ++j) gv[bj][n][j] = nrm ? gv[bj][n][j] * sc0 : 1.0f;
#pragma unroll
        for (int ai = 0; ai < 2; ++ai)
#pragma unroll
            for (int m = 0; m < 4; ++m) { const int row = row0 + ai * HALF + m * 16; const float rs = rsqrtf(rsv[ai][m] * (1.0f / 1024.0f) + 1e-6f);
                f32x4 y[2][2]; float ss = 0.f;
#pragma unroll
                for (int bj = 0; bj < 2; ++bj)
#pragma unroll
                    for (int n = 0; n < 2; ++n) { y[bj][n] = acc[ai][bj][m][n] * rs; const f32x4 t = y[bj][n]; ss += (t[0] * t[0] + t[1] * t[1]) + (t[2] * t[2] + t[3] * t[3]); }
                ss += __shfl_xor(ss, 16); ss += __shfl_xor(ss, 32); const float sc1 = rsqrtf(ss * (1.0f / 64.0f) + 1e-6f), sc = nrm ? sc1 : 1.0f;
#pragma unroll
                for (int bj = 0; bj < 2; ++bj)
#pragma unroll
                    for (int n = 0; n < 2; ++n) y[bj][n] = y[bj][n] * sc * gv[bj][n];
                const int hh = ((u.pn & 3) << 2) + wc;
                bf16_t* blk = O + (size_t)part * (16384u * 1024u) + ((size_t)((row >> 12) * 16 + hh) * 4096 + ((row - fr) & 4095)) * 64 + 8 * fq;
                u32x4 w0, w1, xx;
                w0.x = cvt_pk_bf16(y[0][0][0], y[0][0][1]); w0.y = cvt_pk_bf16(y[0][0][2], y[0][0][3]); w0.z = cvt_pk_bf16(y[0][1][0], y[0][1][1]); w0.w = cvt_pk_bf16(y[0][1][2], y[0][1][3]);
                w1.x = cvt_pk_bf16(y[1][0][0], y[1][0][1]); w1.y = cvt_pk_bf16(y[1][0][2], y[1][0][3]); w1.z = cvt_pk_bf16(y[1][1][0], y[1][1][1]); w1.w = cvt_pk_bf16(y[1][1][2], y[1][1][3]);
#pragma unroll
                for (int c = 0; c < 4; ++c) xx[c] = (unsigned)__builtin_amdgcn_update_dpp(0, (int)w1[c], 0x128, 0xf, 0xf, false);
                const bool lo = fr < 8; u32x4 sa, sb;
#pragma unroll
                for (int c = 0; c < 4; ++c) { sa[c] = lo ? w0[c] : xx[c]; sb[c] = lo ? xx[c] : w0[c]; }
                *(u32x4*)(blk + (fr & 7) * 64 + (lo ? 0 : 32)) = sa;
                *(u32x4*)(blk + (8 + (fr & 7)) * 64 + (lo ? 32 : 0)) = sb; }
    }
};

template <int CTRL> __device__ __forceinline__ float dppf(float o, float s) { return __int_as_float(__builtin_amdgcn_update_dpp(__float_as_int(o), __float_as_int(s), CTRL, 0xf, 0xf, false)); }
template <int CTRL> __device__ __forceinline__ f32x4 dpp4(f32x4 o, f32x4 s) { f32x4 r; r[0] = dppf<CTRL>(o[0], s[0]); r[1] = dppf<CTRL>(o[1], s[1]); r[2] = dppf<CTRL>(o[2], s[2]); r[3] = dppf<CTRL>(o[3], s[3]); return r; }
__device__ __forceinline__ f32x4 dpp4_shr1(f32x4 o, f32x4 s) { return dpp4<0x111>(o, s); }
__device__ __forceinline__ f32x4 dpp4_shr2(f32x4 o, f32x4 s) { return dpp4<0x112>(o, s); }
__device__ __forceinline__ f32x4 dpp4_shl15(f32x4 o, f32x4 s) { return dpp4<0x10f>(o, s); }
__device__ __forceinline__ f32x4 dpp4_shl14(f32x4 o, f32x4 s) { return dpp4<0x10e>(o, s); }
#define PIN4(x) asm volatile("" : "+v"(x))
#define DPPM " row_mask:0xf bank_mask:0xf bound_ctrl:1\n\t"
__device__ __forceinline__ void conv_taps_cur(f32x4& nv, const f32x4 cur, const f32x4 w1, const f32x4 w0) {
    float n0 = nv[0], n1 = nv[1], n2 = nv[2], n3 = nv[3];
    asm volatile("s_nop 1\n\t"
        "v_fmac_f32_dpp %0, %4, %8 row_shr:1" DPPM "v_fmac_f32_dpp %1, %5, %9 row_shr:1" DPPM "v_fmac_f32_dpp %2, %6, %10 row_shr:1" DPPM "v_fmac_f32_dpp %3, %7, %11 row_shr:1" DPPM
        "v_fmac_f32_dpp %0, %4, %12 row_shr:2" DPPM "v_fmac_f32_dpp %1, %5, %13 row_shr:2" DPPM "v_fmac_f32_dpp %2, %6, %14 row_shr:2" DPPM "v_fmac_f32_dpp %3, %7, %15 row_shr:2" DPPM
        : "+v"(n0), "+v"(n1), "+v"(n2), "+v"(n3)
        : "v"(cur[0]), "v"(cur[1]), "v"(cur[2]), "v"(cur[3]), "v"(w1[0]), "v"(w1[1]), "v"(w1[2]), "v"(w1[3]), "v"(w0[0]), "v"(w0[1]), "v"(w0[2]), "v"(w0[3]));
    nv = (f32x4){n0, n1, n2, n3};
}
__device__ __forceinline__ void conv_taps_prev(f32x4& nv, const f32x4 pv, const f32x4 w1, const f32x4 w0) {
    float n0 = nv[0], n1 = nv[1], n2 = nv[2], n3 = nv[3];
    asm volatile("s_nop 1\n\t"
        "v_fmac_f32_dpp %0, %4, %8 row_shl:15" DPPM "v_fmac_f32_dpp %1, %5, %9 row_shl:15" DPPM "v_fmac_f32_dpp %2, %6, %10 row_shl:15" DPPM "v_fmac_f32_dpp %3, %7, %11 row_shl:15" DPPM
        "v_fmac_f32_dpp %0, %4, %12 row_shl:14" DPPM "v_fmac_f32_dpp %1, %5, %13 row_shl:14" DPPM "v_fmac_f32_dpp %2, %6, %14 row_shl:14" DPPM "v_fmac_f32_dpp %3, %7, %15 row_shl:14" DPPM
        : "+v"(n0), "+v"(n1), "+v"(n2), "+v"(n3)
        : "v"(pv[0]), "v"(pv[1]), "v"(pv[2]), "v"(pv[3]), "v"(w1[0]), "v"(w1[1]), "v"(w1[2]), "v"(w1[3]), "v"(w0[0]), "v"(w0[1]), "v"(w0[2]), "v"(w0[3]));
    nv = (f32x4){n0, n1, n2, n3};
}
struct EpiConvGlu {
    static constexpr bool PERM = true, AFTER_DRAIN = false, PREFETCH = true;
    bf16_t* act; const float* ssq; const float* cw; const float* cb; PG8_LAS float* halo;
    __device__ __forceinline__ void prefetch(const Unit& u, int wid, int lane, int par) const {
        PG8_LAS unsigned char* pf = (PG8_LAS unsigned char*)halo + 12288 + par * 5120;
        if (wid < 4) { const int b = u.pm / 17, it = u.pm - b * 17; int tl = 254 * it - 2 + wid * 64 + lane; tl = tl < 0 ? 0 : (tl > 4095 ? 4095 : tl);
            __builtin_amdgcn_global_load_lds((const unsigned*)(ssq + b * 4096 + tl), (PG8_LAS unsigned*)(pf + 4096 + wid * 256), 4, 0, 0); }
        else { const int seg = (wid - 4) * 2 + (lane >> 5), j = seg >> 1, bj = seg & 1; const float* src = (j < 3 ? cw + j * 5632 : cb) + u.pn * HALF + bj * 2816 + (lane & 31) * 4;
            __builtin_amdgcn_global_load_lds((const unsigned*)src, (PG8_LAS unsigned*)(pf + (wid - 4) * 1024), 16, 0, 0); }
    }
    __device__ __forceinline__ void operator()(f32x4 (&acc)[2][2][4][2], const Unit& u, int wr, int wc, int fr, int fq, int par) const {
        const int b = u.pm / 17, it = u.pm - b * 17; const int tl0 = 254 * it - 2 + wr * 64 + fr;
        const int colg = u.pn * HALF + wc * 32 + 8 * fq;
        float rsv[2][4];
        const PG8_LAS float* pfs = (const PG8_LAS float*)((const PG8_LAS unsigned char*)halo + 12288 + par * 5120 + 4096) + wr * 64 + fr;
        const PG8_LAS unsigned char* pfw = (const PG8_LAS unsigned char*)halo + 12288 + par * 5120 + (wc * 32 + 8 * fq) * 4;
#pragma unroll
        for (int ai = 0; ai < 2; ++ai)
#pragma unroll
            for (int m = 0; m < 4; ++m) rsv[ai][m] = pfs[ai * HALF + m * 16];
#pragma unroll
        for (int ai = 0; ai < 2; ++ai)
#pragma unroll
            for (int m = 0; m < 4; ++m) { const int tl = tl0 + ai * HALF + m * 16; const bool ok = (tl >= 0) && (tl < 4096); const float r0 = rsqrtf(rsv[ai][m] * (1.0f / 1024.0f) + 1e-6f); const float rs = ok ? r0 : 0.f;
#pragma unroll
                for (int bj = 0; bj < 2; ++bj)
#pragma unroll
                    for (int n = 0; n < 2; ++n) { acc[ai][bj][m][n] = acc[ai][bj][m][n] * rs; PIN4(acc[ai][bj][m][n]); } }
        PG8_LAS f32x4* H = (PG8_LAS f32x4*)halo;
        { PG8_LAS f32x4* Hw = H + ((wr ^ 1) * 16 + wc * 4 + fq) + wr * 256 + (fr & 1) * 128;
          if (fr >= 14) {
#pragma unroll
            for (int ai = 0; ai < 2; ++ai)
#pragma unroll
                for (int bj = 0; bj < 2; ++bj)
#pragma unroll
                    for (int n = 0; n < 2; ++n) Hw[ai * 256 + bj * 64 + n * 32] = acc[ai][bj][3][n]; } }
        asm volatile("s_waitcnt lgkmcnt(0)" ::: "memory"); __builtin_amdgcn_s_barrier(); asm volatile("" ::: "memory"); __builtin_amdgcn_sched_barrier(0);
        const PG8_LAS f32x4* Hr = H + (wr * 16 + wc * 4 + fq);
#pragma unroll
        for (int bj = 0; bj < 2; ++bj)
#pragma unroll
            for (int n = 0; n < 2; ++n) { const int c = colg + bj * 2816 + 4 * n;
                f32x4 w0 = *(const PG8_LAS f32x4*)(pfw + (0 + bj) * 512 + n * 16), w1 = *(const PG8_LAS f32x4*)(pfw + (2 + bj) * 512 + n * 16), w2 = *(const PG8_LAS f32x4*)(pfw + (4 + bj) * 512 + n * 16), bb = *(const PG8_LAS f32x4*)(pfw + (6 + bj) * 512 + n * 16);
                PIN4(w0); PIN4(w1); PIN4(w2); PIN4(bb);
#pragma unroll
                for (int ai = 0; ai < 2; ++ai) { const int s = 2 * ai + wr;
                    f32x4 h1 = (f32x4){0.f, 0.f, 0.f, 0.f}, h2 = h1;
                    if (s > 0) { h2 = Hr[ai * 256 + bj * 64 + n * 32]; h1 = Hr[ai * 256 + 128 + bj * 64 + n * 32]; }
                    PIN4(h1); PIN4(h2);
#pragma unroll
                    for (int m = 3; m >= 0; --m) { f32x4 cur = acc[ai][bj][m][n]; PIN4(cur); f32x4 o1, o2;
#ifdef X_SHFL
                        const int ln = (int)(threadIdx.x & 63); f32x4 p1, p2;
                        if (m > 0) { const f32x4 pv = acc[ai][bj][m - 1][n];
                            for (int j = 0; j < 4; ++j) { const float a1 = __shfl(cur[j], ln - 1, 64), b1 = __shfl(pv[j], ln + 15, 64), a2 = __shfl(cur[j], ln - 2, 64), b2 = __shfl(pv[j], ln + 14, 64);
                                p1[j] = fr >= 1 ? a1 : b1; p2[j] = fr >= 2 ? a2 : b2; } }
                        else { for (int j = 0; j < 4; ++j) { const float a1 = __shfl(cur[j], ln - 1, 64), a2 = __shfl(cur[j], ln - 2, 64);
                                p1[j] = fr >= 1 ? a1 : h1[j]; p2[j] = fr >= 2 ? a2 : (fr == 0 ? h2[j] : h1[j]); } }
                        f32x4 nv = w2 * cur + w1 * p1 + w0 * p2 + bb; PIN4(nv);
#elif !defined(X_DPPMOV)
                        f32x4 nv = w2 * cur + bb;
                        if (m > 0) { const f32x4 pv = acc[ai][bj][m - 1][n]; conv_taps_prev(nv, pv, w1, w0); }
                        else { const f32x4 hz = (f32x4){0.f, 0.f, 0.f, 0.f}; const f32x4 t1 = (fr == 0) ? h1 : hz, t2 = (fr == 0) ? h2 : ((fr == 1) ? h1 : hz); nv = nv + w1 * t1 + w0 * t2; }
                        conv_taps_cur(nv, cur, w1, w0);
#else
                        if (m > 0) { const f32x4 pv = acc[ai][bj][m - 1][n]; o1 = dpp4_shl15(pv, pv); o2 = dpp4_shl14(pv, pv); }
                        else { o1 = h1; o2 = (fr == 0) ? h2 : h1; }
                        const f32x4 p1 = dpp4_shr1(o1, cur), p2 = dpp4_shr2(o2, cur);
                        f32x4 nv = w2 * cur + w1 * p1 + w0 * p2 + bb; PIN4(nv);
#endif
                        acc[ai][bj][m][n] = nv; } } }
        __builtin_amdgcn_sched_barrier(0);
#pragma unroll
        for (int ai = 0; ai < 2; ++ai)
#pragma unroll
            for (int m = 0; m < 4; ++m) { const int rl = ai * HALF + wr * 64 + m * 16 + fr; const int tl = 254 * it - 2 + rl;
                f32x4 r[2];
#pragma unroll
                for (int n = 0; n < 2; ++n) { const f32x4 g = acc[ai][0][m][n], up = acc[ai][1][m][n];
#pragma unroll
                    for (int j = 0; j < 4; ++j) { const float e = __builtin_amdgcn_exp2f(g[j] * -1.4426950408889634f); r[n][j] = g[j] * __builtin_amdgcn_rcpf(1.0f + e) * up[j]; } }
                if (rl >= 2 && tl < 4096) { u32x4 w; w.x = cvt_pk_bf16(r[0][0], r[0][1]); w.y = cvt_pk_bf16(r[0][2], r[0][3]); w.z = cvt_pk_bf16(r[1][0], r[1][1]); w.w = cvt_pk_bf16(r[1][2], r[1][3]);
                    *(u32x4*)(act + (size_t)(b * 4096 + tl) * 2816 + colg) = w; }
                asm volatile("" ::: "memory"); }
    }
};
struct OverlapOrder : StaticOrder {
    __device__ __forceinline__ long a_row(const Unit& u) const { const int b = u.pm / 17, it = u.pm - b * 17; return (long)b * 4096 + 254 * it - 2; }
};

template <class Epi, class Sched, bool ALIGN_EPI = false, bool SP2 = false>
__device__ __forceinline__ void gemm_phase(PG8_LAS unsigned char* lds, const Gemm g, const Sched& S, const Epi& E) {
    const int tid = threadIdx.x, wid = __builtin_amdgcn_readfirstlane(tid >> 6), lane = tid & 63, wr = wid >> 2, wc = wid & 3, fr = lane & 15, fq = lane >> 4;
    const int K = g.K, nt = K / BK;
    unsigned voffA[2], voffB[2];
#pragma unroll
    for (int i = 0; i < 2; ++i) { int R, C; stage_rc(tid * 16 + i * 8192, R, C); const int Rb = Epi::PERM ? ((R & ~31) + perm32(R & 31)) : R;
        voffA[i] = (unsigned)(R * K + C) * 2u; voffB[i] = (unsigned)(Rb * K + C) * 2u; }
    const size_t kstep = (size_t)(BK * 2);
    const size_t hstep = (size_t)HALF * K * 2;
    const size_t tstep = 2 * hstep;
    const unsigned ldsw = (unsigned)wid * 1024u;
    const int aoff = lds_byte(wr * 64 + fr, fq * 8), boff = lds_byte(wc * 32 + fr, fq * 8);
#define PG8_SA(b, h) (((b) * 2 + (h)) * HTB)
#define PG8_SB(b, h) ((4 + (b) * 2 + (h)) * HTB)
#define PG8_STAGE(bufoff, gbase, voff) do { _Pragma("unroll") for (int _i = 0; _i < 2; ++_i) \
        __builtin_amdgcn_global_load_lds((const unsigned*)((const char*)(gbase) + (voff)[_i]), (PG8_LAS unsigned*)(lds + (bufoff) + ldsw + _i * 8192), 16, 0, 0); } while (0)
#define PG8_LDA(dst, b, h) do { _Pragma("unroll") for (int m = 0; m < 4; ++m) _Pragma("unroll") for (int k = 0; k < 2; ++k) dst[m][k] = *(const PG8_LAS bf16x8*)(lds + PG8_SA(b, h) + aoff + m * 2048 + k * 1024); } while (0)
#define PG8_LDB(dst, b, h) do { _Pragma("unroll") for (int n = 0; n < 2; ++n) _Pragma("unroll") for (int k = 0; k < 2; ++k) dst[n][k] = *(const PG8_LAS bf16x8*)(lds + PG8_SB(b, h) + boff + n * 2048 + k * 1024); } while (0)
#define PG8_MMA(ai, bj, At, Bt) do { __builtin_amdgcn_s_setprio(1); _Pragma("unroll") for (int m = 0; m < 4; ++m) _Pragma("unroll") for (int n = 0; n < 2; ++n) _Pragma("unroll") for (int k = 0; k < 2; ++k) \
        acc[ai][bj][m][n] = __builtin_amdgcn_mfma_f32_16x16x32_bf16(Bt[n][k], At[m][k], acc[ai][bj][m][n], 0, 0, 0); __builtin_amdgcn_s_setprio(0); } while (0)
#define PG8_WAIT_V(n) asm volatile("s_waitcnt vmcnt(" #n ")" ::: "memory")
#define PG8_WAIT_L(n) asm volatile("s_waitcnt lgkmcnt(" #n ")" ::: "memory")
#define PG8_BAR __builtin_amdgcn_s_barrier()
#define PG8_SCHED __builtin_amdgcn_sched_barrier(0)
    Unit cur, nxt; int ui = 0;
    if (!S.next(0, cur)) return;
    f32x4 acc[2][2][4][2];
#pragma unroll
    for (int a = 0; a < 2; ++a)
#pragma unroll
        for (int b = 0; b < 2; ++b)
#pragma unroll
            for (int m = 0; m < 4; ++m)
#pragma unroll
                for (int n = 0; n < 2; ++n) acc[a][b][m][n] = (f32x4){0.f, 0.f, 0.f, 0.f};
    bf16x8 At[4][2], B0[2][2], B1[2][2];
    const char* cA = (const char*)g.A + (long)S.a_row(cur) * (long)(K * 2); const char* cB = (const char*)g.Bt + (size_t)cur.pn * tstep;
    S.a_ready(cur);
    if constexpr (Epi::PREFETCH) E.prefetch(cur, wid, lane, 0);
    if constexpr (SP2) {
        PG8_STAGE(PG8_SB(0, 0), cB, voffB); PG8_STAGE(PG8_SB(0, 1), cB + hstep, voffB); PG8_STAGE(PG8_SA(0, 0), cA, voffA); PG8_STAGE(PG8_SA(0, 1), cA + hstep, voffA);
        if (wr == 1) PG8_BAR;
        PG8_WAIT_V(2); PG8_BAR;
        PG8_STAGE(PG8_SB(1, 0), cB + kstep, voffB); PG8_STAGE(PG8_SA(1, 0), cA + kstep, voffA); PG8_STAGE(PG8_SB(1, 1), cB + hstep + kstep, voffB);
        PG8_WAIT_V(6); PG8_BAR;
    } else {
        PG8_STAGE(PG8_SB(0, 0), cB, voffB); PG8_STAGE(PG8_SA(0, 0), cA, voffA); PG8_STAGE(PG8_SB(0, 1), cB + hstep, voffB); PG8_STAGE(PG8_SA(0, 1), cA + hstep, voffA);
        if (wr == 1) PG8_BAR;
        PG8_WAIT_V(4); PG8_BAR;
        PG8_STAGE(PG8_SB(1, 0), cB + kstep, voffB); PG8_STAGE(PG8_SA(1, 0), cA + kstep, voffA); PG8_STAGE(PG8_SB(1, 1), cB + hstep + kstep, voffB);
        PG8_WAIT_V(6); PG8_BAR;
    }
    for (;;) {
        const bool has_next = S.next(ui + 1, nxt);
        const char* nA = has_next ? (const char*)g.A + (long)S.a_row(nxt) * (long)(K * 2) : cA; const char* nB = has_next ? (const char*)g.Bt + (size_t)nxt.pn * tstep : cB;
        for (int t = 0; t < nt; t += 2) {
            const bool last = (t == nt - 2);
            const char* a1 = cA + (size_t)(t + 1) * kstep;
            const char* a2 = last ? nA : cA + (size_t)(t + 2) * kstep; const char* b2 = last ? nB : cB + (size_t)(t + 2) * kstep;
            const char* a3 = a2 + kstep; const char* b3 = b2 + kstep;
            if (last && has_next) S.a_ready(nxt);
            if constexpr (SP2) {
            PG8_LDB(B0, 0, 0); PG8_LDB(B1, 0, 1); PG8_SCHED; PG8_LDA(At, 0, 0); PG8_STAGE(PG8_SA(1, 1), a1 + hstep, voffA);
            PG8_WAIT_V(8); PG8_WAIT_L(0); PG8_BAR; PG8_MMA(0, 0, At, B0); PG8_MMA(0, 1, At, B1); PG8_BAR; PG8_SCHED;
            PG8_LDA(At, 0, 1); PG8_STAGE(PG8_SB(0, 0), b2, voffB); PG8_STAGE(PG8_SB(0, 1), b2 + hstep, voffB); PG8_STAGE(PG8_SA(0, 0), a2, voffA);
            PG8_WAIT_V(8); PG8_WAIT_L(0); PG8_BAR; PG8_MMA(1, 0, At, B0); PG8_MMA(1, 1, At, B1); PG8_BAR; PG8_SCHED;
            PG8_LDB(B0, 1, 0); PG8_LDB(B1, 1, 1); PG8_SCHED; PG8_LDA(At, 1, 0); PG8_STAGE(PG8_SA(0, 1), a2 + hstep, voffA);
            PG8_WAIT_V(8); PG8_WAIT_L(0); PG8_BAR; PG8_MMA(0, 0, At, B0); PG8_MMA(0, 1, At, B1); PG8_BAR; PG8_SCHED;
            PG8_LDA(At, 1, 1); PG8_STAGE(PG8_SB(1, 0), b3, voffB); PG8_STAGE(PG8_SB(1, 1), b3 + hstep, voffB); PG8_STAGE(PG8_SA(1, 0), a3, voffA);
            PG8_WAIT_V(8); PG8_WAIT_L(0); PG8_BAR; PG8_MMA(1, 0, At, B0); PG8_MMA(1, 1, At, B1); PG8_BAR; PG8_SCHED;
            } else {
            PG8_LDB(B0, 0, 0); PG8_SCHED; PG8_LDA(At, 0, 0); PG8_STAGE(PG8_SA(1, 1), a1 + hstep, voffA);
            PG8_WAIT_L(8); PG8_BAR; PG8_WAIT_L(0); PG8_MMA(0, 0, At, B0); PG8_BAR; PG8_SCHED;
            PG8_LDB(B1, 0, 1); PG8_STAGE(PG8_SB(0, 0), b2, voffB);
            PG8_BAR; PG8_WAIT_L(0); PG8_MMA(0, 1, At, B1); PG8_BAR;
            PG8_LDA(At, 0, 1); PG8_STAGE(PG8_SA(0, 0), a2, voffA);
            PG8_BAR; PG8_WAIT_L(0); PG8_MMA(1, 0, At, B0); PG8_BAR; PG8_SCHED;
            PG8_STAGE(PG8_SB(0, 1), b2 + hstep, voffB);
            PG8_WAIT_V(6); PG8_BAR; PG8_MMA(1, 1, At, B1); PG8_BAR;
            PG8_LDB(B0, 1, 0); PG8_SCHED; PG8_LDA(At, 1, 0); PG8_STAGE(PG8_SA(0, 1), a2 + hstep, voffA);
            PG8_WAIT_L(8); PG8_BAR; PG8_WAIT_L(0); PG8_MMA(0, 0, At, B0); PG8_BAR; PG8_SCHED;
            PG8_LDB(B1, 1, 1); PG8_STAGE(PG8_SB(1, 0), b3, voffB);
            PG8_BAR; PG8_WAIT_L(0); PG8_MMA(0, 1, At, B1); PG8_BAR;
            PG8_LDA(At, 1, 1); PG8_STAGE(PG8_SA(1, 0), a3, voffA);
            PG8_BAR; PG8_WAIT_L(0); PG8_MMA(1, 0, At, B0); PG8_BAR; PG8_SCHED;
            PG8_STAGE(PG8_SB(1, 1), b3 + hstep, voffB);
            PG8_WAIT_V(6); PG8_BAR; PG8_MMA(1, 1, At, B1); PG8_BAR;
            }
        }
        if constexpr (ALIGN_EPI) { if (wr == 0) PG8_BAR; }
        if constexpr (Epi::PREFETCH) { E(acc, cur, wr, wc, fr, fq, ui & 1); if (has_next) E.prefetch(nxt, wid, lane, (ui + 1) & 1); S.done(cur); }
        else if constexpr (!Epi::AFTER_DRAIN) { E(acc, cur, wr, wc, fr, fq); S.done(cur); }
        if (!has_next) break;
#pragma unroll
        for (int a = 0; a < 2; ++a)
#pragma unroll
            for (int b = 0; b < 2; ++b)
#pragma unroll
                for (int m = 0; m < 4; ++m)
#pragma unroll
                    for (int n = 0; n < 2; ++n) acc[a][b][m][n] = (f32x4){0.f, 0.f, 0.f, 0.f};
        cur = nxt; cA = nA; cB = nB; ++ui;
        if constexpr (ALIGN_EPI) { if (wr == 1) PG8_BAR; }
    }
    PG8_WAIT_V(0);
    if constexpr (!ALIGN_EPI) { if (wr == 0) PG8_BAR; }
    PG8_BAR;
    if constexpr (Epi::AFTER_DRAIN) { E.fused(acc, cur, wr, wc, fr, fq, lds, wid, lane); S.done(cur); }
#undef PG8_SA
#undef PG8_SB
#undef PG8_STAGE
#undef PG8_LDA
#undef PG8_LDB
#undef PG8_MMA
#undef PG8_WAIT_V
#undef PG8_WAIT_L
#undef PG8_BAR
#undef PG8_SCHED
}
}

#define GAS __attribute__((address_space(1)))
#define LAS __attribute__((address_space(3)))
typedef unsigned short bf16;
typedef unsigned v4u __attribute__((ext_vector_type(4)));
typedef float f32x4 __attribute__((ext_vector_type(4)));
typedef short bf16x8 __attribute__((ext_vector_type(8)));
typedef GAS unsigned gu32;
typedef GAS unsigned long long gu64;
#define RLX_AGENT __ATOMIC_RELAXED, __HIP_MEMORY_SCOPE_AGENT
#define LDS_WAIT() asm volatile("s_waitcnt lgkmcnt(0)" ::: "memory")
#define VM_WAIT() asm volatile("s_waitcnt vmcnt(0)" ::: "memory")
__device__ __forceinline__ unsigned long long rt() { return __builtin_amdgcn_s_memrealtime(); }
__device__ __forceinline__ unsigned pk2(float lo, float hi) { return (unsigned)f2bf(lo) | ((unsigned)f2bf(hi) << 16); }
#define XB_TMO      128
#define XB_XCNT(j)  (256  + 64 * (j))
#define XB_XSUB(j)  (1280 + 64 * (j))
#define XB_XGEN(j)  (2304 + 64 * (j))
#define XB_TOP      3328
#define XB_TOPGEN   3392
#define XCD_BAR_WORDS 3456
#define XB_SPIN_CAP (1u << 18)

__device__ __forceinline__ unsigned xb_ld(unsigned* p)              { return __hip_atomic_load(p, __ATOMIC_RELAXED, __HIP_MEMORY_SCOPE_AGENT); }
__device__ __forceinline__ unsigned xb_add(unsigned* p, unsigned v) { return __hip_atomic_fetch_add(p, v, __ATOMIC_RELAXED, __HIP_MEMORY_SCOPE_AGENT); }
__device__ __forceinline__ unsigned xb_xcc_id() { return (unsigned)__builtin_amdgcn_s_getreg((3 << 11) | 20) & 0xFu; }
#define XB_SPIN(cond, bar) do { unsigned _sp = 0; while (cond) { __builtin_amdgcn_s_sleep(1); \
    if ((++_sp & 255u) == 0u) { if (xb_ld(&(bar)[XB_TMO])) break; if (_sp > XB_SPIN_CAP) { atomicAdd(&(bar)[XB_TMO], 1u); break; } } } } while (0)

struct XcdBarrier {
    unsigned* bar; unsigned x;
    volatile LAS unsigned* st;
};

__device__ __forceinline__ XcdBarrier xcd_barrier_post(unsigned* bar, volatile LAS unsigned* st) {
    XcdBarrier b; b.bar = bar; b.x = xb_xcc_id(); b.st = st;
    if (threadIdx.x == 0) (void)xb_add(&bar[XB_XCNT(b.x)], 1u);
    return b;
}
__device__ __forceinline__ void xcd_barrier_complete(unsigned* bar, unsigned x, unsigned& nloc, unsigned& nx) {
    const unsigned G = gridDim.x * gridDim.y * gridDim.z;
    unsigned sum, cnt, mine, sp = 0u;
    for (;;) {
        sum = 0u; cnt = 0u; mine = 0u;
#pragma unroll
        for (unsigned j = 0; j < 16; ++j) { const unsigned c = xb_ld(&bar[XB_XCNT(j)]); sum += c; cnt += (c > 0u) ? 1u : 0u; mine = (j == x) ? c : mine; }
        if (sum == G) break;
        __builtin_amdgcn_s_sleep(1);
        if ((++sp & 255u) == 0u) { if (xb_ld(&bar[XB_TMO])) break; if (sp > XB_SPIN_CAP) { atomicAdd(&bar[XB_TMO], 1u); break; } }
    }
    nloc = mine > 0u ? mine : 1u; nx = cnt > 0u ? cnt : 1u;
}

__device__ __forceinline__ void xcd_barrier_protocol(const XcdBarrier& b) {
        unsigned* bar = b.bar;
        __builtin_amdgcn_s_waitcnt(0);
        unsigned nloc = b.st[0], nx = b.st[1];
        if (nloc == 0u) { xcd_barrier_complete(bar, b.x, nloc, nx); b.st[0] = nloc; b.st[1] = nx; }
        const unsigned old = xb_add(&bar[XB_XSUB(b.x)], 1u);
        const unsigned gen = old / nloc;
        if (old + 1u == (gen + 1u) * nloc) {
            __builtin_amdgcn_fence(__ATOMIC_RELEASE, "agent");
            asm volatile("s_waitcnt vmcnt(0)" ::: "memory");
            const unsigned og = xb_add(&bar[XB_TOP], 1u);
            const unsigned tg = og / nx;
            if (og + 1u == (tg + 1u) * nx) xb_add(&bar[XB_TOPGEN], 1u);
            else XB_SPIN(xb_ld(&bar[XB_TOPGEN]) == tg, bar);
            __builtin_amdgcn_fence(__ATOMIC_ACQUIRE, "agent");
            asm volatile("s_waitcnt vmcnt(0)" ::: "memory");
        } else {
            XB_SPIN(xb_ld(&bar[XB_TOPGEN]) == gen, bar);
            __builtin_amdgcn_fence(__ATOMIC_ACQUIRE, "agent");
            asm volatile("s_waitcnt vmcnt(0)" ::: "memory");
        }
}
__device__ __forceinline__ void xcd_barrier(const XcdBarrier& b) {
    asm volatile("s_waitcnt vmcnt(0)" ::: "memory");
    __syncthreads();
    if (threadIdx.x == 0) xcd_barrier_protocol(b);
    __syncthreads();
}
template <class Work>
__device__ __forceinline__ void xcd_barrier_work(const XcdBarrier& b, int wave, const Work& work) {
    asm volatile("s_waitcnt vmcnt(0)" ::: "memory");
    __syncthreads();
    if (wave == 0) { if (threadIdx.x == 0) xcd_barrier_protocol(b); }
    else work(wave - 1);
    __syncthreads();
}

constexpr int NWAVES = 8;
constexpr int CW_BAR = 163840;
constexpr size_t WS_MH = 540 * 1024;
constexpr size_t WS_RT = 544 * 1024;
constexpr size_t WS_WIN = 1 * MiB, WS_WOUT = 5 * MiB, WS_WQKV = 7 * MiB, WS_WO = 13 * MiB, WS_WUP = 15 * MiB  , WS_WDN = 37 * MiB  , WS_WPOOL = 48 * MiB;
static_assert(WS_WPOOL + 131072 <= WS_XB - 4096 && WS_XB + (size_t)T * D * 2 + 512 * 1024 <= WS_R && WS_END <= 256 * MiB, "d_ws map");
constexpr int RING_OFF = 0, RING_BYTES = 131072, LDSCTL_OFF = RING_BYTES, MISC_OFF = LDSCTL_OFF + 320, HALO_OFF = RING_BYTES + 1024, LDS_BYTES = 154624;
static_assert(HALO_OFF + 12288 + 2 * 5120 <= LDS_BYTES, "LDS map");
static_assert(WS_BIAS + 3 * 129 * 16 * 4 <= WS_MH && WS_MH + 64 <= WS_RT && WS_RT + 16 * 3 * 256 * 4 <= (size_t)CW_BAR * 4 && (size_t)CW_BAR * 4 + 11 * 3456 * 4 <= MiB && WS_SSQ + 4 * T * 4 <= WS_BIAS, "control region map");

struct Frame {
    LAS unsigned char* lds; volatile LAS unsigned* MISC; gu32* ctl;
    int tid, lane, wave, vcu, G;
};
struct Args { const float* in[18]; float* out; unsigned char* ws; int ph_lo, ph_hi, li, pad; };

__device__ __forceinline__ int t5_bucket(int dist) {
    if (dist < 16) return dist;
    int b = 16;
    b += dist >= 22; b += dist >= 30; b += dist >= 40; b += dist >= 54; b += dist >= 73; b += dist >= 99; b += dist >= 134; b += dist >= 182;
    b += dist >= 246; b += dist >= 332; b += dist >= 450; b += dist >= 609; b += dist >= 825; b += dist >= 1117; b += dist >= 1513;
    return b;
}
template <bool HAS_K, bool HAS_N, class DstRow>
__device__ __forceinline__ void p0_item(const float* __restrict__ W, int K, int N, bf16* WT, const float* __restrict__ ksc, const float* __restrict__ nsc, LAS float* scr, int item, int lane, DstRow dst) {
    const int nblk = N / 32, kb = item / nblk, nb = item % nblk, k0 = 64 * kb, n0 = 32 * nb;
    const int c = lane & 7;
    const float* wp = W + (size_t)(k0 + (lane >> 5)) * N + n0 + (lane & 31);
    float v[32];
#pragma unroll
    for (int i = 0; i < 32; ++i) v[i] = wp[(size_t)(2 * i) * N];
    float ns = 1.f; f32x4 ka = {1.f, 1.f, 1.f, 1.f}, kb4 = ka;
    if (HAS_N) ns = nsc[n0 + (lane & 31)];
    if (HAS_K) { ka = *(const f32x4*)(ksc + k0 + 8 * c); kb4 = *(const f32x4*)(ksc + k0 + 8 * c + 4); }
#pragma unroll
    for (int i = 0; i < 32; ++i) scr[(2 * i + (lane >> 5)) * 33 + (lane & 31)] = HAS_N ? v[i] * ns : v[i];
    LDS_WAIT(); asm volatile("" ::: "memory");
#pragma unroll
    for (int j = 0; j < 4; ++j) { const int n = (lane >> 3) + 8 * j; const LAS float* s = scr + (8 * c) * 33 + n;
        v4u o; o.x = pk2(s[0 * 33] * ka[0], s[1 * 33] * ka[1]); o.y = pk2(s[2 * 33] * ka[2], s[3 * 33] * ka[3]); o.z = pk2(s[4 * 33] * kb4[0], s[5 * 33] * kb4[1]); o.w = pk2(s[6 * 33] * kb4[2], s[7 * 33] * kb4[3]);
        *(GAS v4u*)(WT + (size_t)dst(n0 + n) * K + k0 + 8 * c) = o; }
    LDS_WAIT(); asm volatile("" ::: "memory");
}
struct DstId { __device__ __forceinline__ int operator()(int n) const { return n; } };
struct DstQkv { __device__ __forceinline__ int operator()(int c) const { const int cl = c & 255; return (c & ~255) + 128 * ((cl & 63) >> 5) + 32 * (cl >> 6) + (cl & 31); } };
struct DstUp { __device__ __forceinline__ int operator()(int c) const { return c < DFF ? 256 * (c >> 7) + (c & 127) : 256 * ((c - DFF) >> 7) + 128 + ((c - DFF) & 127); } };

constexpr int I_IN = 16 * 64, I_OUT = 16 * 32, I_QKV = 16 * 96, I_O = 16 * 32, I_UP = 16 * 176, I_DN = 44 * 32, I_POOL = 2 * 4;
constexpr int IT_POOL = I_IN, IT_OUT = IT_POOL + 4 * I_POOL, IT_UP0 = IT_OUT + I_OUT, IT_DN0 = IT_UP0 + I_UP, IT_QKV = IT_DN0 + I_DN, IT_O = IT_QKV + I_QKV, IT_UP1 = IT_O + I_O, IT_DN1 = IT_UP1 + I_UP, IT_END = IT_DN1 + I_DN;
__device__ __forceinline__ void convert_item(const Args& a, LAS float* scr, int it, int lane) {
    unsigned char* ws = a.ws;
    if (it < IT_POOL) { p0_item<true, false>(a.in[3], D, EVEN_IN, (bf16*)(ws + WS_WIN), a.in[2], nullptr, scr, it, lane, DstId()); return; }
    if (it < IT_OUT) { const int r = it - IT_POOL, g = r / I_POOL; p0_item<false, true>(a.in[5] + (size_t)g * 128 * 128, 128, 128, (bf16*)(ws + WS_WPOOL) + (size_t)g * 128 * 128, nullptr, a.in[6] + g * 128, scr, r - g * I_POOL, lane, DstId()); return; }
    if (it < IT_UP0) { p0_item<false, false>(a.in[7], D, D, (bf16*)(ws + WS_WOUT), nullptr, nullptr, scr, it - IT_OUT, lane, DstId()); return; }
    if (it < IT_DN0) { p0_item<true, false>(a.in[14], D, DFF2, (bf16*)(ws + WS_WUP), a.in[13], nullptr, scr, it - IT_UP0, lane, DstUp()); return; }
    if (it < IT_QKV) { p0_item<false, false>(a.in[17], DFF, D, (bf16*)(ws + WS_WDN), nullptr, nullptr, scr, it - IT_DN0, lane, DstId()); return; }
    if (it < IT_O) { p0_item<true, false>(a.in[9], D, NQKV, (bf16*)(ws + WS_WQKV), a.in[8], nullptr, scr, it - IT_QKV, lane, DstQkv()); return; }
    if (it < IT_UP1) { p0_item<false, false>(a.in[12], D, D, (bf16*)(ws + WS_WO), nullptr, nullptr, scr, it - IT_O, lane, DstId()); return; }
    if (it < IT_DN1) { p0_item<true, false>(a.in[14] + (size_t)D * DFF2, D, DFF2, (bf16*)(ws + WS_WUP) + (size_t)DFF2 * D, a.in[13] + D, nullptr, scr, it - IT_UP1, lane, DstUp()); return; }
    p0_item<false, false>(a.in[17] + (size_t)DFF * D, DFF, D, (bf16*)(ws + WS_WDN) + (size_t)D * DFF, nullptr, nullptr, scr, it - IT_DN1, lane, DstId());
}
struct ConvertWork { const Args* a; LAS unsigned char* lds; int vcu, G, lane, lo, hi;
    __device__ __forceinline__ void operator()(int w7) const { LAS float* scr = (LAS float*)(lds + (w7 + 1) * 16384);
        for (int it = lo + vcu * 7 + w7; it < hi; it += G * 7) convert_item(*a, scr, it, lane); } };
#ifndef CONVERT_IN_SEAMS
#define CONVERT_IN_SEAMS 1
#endif
__device__ __forceinline__ void p0_prologue(Frame& F, const Args& a) {
    unsigned char* ws = a.ws;
    LAS float* scr = (LAS float*)(F.lds + RING_OFF + F.wave * 16384);
    const int gw = F.vcu * NWAVES + F.wave, NGW = F.G * NWAVES;
    const float* x = a.in[0];
    for (int it = gw; it < (CONVERT_IN_SEAMS ? IT_OUT : IT_END); it += NGW) convert_item(a, scr, it, F.lane);
    float* ssq = (float*)(ws + WS_SSQ); bf16* xb = (bf16*)(ws + WS_XB);
    for (int m = gw; m < T; m += NGW) {
        const GAS f32x4* xr = (const GAS f32x4*)(x + (size_t)m * D) + F.lane; f32x4 v[4]; float s = 0.f;
#pragma unroll
        for (int j = 0; j < 4; ++j) { v[j] = xr[64 * j]; s += (v[j].x * v[j].x + v[j].y * v[j].y) + (v[j].z * v[j].z + v[j].w * v[j].w); }
        s = wave_sum(s);
        GAS unsigned long long* o8 = (GAS unsigned long long*)(xb + (size_t)m * D) + F.lane;
#pragma unroll
        for (int j = 0; j < 4; ++j) o8[64 * j] = (unsigned long long)pk2(v[j].x, v[j].y) | ((unsigned long long)pk2(v[j].z, v[j].w) << 32);
        if (F.lane == 0) ssq[m] = s;
    }
    if (gw == NGW - 1) { GAS v4u* p = (GAS v4u*)(ws + WS_XB - 4096); for (int i = F.lane; i < 256; i += 64) p[i] = (v4u){0u, 0u, 0u, 0u}; }
    if (gw < NH) {
        const int h = gw; const float* rel = a.in[1];
        float gqm = fabsf(a.in[10][F.lane]), gkm = fabsf(a.in[11][F.lane]), rb = F.lane < 32 ? rel[F.lane * 16 + h] : -1e30f;
#pragma unroll
        for (int o = 1; o < 64; o <<= 1) { gqm = fmaxf(gqm, __shfl_xor(gqm, o)); gkm = fmaxf(gkm, __shfl_xor(gkm, o)); rb = fmaxf(rb, __shfl_xor(rb, o)); }
        const float Mh = 8.0f * gqm * gkm * LOG2E * 1.02f + rb * LOG2E;
        if (F.lane == 0) ((float*)(ws + WS_MH))[h] = Mh;
        float* rtab = (float*)(ws + WS_RT) + h * 3 * 256;
        for (int i = F.lane; i < 3 * 256; i += 64) { const int br = i / 256, xx = i % 256, jrel = 191 - xx, dil = br == 0 ? 1 : (br == 1 ? 4 : 16);
            rtab[i] = (jrel >= 0 && jrel <= 128) ? rel[t5_bucket(jrel * dil) * 16 + h] * LOG2E - Mh : -1e30f; }
        float* bias = (float*)(ws + WS_BIAS);
        for (int i = F.lane; i < 3 * 129; i += 64) { const int br = i / 129, j = i % 129, dil = br == 0 ? 1 : (br == 1 ? 4 : 16); bias[(br * 129 + j) * 16 + h] = rel[t5_bucket(j * dil) * 16 + h] * LOG2E; }
    }
}


typedef unsigned u32x4_t __attribute__((ext_vector_type(4)));
typedef float f32x2_t __attribute__((ext_vector_type(2))); typedef __bf16 bf16x2_t __attribute__((ext_vector_type(2)));
__device__ __forceinline__ unsigned cvtpk_c(float lo, float hi) { f32x2_t v = {lo, hi}; bf16x2_t b = __builtin_convertvector(v, bf16x2_t); return __builtin_bit_cast(unsigned, b); }
typedef unsigned u32x2_t __attribute__((ext_vector_type(2)));
__device__ __forceinline__ void ld8(const bf16* p, float (&f)[8]) { const u32x4_t v = *(const u32x4_t*)p;
#pragma unroll
    for (int i = 0; i < 4; ++i) { f[2 * i] = __uint_as_float(v[i] << 16); f[2 * i + 1] = __uint_as_float(v[i] & 0xffff0000u); } }
__device__ __forceinline__ u32x4_t pk8(const float (&f)[8]) { u32x4_t w; w.x = pg8::cvt_pk_bf16(f[0], f[1]); w.y = pg8::cvt_pk_bf16(f[2], f[3]); w.z = pg8::cvt_pk_bf16(f[4], f[5]); w.w = pg8::cvt_pk_bf16(f[6], f[7]); return w; }
__device__ __forceinline__ void unpk8(const u32x4_t v, float (&f)[8]) {
#pragma unroll
    for (int i = 0; i < 4; ++i) { f[2 * i] = __uint_as_float(v[i] << 16); f[2 * i + 1] = __uint_as_float(v[i] & 0xffff0000u); } }
template <int K>
__device__ __forceinline__ void pooled_part(const bf16* __restrict__ pin, int tl0, LAS unsigned char* dst, int pitch) {
    u32x4_t hraw[K - 1], araw[8];
#pragma unroll
    for (int j = 1; j < K; ++j) hraw[j - 1] = *(const u32x4_t*)(pin - (size_t)((tl0 - j >= 0) ? j : 0) * EVEN_IN);
#pragma unroll
    for (int i = 0; i < 8; ++i) araw[i] = *(const u32x4_t*)(pin + (size_t)i * EVEN_IN);
    float sm[8];
#pragma unroll
    for (int e = 0; e < 8; ++e) sm[e] = 0.f;
#pragma unroll
    for (int j = 1; j < K; ++j) { const bool ok = tl0 - j >= 0;
#pragma unroll
        for (int q = 0; q < 4; ++q) hraw[j - 1][q] = ok ? hraw[j - 1][q] : 0u;
        float a[8]; unpk8(hraw[j - 1], a);
#pragma unroll
        for (int e = 0; e < 8; ++e) sm[e] += a[e]; }
#pragma unroll
    for (int i = 0; i < 8; ++i) { const int tl = tl0 + i; float a[8], y[8]; unpk8(araw[i], a);
#pragma unroll
        for (int e = 0; e < 8; ++e) sm[e] += a[e];
        const float inv = (tl + 1 >= K) ? (1.0f / (float)K) : __builtin_amdgcn_rcpf((float)(tl + 1));
#pragma unroll
        for (int e = 0; e < 8; ++e) y[e] = sm[e] * inv - a[e];
        *(LAS u32x4_t*)(dst + i * pitch) = pk8(y);
        if (i < 7) { float r[8]; if (i + 1 - K >= 0) unpk8(araw[i + 1 - K >= 0 ? i + 1 - K : 0], r); else unpk8(hraw[(K - 2 - i) >= 0 ? (K - 2 - i) : 0], r);
#pragma unroll
            for (int e = 0; e < 8; ++e) sm[e] -= r[e]; } }
}
__device__ __forceinline__ void mixer_phase(Frame& F, const bf16* __restrict__ proj, const float* __restrict__ cw, const bf16* __restrict__ wpool, bf16* mix) {
    constexpr int PITCH = 1040;
    LAS unsigned char* P = F.lds + RING_OFF;
    const int tid = F.tid, cc = tid & 63, tg = tid >> 6, c0 = 8 * cc;
    for (int u = F.vcu; u < T / 64; u += F.G) {
        const int t0 = u * 64 + 8 * tg; const int tl0 = t0 & (SEQ - 1);
        const bf16* pr = proj + (size_t)t0 * EVEN_IN;
        {
            float w0[8], w1[8], w2[8];
#pragma unroll
            for (int e = 0; e < 8; ++e) { w0[e] = cw[c0 + e]; w1[e] = cw[AW + c0 + e]; w2[e] = cw[2 * AW + c0 + e]; }
            float pm2[8], pm1[8];
#pragma unroll
            for (int e = 0; e < 8; ++e) { pm2[e] = 0.f; pm1[e] = 0.f; }
            if (tl0 >= 2) { float a[8], c[8]; ld8(pr - 2 * EVEN_IN + c0, a); ld8(pr - 2 * EVEN_IN + 2 * AW + c0, c);
#pragma unroll
                for (int e = 0; e < 8; ++e) pm2[e] = a[e] * c[e];
                ld8(pr - EVEN_IN + c0, a); ld8(pr - EVEN_IN + 2 * AW + c0, c);
#pragma unroll
                for (int e = 0; e < 8; ++e) pm1[e] = a[e] * c[e]; }
#pragma unroll
            for (int j = 0; j < 8; ++j) { float a[8], c[8], gb[8], y[8]; ld8(pr + j * EVEN_IN + c0, a); ld8(pr + j * EVEN_IN + 2 * AW + c0, c); ld8(pr + j * EVEN_IN + AW + c0, gb);
#pragma unroll
                for (int e = 0; e < 8; ++e) { const float pc = a[e] * c[e]; y[e] = gb[e] * (w0[e] * pm2[e] + w1[e] * pm1[e] + w2[e] * pc); pm2[e] = pm1[e]; pm1[e] = pc; }
                *(u32x4_t*)(mix + (size_t)(t0 + j) * D + c0) = pk8(y); }
        }
        {
            const int g = F.wave >> 1, tgp = (F.wave & 1) * 4 + (F.lane >> 4), c0p = 8 * (16 * g + (F.lane & 15));
            const int t0p = u * 64 + 8 * tgp, tl0p = t0p & (SEQ - 1);
            const bf16* pin = proj + (size_t)t0p * EVEN_IN + 3 * AW + c0p; LAS unsigned char* dst = P + (8 * tgp) * PITCH + c0p * 2;
            if (g == 0) pooled_part<2>(pin, tl0p, dst, PITCH); else if (g == 1) pooled_part<4>(pin, tl0p, dst, PITCH); else if (g == 2) pooled_part<8>(pin, tl0p, dst, PITCH); else pooled_part<16>(pin, tl0p, dst, PITCH);
        }
        {
            const int g = F.wave >> 1, th = F.wave & 1, fr = F.lane & 15, fq = F.lane >> 4;
            const bf16* wb = wpool + (size_t)g * 128 * 128 + (size_t)fr * 128 + 8 * fq;
            __builtin_amdgcn_sched_barrier(0);
            pg8::bf16x8 bfa[8][4];
#pragma unroll
            for (int n = 0; n < 6; ++n)
#pragma unroll
                for (int ks = 0; ks < 4; ++ks) bfa[n][ks] = *(const pg8::bf16x8*)(wb + (size_t)n * 16 * 128 + 32 * ks);
            __syncthreads();
            pg8::bf16x8 af[2][4];
#pragma unroll
            for (int m = 0; m < 2; ++m)
#pragma unroll
                for (int ks = 0; ks < 4; ++ks) af[m][ks] = *(const LAS pg8::bf16x8*)(P + (32 * th + 16 * m + fr) * PITCH + (128 * g + 32 * ks + 8 * fq) * 2);
#pragma unroll
            for (int n = 6; n < 8; ++n)
#pragma unroll
                for (int ks = 0; ks < 4; ++ks) bfa[n][ks] = *(const pg8::bf16x8*)(wb + (size_t)n * 16 * 128 + 32 * ks);
            bf16* orow = mix + (size_t)(u * 64 + 32 * th + fr) * D + AW + 128 * g + 4 * fq;
#pragma unroll
            for (int n = 0; n < 8; ++n) {
                pg8::f32x4 a0 = {0.f, 0.f, 0.f, 0.f}, a1 = a0;
#pragma unroll
                for (int ks = 0; ks < 4; ++ks) { a0 = __builtin_amdgcn_mfma_f32_16x16x32_bf16(bfa[n][ks], af[0][ks], a0, 0, 0, 0); a1 = __builtin_amdgcn_mfma_f32_16x16x32_bf16(bfa[n][ks], af[1][ks], a1, 0, 0, 0); }
                u32x2_t w; w.x = pg8::cvt_pk_bf16(a0[0], a0[1]); w.y = pg8::cvt_pk_bf16(a0[2], a0[3]); *(u32x2_t*)(orow + 16 * n) = w;
                w.x = pg8::cvt_pk_bf16(a1[0], a1[1]); w.y = pg8::cvt_pk_bf16(a1[2], a1[3]); *(u32x2_t*)(orow + (size_t)16 * D + 16 * n) = w; }
        }
        __syncthreads();
    }
}

namespace att {
constexpr int OPB = 136, VP = 160, NTAB = 256;
constexpr int LDS_TAB = 0, LDS_V = 3 * NTAB * 4, V_BYTES = 32 * VP, LDS_L = LDS_V + 8 * V_BYTES, LDS_O = LDS_L + 2048, LDS_END = LDS_O + 512 * OPB;
static_assert(LDS_V % 16 == 0 && LDS_O % 16 == 0 && LDS_END <= RING_BYTES, "attention LDS map");
typedef short v4i16_t __attribute__((ext_vector_type(4)));
__device__ __forceinline__ v4i16_t vtr(const LAS unsigned char* p) { return __builtin_amdgcn_ds_read_tr16_b64_v4i16((LAS v4i16_t*)p); }
struct KV { pg8::bf16x8 k[2][2]; u32x4_t v[4]; };
__device__ __forceinline__ pg8::f32x4 bf4_to_f32(u32x2_t w) { return (pg8::f32x4){__uint_as_float(w.x << 16), __uint_as_float(w.x & 0xffff0000u), __uint_as_float(w.y << 16), __uint_as_float(w.y & 0xffff0000u)}; }
template <int MODE, int SH, bool CLAMP, int NT>
__device__ __forceinline__ void item(const bf16* __restrict__ qkv, bf16* __restrict__ ao, LAS unsigned char* lds, int wave, int lane, int b, int h, int p0, int rel) {
    constexpr int DIL = 1 << SH, NS = 4 + NT / 2;
    { int l_ = threadIdx.x & 63; asm volatile("" : "+v"(l_)); lane = l_; }
    const int q = lane & 15, g4 = lane >> 4;
    const int base_pos = p0 + rel, res = base_pos & (DIL - 1), i0 = base_pos >> SH, kmin = 128 - i0;
    const size_t rowbase = (size_t)b * SEQ;
    const bf16* hq = qkv + (size_t)(b * NH + h) * SEQ * HD;
    const bf16* qp = hq + (size_t)(base_pos + DIL * q) * HD + 8 * g4;
    pg8::bf16x8 qf[NT][2];
#pragma unroll
    for (int t = 0; t < NT; ++t) { qf[t][0] = *(const pg8::bf16x8*)(qp + (size_t)t * 16 * DIL * HD); qf[t][1] = *(const pg8::bf16x8*)(qp + (size_t)t * 16 * DIL * HD + 32); }
    const bf16* kbase = hq + (size_t)T * D + 8 * g4;
    const bf16* vbase = hq + (size_t)2 * T * D + 8 * (lane & 7);
    LAS unsigned char* vbuf = lds + LDS_V + wave * V_BYTES;
    LAS unsigned char* vw = vbuf + (lane >> 3) * VP + (lane & 7) * 16;
    const LAS unsigned char* vr = vbuf + (4 * g4 + (q >> 2)) * VP + (q & 3) * 8;
    const LAS float* tab = (const LAS float*)(lds + LDS_TAB) + (SH == 4 ? 2 : (SH == 2 ? 1 : 0)) * NTAB + (15 - q + 4 * g4);
    asm volatile("" : "+v"(tab), "+v"(vw), "+v"(vr));
    pg8::f32x4 o[NT][4]; float lsum[NT];
#pragma unroll
    for (int t = 0; t < NT; ++t) { lsum[t] = 0.f;
#pragma unroll
        for (int dt = 0; dt < 4; ++dt) o[t][dt] = (pg8::f32x4){0.f, 0.f, 0.f, 0.f}; }
    const char* kb_u = (const char*)(hq + (size_t)T * D); const char* vb_u = (const char*)(hq + (size_t)2 * T * D);
    const unsigned koff0 = (unsigned)(((res + ((i0 - 128 + q) << SH)) * HD + 8 * g4) * 2);
    const unsigned voff0 = (unsigned)(((res + ((i0 - 128 + (lane >> 3)) << SH)) * HD + 8 * (lane & 7)) * 2);
    auto load = [&](int st, KV& d) {
#pragma unroll
        for (int j = 0; j < 2; ++j) { const char* kp;
            if (CLAMP) { int ik = i0 - 128 + 32 * st + 16 * j + q; ik = ik < 0 ? 0 : ik; kp = kb_u + (size_t)(unsigned)(((res + (ik << SH)) * HD + 8 * g4) * 2); }
            else kp = kb_u + (size_t)(((32 * st + 16 * j) << SH) * HD * 2) + (size_t)koff0;
            d.k[j][0] = *(const pg8::bf16x8*)kp; d.k[j][1] = *(const pg8::bf16x8*)(kp + 64); }
#pragma unroll
        for (int i = 0; i < 4; ++i) { const char* vp;
            if (CLAMP) { int ik = i0 - 128 + 32 * st + 8 * i + (lane >> 3); ik = ik < 0 ? 0 : ik; vp = vb_u + (size_t)(unsigned)(((res + (ik << SH)) * HD + 8 * (lane & 7)) * 2); }
            else vp = vb_u + (size_t)(((32 * st + 8 * i) << SH) * HD * 2) + (size_t)voff0;
            d.v[i] = *(const u32x4_t*)vp; }
    };
    KV cur; load(0, cur);
#pragma unroll
    for (int st = 0; st < NS; ++st) {
#pragma unroll
        for (int i = 0; i < 4; ++i) *(LAS u32x4_t*)(vw + 8 * i * VP) = cur.v[i];
        asm volatile("" ::: "memory");
        KV nxt; if (st < NS - 1) { load(st + 1, nxt); __builtin_amdgcn_sched_barrier(0); }
        pg8::bf16x8 pb[NT];
        const LAS float* tabs = tab + 32 * st; asm volatile("" : "+v"(tabs));
#pragma unroll
        for (int t = 0; t < NT; ++t) { pg8::f32x4 sT[2];
            const LAS float* tabt = tabs + 16 * (3 - t); if (NT > 2) asm volatile("" : "+v"(tabt));
#pragma unroll
            for (int j = 0; j < 2; ++j) { if (2 * st + j >= t && 2 * st + j <= t + 8) {
                const pg8::f32x4 bias4 = (pg8::f32x4){tabt[16 * j], tabt[16 * j + 1], tabt[16 * j + 2], tabt[16 * j + 3]};
                sT[j] = __builtin_amdgcn_mfma_f32_16x16x32_bf16(cur.k[j][0], qf[t][0], bias4, 0, 0, 0);
                sT[j] = __builtin_amdgcn_mfma_f32_16x16x32_bf16(cur.k[j][1], qf[t][1], sT[j], 0, 0, 0); } }
            float p[2][4];
#pragma unroll
            for (int j = 0; j < 2; ++j)
#pragma unroll
                for (int r = 0; r < 4; ++r) { if (2 * st + j >= t && 2 * st + j <= t + 8) { const int kk = 32 * st + 16 * j + 4 * g4 + r; float sv = sT[j][r]; if (CLAMP) sv = kk < kmin ? -1e30f : sv;
                    p[j][r] = __builtin_amdgcn_exp2f(sv); lsum[t] += p[j][r]; } else p[j][r] = 0.f; }
            u32x4_t pw; pw.x = cvtpk_c(p[0][0], p[0][1]); pw.y = cvtpk_c(p[0][2], p[0][3]); pw.z = cvtpk_c(p[1][0], p[1][1]); pw.w = cvtpk_c(p[1][2], p[1][3]);
            pb[t] = __builtin_bit_cast(pg8::bf16x8, pw); if (NT > 2) { asm volatile("" : "+v"(lsum[t])); __builtin_amdgcn_sched_barrier(0); } }
#pragma unroll
        for (int dt = 0; dt < 4; ++dt) { const v4i16_t lo = vtr(vr + dt * 32), hi = vtr(vr + 16 * VP + dt * 32);
            const pg8::bf16x8 va = (pg8::bf16x8){lo[0], lo[1], lo[2], lo[3], hi[0], hi[1], hi[2], hi[3]};
#pragma unroll
            for (int t = 0; t < NT; ++t) if (2 * st + 1 >= t && 2 * st <= t + 8) o[t][dt] = __builtin_amdgcn_mfma_f32_16x16x32_bf16(va, pb[t], o[t][dt], 0, 0, 0); }
        asm volatile("" ::: "memory"); __builtin_amdgcn_sched_barrier(0);
        if (st < NS - 1) cur = nxt;
    }
#pragma unroll
    for (int t = 0; t < NT; ++t) { float ls = lsum[t]; ls += __shfl_xor(ls, 16); ls += __shfl_xor(ls, 32);
        const int posu = rel + DIL * (16 * t + q), slot = (posu & ~0xF) | ((posu ^ (posu >> 4)) & 0xF);
        LAS unsigned char* Ol = lds + LDS_O + slot * OPB + 8 * g4; LAS float* Ll = (LAS float*)(lds + LDS_L) + slot;
        if (MODE == 0) {
#pragma unroll
            for (int dt = 0; dt < 4; ++dt) { u32x2_t w; w.x = cvtpk_c(o[t][dt][0], o[t][dt][1]); w.y = cvtpk_c(o[t][dt][2], o[t][dt][3]); *(LAS u32x2_t*)(Ol + 32 * dt) = w; }
            if (g4 == 0) *Ll = ls;
        } else if (MODE == 1) {
#pragma unroll
            for (int dt = 0; dt < 4; ++dt) { const pg8::f32x4 v = bf4_to_f32(*(LAS u32x2_t*)(Ol + 32 * dt)) + o[t][dt]; u32x2_t w; w.x = cvtpk_c(v[0], v[1]); w.y = cvtpk_c(v[2], v[3]); *(LAS u32x2_t*)(Ol + 32 * dt) = w; }
            if (g4 == 0) *Ll = *Ll + ls;
        } else {
            const float inv = 1.0f / (*Ll + ls);
            bf16* op = ao + (rowbase + p0 + posu) * D + h * HD + 4 * g4;
#pragma unroll
            for (int dt = 0; dt < 4; ++dt) { const pg8::f32x4 v = (bf4_to_f32(*(LAS u32x2_t*)(Ol + 32 * dt)) + o[t][dt]) * inv;
                u32x2_t w; w.x = cvtpk_c(v[0], v[1]); w.y = cvtpk_c(v[2], v[3]); *(u32x2_t*)(op + 16 * dt) = w; }
        }
    }
}
}
__device__ __forceinline__ void attn_phase(Frame& F, const bf16* qkv, const float* rt, bf16* ao) {
    LAS unsigned char* lds = F.lds + RING_OFF;
    const int nunits = BATCH * NH * (SEQ / 512);
    for (int i = 0; i * F.G < nunits; ++i) {
        int bh, blk;
        if (F.G == 256) { const int x = F.vcu >> 5, loc = F.vcu & 31; bh = 8 * x + 4 * i + (loc >> 3); blk = loc & 7; }
        else { const int u = i * F.G + F.vcu; if (u >= nunits) break; bh = u >> 3; blk = u & 7; }
        const int b = bh / NH, h = bh % NH, p0 = blk * 512;
        for (int j = F.tid; j < 3 * att::NTAB; j += NWAVES * 64) ((LAS float*)(lds + att::LDS_TAB))[j] = rt[h * 3 * att::NTAB + j];
        __syncthreads();
#pragma unroll 1
        for (int k = 0; k < 2; ++k) { const int g = 2 * F.wave + k;
            if (((p0 + g) >> 4) < 128) att::item<0, 4, true, 2>(qkv, ao, lds, F.wave, F.lane, b, h, p0, g); else att::item<0, 4, false, 2>(qkv, ao, lds, F.wave, F.lane, b, h, p0, g); }
        __syncthreads();
        { const int g = F.wave; const int rel = 256 * (g >> 2) + (g & 3);
            if (((p0 + rel) >> 2) < 128) { att::item<1, 2, true, 2>(qkv, ao, lds, F.wave, F.lane, b, h, p0, rel); att::item<1, 2, true, 2>(qkv, ao, lds, F.wave, F.lane, b, h, p0, rel + 128); }
            else att::item<1, 2, false, 4>(qkv, ao, lds, F.wave, F.lane, b, h, p0, rel); }
        __syncthreads();
        { const int rel = 64 * F.wave;
            if ((p0 + rel) < 128) { att::item<2, 0, true, 2>(qkv, ao, lds, F.wave, F.lane, b, h, p0, rel); att::item<2, 0, true, 2>(qkv, ao, lds, F.wave, F.lane, b, h, p0, rel + 32); }
            else att::item<2, 0, false, 4>(qkv, ao, lds, F.wave, F.lane, b, h, p0, rel); }
        __syncthreads();
    }
}

__global__ void __launch_bounds__(NWAVES * 64, 2) mega_fwd(Args args) {
    extern __shared__ __attribute__((aligned(16))) unsigned char lds[];
    Frame F;
    F.lds = (LAS unsigned char*)lds; F.MISC = (volatile LAS unsigned*)(F.lds + MISC_OFF);
    F.tid = threadIdx.x; F.lane = F.tid & 63; F.wave = __builtin_amdgcn_readfirstlane(F.tid >> 6);
    F.G = gridDim.x; { const int bx = blockIdx.x; F.vcu = (F.G % 8 == 0) ? (bx % 8) * (F.G / 8) + bx / 8 : bx; }
    unsigned char* ws = args.ws; F.ctl = (gu32*)(ws + WS_CTL);
    for (int u = F.tid; u < (LDS_BYTES - LDSCTL_OFF) / 4; u += NWAVES * 64) ((LAS unsigned*)(F.lds + LDSCTL_OFF))[u] = 0u;
    __syncthreads();
    const int lo = args.ph_lo, hi = args.ph_hi; const bool use_bar = (hi - lo) > 1;
    XcdBarrier bar; bar.bar = (unsigned*)(F.ctl + CW_BAR) + args.li * XCD_BAR_WORDS; bar.x = 0; bar.st = nullptr;
    if (use_bar) bar = xcd_barrier_post((unsigned*)(F.ctl + CW_BAR) + args.li * XCD_BAR_WORDS, F.MISC + 8);
#ifndef PHASES_COMPILED
#define PHASES_COMPILED 0x7FF
#endif
#define IN(k) ((((PHASES_COMPILED) >> (k)) & 1) && lo <= (k) && (k) < hi)
#ifndef REP_MASK
#define REP_MASK 0
#endif
#define REPS(k) for (int rep_ = 0; rep_ < ((((REP_MASK) >> (k)) & 1) ? 2 : 1); ++rep_)
#ifndef SEAM_REPS
#define SEAM_REPS 1
#endif
#define SEAM_WORK(k, lo_, hi_) do { if (IN(k) && IN((k) + 1)) { if (CONVERT_IN_SEAMS) { ConvertWork cw_{&args, F.lds + RING_OFF, F.vcu, F.G, F.lane, (lo_), (hi_)}; xcd_barrier_work(bar, F.wave, cw_); } else xcd_barrier(bar); } } while (0)
#define SEAM_PLAIN(k) do { if (IN(k) && IN((k) + 1)) { for (int sr_ = 0; sr_ < SEAM_REPS; ++sr_) xcd_barrier(bar); } } while (0)
constexpr int CHUNK = (IT_END - IT_OUT + 7) / 8;
static_assert(IT_UP0 <= IT_OUT + 2 * CHUNK && IT_DN0 <= IT_OUT + 3 * CHUNK && IT_QKV <= IT_OUT + 4 * CHUNK && IT_O <= IT_OUT + 5 * CHUNK && IT_UP1 <= IT_OUT + 7 * CHUNK && IT_DN1 <= IT_OUT + 8 * CHUNK, "conversion deadlines");
#define SEAM(k) do { if ((k) < 8) SEAM_WORK(k, IT_OUT + (k) * CHUNK, (IT_OUT + ((k) + 1) * CHUNK) < IT_END ? (IT_OUT + ((k) + 1) * CHUNK) : IT_END); else SEAM_PLAIN(k); } while (0)
    float* ssq = (float*)(ws + WS_SSQ); float* out = args.out;
    bf16* xb = (bf16*)(ws + WS_XB); bf16* proj = (bf16*)(ws + WS_PROJ); bf16* mix = (bf16*)(ws + WS_MIX); bf16* qkv = (bf16*)(ws + WS_QKV); bf16* ao = (bf16*)(ws + WS_AO); bf16* act = (bf16*)(ws + WS_ACT);
    PG8_LAS unsigned char* ring = F.lds + RING_OFF;

    if (IN(0)) REPS(0) { p0_prologue(F, args); } SEAM(0);
    if (IN(1)) REPS(1) { pg8::Gemm g{xb, (const bf16*)(ws + WS_WIN), T, EVEN_IN, D}; pg8::StaticOrder S; S.init(T, EVEN_IN, F.G, (int)blockIdx.x);
        pg8::EpiRowScale E{proj, EVEN_IN, ssq};
        pg8::gemm_phase<pg8::EpiRowScale, pg8::StaticOrder, true, true>(ring, g, S, E); } SEAM(1);
    if (IN(2)) REPS(2) { mixer_phase(F, proj, args.in[4], (const bf16*)(ws + WS_WPOOL), mix); } SEAM(2);
#define PHASE_UP(pu, l) do { if (IN(pu)) REPS(pu) { pg8::Gemm g{xb, (const bf16*)(ws + WS_WUP) + (size_t)(l) * DFF2 * D, 68 * 256, DFF2, D}; pg8::OverlapOrder S; S.init(68 * 256, DFF2, F.G, (int)blockIdx.x); \
        pg8::EpiConvGlu E{act, ssq + ((l) == 0 ? T : 3 * T), args.in[15] + (size_t)(l) * 3 * DFF2, args.in[16] + (size_t)(l) * DFF2, (PG8_LAS float*)(F.lds + HALO_OFF)}; \
        pg8::gemm_phase<pg8::EpiConvGlu, pg8::OverlapOrder, true, true>(ring, g, S, E); } SEAM(pu); } while (0)
#define PHASE_RES(p, BF, OF, OX, SQ, Aptr, Wptr, Kdim, basefptr, outfptr, xbptr, ssqptr) do { if (IN(p)) { pg8::Gemm g{(Aptr), (Wptr), T, D, (Kdim)}; pg8::StaticOrder S; S.init(T, D, F.G, (int)blockIdx.x); \
        typedef pg8::EpiResidual<BF, OF, OX, SQ> Epi_; Epi_ E{(basefptr), xb, (outfptr), (xbptr), (ssqptr)}; \
        pg8::gemm_phase<Epi_, pg8::StaticOrder, false, true>(ring, g, S, E); } SEAM(p); } while (0)
    PHASE_RES(3, false, false, true, true, mix, (const bf16*)(ws + WS_WOUT), D, (const float*)nullptr, (float*)nullptr, xb, ssq + T);
    PHASE_UP(4, 0);
    PHASE_RES(5, false, false, true, true, act, (const bf16*)(ws + WS_WDN), DFF, (const float*)nullptr, (float*)nullptr, xb, ssq + 2 * T);
    if (IN(6)) REPS(6) { pg8::Gemm g{xb, (const bf16*)(ws + WS_WQKV), T, NQKV, D}; pg8::StaticOrder S; S.init(T, NQKV, F.G, (int)blockIdx.x);
        pg8::EpiQkv E{qkv, ssq + 2 * T, args.in[10], args.in[11]};
        pg8::gemm_phase<pg8::EpiQkv, pg8::StaticOrder, true, true>(ring, g, S, E); } SEAM(6);
    if (IN(7)) REPS(7) { attn_phase(F, qkv, (const float*)(ws + WS_RT), ao); } SEAM(7);
    PHASE_RES(8, false, false, true, true, ao, (const bf16*)(ws + WS_WO), D, (const float*)nullptr, (float*)nullptr, xb, ssq + 3 * T);
    PHASE_UP(9, 1);
    PHASE_RES(10, false, true, false, false, act, (const bf16*)(ws + WS_WDN) + (size_t)D * DFF, DFF, (const float*)nullptr, out, (bf16*)nullptr, (float*)nullptr);
#undef IN
#undef SEAM
}

#ifndef FAST_MASK
#define FAST_MASK 0x7FF
#endif
extern "C" void kernel_launch(void* const* d_in, const int* in_sizes, int n_in, void* d_out, int out_size, void* d_ws, size_t ws_size, hipStream_t stream) {
    static int grid = 0;
    if (grid == 0) {
        if (n_in != 18 || out_size != T * D || ws_size < WS_END) { fprintf(stderr, "kernel_launch: unexpected shapes n_in %d out %d ws %zu\n", n_in, out_size, ws_size); grid = -1; return; }
        int dev = 0, cus = 0;
        if (hipGetDevice(&dev) != hipSuccess || hipDeviceGetAttribute(&cus, hipDeviceAttributeMultiprocessorCount, dev) != hipSuccess) { grid = -1; return; }
        if (hipFuncSetAttribute((const void*)mega_fwd, hipFuncAttributeMaxDynamicSharedMemorySize, LDS_BYTES) != hipSuccess) { fprintf(stderr, "kernel_launch: hipFuncSetAttribute failed\n"); grid = -1; return; }
        (void)hipFuncSetAttribute((const void*)n_gemm_rowscale, hipFuncAttributeMaxDynamicSharedMemorySize, 18 * 4096);
        (void)hipFuncSetAttribute((const void*)n_gemm_residual, hipFuncAttributeMaxDynamicSharedMemorySize, 18 * 4096);
        (void)hipFuncSetAttribute((const void*)n_ffn_up, hipFuncAttributeMaxDynamicSharedMemorySize, 18 * 4096);
        (void)hipFuncSetAttribute((const void*)n_qkv, hipFuncAttributeMaxDynamicSharedMemorySize, 18 * 4096);
        (void)hipGetLastError();
        grid = cus;
    }
    if (grid < 0) return;
    const float* x = (const float*)d_in[0];
    const float* even_norm = (const float*)d_in[2]; const float* w_in = (const float*)d_in[3]; const float* even_cw = (const float*)d_in[4];
    const float* pool_w = (const float*)d_in[5]; const float* pool_s = (const float*)d_in[6]; const float* w_out = (const float*)d_in[7];
    const float* odd_norm = (const float*)d_in[8]; const float* w_qkv = (const float*)d_in[9]; const float* gq = (const float*)d_in[10]; const float* gk = (const float*)d_in[11];
    const float* w_o = (const float*)d_in[12]; const float* ffn_norm = (const float*)d_in[13]; const float* w_up = (const float*)d_in[14];
    const float* ffn_cw = (const float*)d_in[15]; const float* ffn_cb = (const float*)d_in[16]; const float* w_dn = (const float*)d_in[17];
    unsigned char* ws = (unsigned char*)d_ws; float* out = (float*)d_out;
    float* ssq = (float*)(ws + WS_SSQ); float* bias = (float*)(ws + WS_BIAS);
    bf16_t* xb = (bf16_t*)(ws + WS_XB); bf16_t* proj = (bf16_t*)(ws + WS_PROJ); bf16_t* mix = (bf16_t*)(ws + WS_MIX);
    bf16_t* qkv = (bf16_t*)(ws + WS_QKV); bf16_t* ao = (bf16_t*)(ws + WS_AO); bf16_t* act = (bf16_t*)(ws + WS_ACT);
    const size_t LDSB = 18 * 4096;
    (void)hipMemsetAsync(ws + WS_CTL, 0, 1 * MiB, stream);
    Args a{};
    for (int i = 0; i < 18; ++i) a.in[i] = (const float*)d_in[i];
    a.out = out; a.ws = ws;
    const unsigned fast = FAST_MASK;
    int p = 0, li = 0;
    while (p < 11) {
        if ((fast >> p) & 1u) {
            int q = p; while (q < 11 && ((fast >> q) & 1u)) ++q;
            a.ph_lo = p; a.ph_hi = q; a.li = li++;
            hipLaunchKernelGGL(mega_fwd, dim3(grid), dim3(NWAVES * 64), LDS_BYTES, stream, a);
            p = q; continue;
        }
        switch (p) {
            case 0: n_prologue<<<T / 4, 256, 0, stream>>>(x, ssq, xb); n_bias<<<(3 * 129 * 16 + 255) / 256, 256, 0, stream>>>((const float*)d_in[1], bias); break;
            case 1: n_gemm_rowscale<<<dim3(EVEN_IN / 256, T / 16), 256, LDSB, stream>>>(xb, even_norm, w_in, EVEN_IN, D, ssq, proj); break;
            case 2: n_mixer<<<T / 16, 512, 0, stream>>>(proj, even_cw, pool_w, pool_s, mix); break;
            case 3: n_gemm_residual<<<dim3(D / 256, T / 16), 256, LDSB, stream>>>(mix, w_out, D, x, out, xb, ssq + T); break;
            case 4: n_ffn_up<<<dim3(DFF / 256, T / 16), 256, LDSB, stream>>>(xb, ffn_norm, w_up, ssq + T, ffn_cw, ffn_cb, act); break;
            case 5: n_gemm_residual<<<dim3(D / 256, T / 16), 256, LDSB, stream>>>(act, w_dn, DFF, out, out, xb, ssq + 2 * T); break;
            case 6: n_qkv<<<dim3(NQKV / 256, T / 16), 256, LDSB, stream>>>(xb, odd_norm, w_qkv, ssq + 2 * T, gq, gk, qkv); break;
            case 7: n_attn<<<T * NH / 4, 256, 0, stream>>>(qkv, bias, ao); break;
            case 8: n_gemm_residual<<<dim3(D / 256, T / 16), 256, LDSB, stream>>>(ao, w_o, D, out, out, xb, ssq + 3 * T); break;
            case 9: n_ffn_up<<<dim3(DFF / 256, T / 16), 256, LDSB, stream>>>(xb, ffn_norm + D, w_up + (size_t)D * DFF2, ssq + 3 * T, ffn_cw + 3 * DFF2, ffn_cb + DFF2, act); break;
            case 10: n_gemm_residual<<<dim3(D / 256, T / 16), 256, LDSB, stream>>>(act, w_dn + (size_t)DFF * D, DFF, out, out, nullptr, nullptr); break;
        }
        ++p;
    }
}
```

```cpp
#include <hip/hip_runtime.h>
#include <cstdio>
#include <cstdint>

typedef unsigned short bf16_t;
constexpr int BATCH = 4, SEQ = 4096, D = 1024, T = BATCH * SEQ;
constexpr int EVEN_IN = 2048, AW = 512, DFF = 2816, DFF2 = 5632, NH = 16, HD = 64, NQKV = 3072;
constexpr float EPS = 1e-6f;
constexpr float LOG2E = 1.4426950408889634f;

__device__ __forceinline__ float bf2f(bf16_t v) { return __uint_as_float((unsigned)v << 16); }
__device__ __forceinline__ bf16_t f2bf(float f) { unsigned u = __float_as_uint(f); return (bf16_t)((u + 0x7fffu + ((u >> 16) & 1u)) >> 16); }
__device__ __forceinline__ float wave_sum(float v) {
#pragma unroll
    for (int o = 1; o < 64; o <<= 1) v += __shfl_xor(v, o);
    return v;
}

constexpr size_t MiB = 1u << 20;
constexpr size_t WS_CTL = 0;
constexpr size_t WS_SSQ = 64 * 1024;
constexpr size_t WS_BIAS = 512 * 1024;
constexpr size_t WS_XB = 50 * MiB;
constexpr size_t WS_R = 84 * MiB;
constexpr size_t WS_PROJ = WS_R;
constexpr size_t WS_MIX = WS_R + 96 * MiB;
constexpr size_t WS_QKV = WS_R;
constexpr size_t WS_AO = WS_R + 96 * MiB;
constexpr size_t WS_ACT = WS_R;
constexpr size_t WS_END = WS_R + 128 * MiB;

__global__ void __launch_bounds__(256) n_prologue(const float* __restrict__ x, float* ssq, bf16_t* xb) {
    const int wave = (blockIdx.x * 256 + threadIdx.x) >> 6, lane = threadIdx.x & 63;
    if (wave >= T) return;
    const float* xr = x + (size_t)wave * D; float s = 0.f;
    for (int j = lane; j < D; j += 64) { float v = xr[j]; s += v * v; xb[(size_t)wave * D + j] = f2bf(v); }
    s = wave_sum(s);
    if (lane == 0) ssq[wave] = s;
}
__global__ void n_bias(const float* __restrict__ rel, float* bias) {
    const int i = blockIdx.x * blockDim.x + threadIdx.x;
    if (i >= 3 * 129 * 16) return;
    const int h = i % 16, j = (i / 16) % 129, br = i / (16 * 129);
    const int dil = br == 0 ? 1 : (br == 1 ? 4 : 16);
    const int dist = j * dil; int b;
    if (dist < 16) b = dist; else { int l = 16 + (int)(log((double)dist / 16.0) / log(128.0) * 16.0); b = l < 31 ? l : 31; }
    bias[i] = rel[b * 16 + h] * LOG2E;
}

template <int NR>
__device__ __forceinline__ void naive_tile(const bf16_t* __restrict__ A, int K, const int* rows, const float* __restrict__ g,
                                           const float* __restrict__ W, int N, int col, float* acc, float* sA  ) {
    for (int r = 0; r < NR; ++r) acc[r] = 0.f;
    for (int k0 = 0; k0 < K; k0 += 1024) {
        const int kc = (K - k0) < 1024 ? (K - k0) : 1024;
        __syncthreads();
        for (int i = threadIdx.x; i < NR * kc; i += 256) { const int r = i / kc, k = i % kc; const int row = rows[r];
            float v = row >= 0 ? bf2f(A[(size_t)row * K + k0 + k]) : 0.f; if (g) v *= g[k0 + k]; sA[r * 1024 + k] = v; }
        __syncthreads();
        for (int k = 0; k < kc; k += 4) {
            const float w0 = W[(size_t)(k0 + k) * N + col], w1 = W[(size_t)(k0 + k + 1) * N + col], w2 = W[(size_t)(k0 + k + 2) * N + col], w3 = W[(size_t)(k0 + k + 3) * N + col];
#pragma unroll
            for (int r = 0; r < NR; ++r) { const float4 a = *(const float4*)(sA + r * 1024 + k); acc[r] += a.x * w0 + a.y * w1 + a.z * w2 + a.w * w3; }
        }
    }
}

__global__ void __launch_bounds__(256) n_gemm_rowscale(const bf16_t* __restrict__ A, const float* __restrict__ g, const float* __restrict__ W, int N, int K,
                                                        const float* __restrict__ ssq, bf16_t* out) {
    extern __shared__ float sA[];
    __shared__ int rows[16];
    const int row0 = blockIdx.y * 16, col = blockIdx.x * 256 + threadIdx.x;
    if (threadIdx.x < 16) rows[threadIdx.x] = row0 + threadIdx.x;
    __syncthreads();
    float acc[16];
    naive_tile<16>(A, K, rows, g, W, N, col, acc, sA);
    for (int r = 0; r < 16; ++r) { const float rs = rsqrtf(ssq[row0 + r] * (1.f / D) + EPS); out[(size_t)(row0 + r) * N + col] = f2bf(acc[r] * rs); }
}
__global__ void __launch_bounds__(256) n_gemm_residual(const bf16_t* __restrict__ A, const float* __restrict__ W, int K,
                                                        const float* base, float* out, bf16_t* xb, float* ssq_next) {
    extern __shared__ float sA[];
    __shared__ int rows[16];
    const int row0 = blockIdx.y * 16, col = blockIdx.x * 256 + threadIdx.x;
    if (threadIdx.x < 16) rows[threadIdx.x] = row0 + threadIdx.x;
    __syncthreads();
    float acc[16];
    naive_tile<16>(A, K, rows, nullptr, W, D, col, acc, sA);
    for (int r = 0; r < 16; ++r) { const size_t o = (size_t)(row0 + r) * D + col; const float v = base[o] + acc[r]; out[o] = v;
        if (xb) xb[o] = f2bf(v);
        if (ssq_next) { const float s = wave_sum(v * v); if ((threadIdx.x & 63) == 0) atomicAdd(ssq_next + row0 + r, s); } }
}
__global__ void __launch_bounds__(256) n_ffn_up(const bf16_t* __restrict__ A, const float* __restrict__ g, const float* __restrict__ W,
                                                 const float* __restrict__ ssq, const float* __restrict__ cw, const float* __restrict__ cb, bf16_t* act) {
    extern __shared__ float sA[];
    __shared__ int rows[18];
    const int row0 = blockIdx.y * 16, c = blockIdx.x * 256 + threadIdx.x;
    if (threadIdx.x < 18) { const int r = row0 - 2 + threadIdx.x; rows[threadIdx.x] = ((row0 % SEQ) == 0 && threadIdx.x < 2) ? -1 : r; }
    __syncthreads();
    float ag[18], au[18];
    naive_tile<18>(A, D, rows, g, W, DFF2, c, ag, sA);
    naive_tile<18>(A, D, rows, g, W, DFF2, c + DFF, au, sA);
    for (int r = 0; r < 18; ++r) { const float rs = rows[r] >= 0 ? rsqrtf(ssq[rows[r]] * (1.f / D) + EPS) : 0.f; ag[r] *= rs; au[r] *= rs; }
    const float g0 = cw[c], g1 = cw[DFF2 + c], g2 = cw[2 * DFF2 + c], gb = cb[c];
    const float u0 = cw[c + DFF], u1 = cw[DFF2 + c + DFF], u2 = cw[2 * DFF2 + c + DFF], ub = cb[c + DFF];
    for (int r = 0; r < 16; ++r) {
        const float gt = g0 * ag[r] + g1 * ag[r + 1] + g2 * ag[r + 2] + gb;
        const float ut = u0 * au[r] + u1 * au[r + 1] + u2 * au[r + 2] + ub;
        const float s = gt / (1.f + __expf(-gt));
        act[(size_t)(row0 + r) * DFF + c] = f2bf(s * ut);
    }
}
__global__ void __launch_bounds__(256) n_qkv(const bf16_t* __restrict__ A, const float* __restrict__ g, const float* __restrict__ W,
                                              const float* __restrict__ ssq, const float* __restrict__ gq, const float* __restrict__ gk, bf16_t* qkv) {
    extern __shared__ float sA[];
    __shared__ int rows[16];
    const int row0 = blockIdx.y * 16, col = blockIdx.x * 256 + threadIdx.x;
    if (threadIdx.x < 16) rows[threadIdx.x] = row0 + threadIdx.x;
    __syncthreads();
    float acc[16];
    naive_tile<16>(A, D, rows, g, W, NQKV, col, acc, sA);
    const int part = col / D;
    for (int r = 0; r < 16; ++r) {
        const float rs = rsqrtf(ssq[row0 + r] * (1.f / D) + EPS); float y = acc[r] * rs;
        if (part < 2) { const float ms = wave_sum(y * y) * (1.f / HD); y = y * rsqrtf(ms + EPS) * (part == 0 ? gq[col & 63] * (0.125f * LOG2E) : gk[col & 63]); }
        qkv[(size_t)(row0 + r) * NQKV + col] = f2bf(y);
    }
}
__global__ void __launch_bounds__(512) n_mixer(const bf16_t* __restrict__ proj, const float* __restrict__ cw, const float* __restrict__ pw,
                                                const float* __restrict__ ps, bf16_t* mix) {
    __shared__ float pooled[16][512];
    const int t0 = blockIdx.x * 16, c = threadIdx.x;
    for (int r = 0; r < 16; ++r) {
        const int t = t0 + r, tl = t % SEQ;
        float conv = 0.f;
        for (int i = 0; i < 3; ++i) { const int tt = tl - 2 + i; if (tt >= 0) { const size_t o = (size_t)(t - 2 + i) * EVEN_IN; conv += cw[i * AW + c] * (bf2f(proj[o + 2 * AW + c]) * bf2f(proj[o + c])); } }
        const float ya = bf2f(proj[(size_t)t * EVEN_IN + AW + c]) * conv;
        mix[(size_t)t * D + c] = f2bf(ya);
        const int gI = c >> 7, k = 2 << gI; const int cnt = (tl + 1) < k ? (tl + 1) : k; float s = 0.f;
        for (int j = 0; j < cnt; ++j) s += bf2f(proj[(size_t)(t - j) * EVEN_IN + 3 * AW + c]);
        pooled[r][c] = s / (float)cnt - bf2f(proj[(size_t)t * EVEN_IN + 3 * AW + c]);
    }
    __syncthreads();
    const int gI = c >> 7, d = c & 127;
    float acc[16];
    for (int r = 0; r < 16; ++r) acc[r] = 0.f;
    for (int cc = 0; cc < 128; ++cc) { const float w = pw[(size_t)(gI * 128 + cc) * 128 + d];
        for (int r = 0; r < 16; ++r) acc[r] += pooled[r][gI * 128 + cc] * w; }
    for (int r = 0; r < 16; ++r) mix[(size_t)(t0 + r) * D + AW + c] = f2bf(acc[r] * ps[c]);
}
__global__ void __launch_bounds__(256) n_attn(const bf16_t* __restrict__ qkv, const float* __restrict__ bias, bf16_t* ao) {
    __shared__ float sp[4][3 * 129 + 5];
    __shared__ float sq[4][64];
    const int w = threadIdx.x >> 6, lane = threadIdx.x & 63;
    const int item = blockIdx.x * 4 + w; const int t = item / NH, h = item % NH; const int tl = t % SEQ;
    sq[w][lane] = bf2f(qkv[(size_t)t * NQKV + h * HD + lane]);
    __syncthreads();
    float mx = -1e30f;
    for (int i = lane; i < 3 * 129; i += 64) {
        const int br = i / 129, j = i % 129, dil = br == 0 ? 1 : (br == 1 ? 4 : 16); const int tk = tl - j * dil;
        float s = -1e30f;
        if (tk >= 0) { const bf16_t* kr = qkv + (size_t)(t - j * dil) * NQKV + D + h * HD; float a = 0.f;
            for (int e = 0; e < 64; ++e) a += sq[w][e] * bf2f(kr[e]);
            s = a + bias[(br * 129 + j) * 16 + h]; }
        sp[w][i] = s; mx = fmaxf(mx, s);
    }
#pragma unroll
    for (int o = 1; o < 64; o <<= 1) mx = fmaxf(mx, __shfl_xor(mx, o));
    __syncthreads();
    float l = 0.f, o = 0.f;
    for (int i = 0; i < 3 * 129; ++i) {
        const float s = sp[w][i]; if (s < -1e29f) continue;
        const int br = i / 129, j = i % 129, dil = br == 0 ? 1 : (br == 1 ? 4 : 16);
        const float p = exp2f(s - mx); l += p;
        o += p * bf2f(qkv[(size_t)(t - j * dil) * NQKV + 2 * D + h * HD + lane]);
    }
    ao[(size_t)t * D + h * HD + lane] = f2bf(o / l);
}


namespace pg8 {
#define PG8_LAS __attribute__((address_space(3)))
typedef unsigned short bf16_t;
typedef short bf16x8 __attribute__((ext_vector_type(8)));
typedef float f32x4 __attribute__((ext_vector_type(4)));
typedef unsigned u32x4 __attribute__((ext_vector_type(4)));
constexpr int BM = 256, BK = 64, HALF = 128, HTB = HALF * BK * 2  , STAGE_BYTES = 8 * HTB, NXCD = 8, WGM = 8;

__host__ __device__ __forceinline__ int lds_byte(int r, int c) { const int st = (r >> 4) * 2 + (c >> 5), rr = r & 15, cc = c & 31, ob = rr * 64 + cc * 2; return st * 1024 + (ob ^ (((ob >> 9) & 1) << 5)); }
__host__ __device__ __forceinline__ void stage_rc(int b, int& R, int& C) { const int st = b / 1024, sb = b % 1024, swz = sb ^ (((sb >> 9) & 1) << 5); R = (st >> 1) * 16 + swz / 64; C = (st & 1) * 32 + (swz % 64) / 2; }
__host__ __device__ __forceinline__ int perm32(int rho) { const int n = rho >> 4, i = rho & 15; return 8 * (i >> 2) + 4 * n + (i & 3); }

struct Unit { int pm, pn; };
struct Gemm { const bf16_t* A; const bf16_t* Bt; int M, N, K; };

struct StaticOrder {
    int nM, nN, nwg, G, c;
    __host__ __device__ void init(int M, int N, int G_, int c_) { nM = M / BM; nN = N / BM; nwg = nM * nN; G = G_; c = c_; }
    __host__ __device__ bool next(int i, Unit& u) const {
        const long L = (long)i * G + c; if (L >= nwg) return false;
        int wgid = (int)L; { const int q = nwg / NXCD, r = nwg % NXCD, xcd = wgid % NXCD, off = wgid / NXCD; wgid = (xcd < r ? xcd * (q + 1) : r * (q + 1) + (xcd - r) * q) + off; }
        const int nig = WGM * nN, gid = wgid / nig, fm = gid * WGM, gsz = (nM - fm) < WGM ? (nM - fm) : WGM;
        u.pm = fm + ((wgid % nig) % gsz); u.pn = (wgid % nig) / gsz; return true;
    }
    __device__ __forceinline__ long a_row(const Unit& u) const { return (long)u.pm * BM; }
    __device__ __forceinline__ void a_ready(const Unit&) const {}
    __device__ __forceinline__ void done(const Unit&) const {}
};

typedef float f32x2c_t __attribute__((ext_vector_type(2))); typedef __bf16 bf16x2c_t __attribute__((ext_vector_type(2)));
__device__ __forceinline__ unsigned cvt_pk_bf16(float lo, float hi) { f32x2c_t v = {lo, hi}; bf16x2c_t b = __builtin_convertvector(v, bf16x2c_t); return __builtin_bit_cast(unsigned, b); }
typedef unsigned u32x2 __attribute__((ext_vector_type(2)));
__device__ __forceinline__ float row_rs(const float* ssq, int row) { return rsqrtf(ssq[row] * (1.0f / 1024.0f) + 1e-6f); }

struct EpiRowScale {
    static constexpr bool PERM = true, AFTER_DRAIN = false, PREFETCH = false;
    bf16_t* O; int ldc; const float* ssq;
    __device__ __forceinline__ void operator()(const f32x4 (&acc)[2][2][4][2], const Unit& u, int wr, int wc, int fr, int fq) const {
        const int row0 = u.pm * BM + wr * 64 + fr, col0 = u.pn * BM + wc * 32 + 8 * fq;
        float rsv[2][4];
#pragma unroll
        for (int ai = 0; ai < 2; ++ai)
#pragma unroll
            for (int m = 0; m < 4; ++m) rsv[ai][m] = ssq[row0 + ai * HALF + m * 16];
#pragma unroll
        for (int ai = 0; ai < 2; ++ai)
#pragma unroll
            for (int m = 0; m < 4; ++m) { const int row = row0 + ai * HALF + m * 16; const float rs = rsqrtf(rsv[ai][m] * (1.0f / 1024.0f) + 1e-6f); bf16_t* rowp = O + (size_t)row * ldc + col0;
#pragma unroll
                for (int bj = 0; bj < 2; ++bj) { const f32x4 v0 = acc[ai][bj][m][0] * rs, v1 = acc[ai][bj][m][1] * rs;
                    u32x4 w; w.x = cvt_pk_bf16(v0[0], v0[1]); w.y = cvt_pk_bf16(v0[2], v0[3]); w.z = cvt_pk_bf16(v1[0], v1[1]); w.w = cvt_pk_bf16(v1[2], v1[3]);
                    *(u32x4*)(rowp + bj * HALF) = w; } }
    }
};

template <bool BASE_F32, bool OUT_F32, bool OUT_XB, bool SSQ>
struct EpiResidual {
    static constexpr bool PERM = true, AFTER_DRAIN = false, PREFETCH = false;
    const float* basef; const bf16_t* baseb; float* outf; bf16_t* xbo; float* ssq_next;
    __device__ __forceinline__ void operator()(const f32x4 (&acc)[2][2][4][2], const Unit& u, int wr, int wc, int fr, int fq) const {
        const int row0 = u.pm * BM + wr * 64 + fr, col0 = u.pn * BM + wc * 32 + 8 * fq;
        if constexpr (!BASE_F32) {
            u32x4 bw[2][4][2]; float ss[2][4];
#pragma unroll
            for (int ai = 0; ai < 2; ++ai)
#pragma unroll
                for (int m = 0; m < 4; ++m)
#pragma unroll
                    for (int bj = 0; bj < 2; ++bj) bw[ai][m][bj] = *(const u32x4*)(baseb + (size_t)(row0 + ai * HALF + m * 16) * 1024 + col0 + bj * HALF);
#pragma unroll
            for (int ai = 0; ai < 2; ++ai)
#pragma unroll
                for (int m = 0; m < 4; ++m) { const int row = row0 + ai * HALF + m * 16; const size_t off = (size_t)row * 1024 + col0; float s = 0.f;
#pragma unroll
                    for (int bj = 0; bj < 2; ++bj) { const size_t o = off + bj * HALF; const u32x4 w = bw[ai][m][bj];
                        f32x4 v0 = (f32x4){__uint_as_float(w.x << 16), __uint_as_float(w.x & 0xffff0000u), __uint_as_float(w.y << 16), __uint_as_float(w.y & 0xffff0000u)};
                        f32x4 v1 = (f32x4){__uint_as_float(w.z << 16), __uint_as_float(w.z & 0xffff0000u), __uint_as_float(w.w << 16), __uint_as_float(w.w & 0xffff0000u)};
                        v0 = v0 + acc[ai][bj][m][0]; v1 = v1 + acc[ai][bj][m][1];
                        if (OUT_F32) { *(f32x4*)(outf + o) = v0; *(f32x4*)(outf + o + 4) = v1; }
                        if (OUT_XB) { u32x4 wo; wo.x = cvt_pk_bf16(v0[0], v0[1]); wo.y = cvt_pk_bf16(v0[2], v0[3]); wo.z = cvt_pk_bf16(v1[0], v1[1]); wo.w = cvt_pk_bf16(v1[2], v1[3]); *(u32x4*)(xbo + o) = wo; }
                        s += (v0[0] * v0[0] + v0[1] * v0[1]) + (v0[2] * v0[2] + v0[3] * v0[3]) + (v1[0] * v1[0] + v1[1] * v1[1]) + (v1[2] * v1[2] + v1[3] * v1[3]); }
                    if (SSQ) { s += __shfl_xor(s, 16); s += __shfl_xor(s, 32); }
                    ss[ai][m] = s; }
            if (SSQ) { if (fq == 0) {
#pragma unroll
                for (int ai = 0; ai < 2; ++ai)
#pragma unroll
                    for (int m = 0; m < 4; ++m) atomicAdd(ssq_next + row0 + ai * HALF + m * 16, ss[ai][m]); } }
        } else {
#pragma unroll
        for (int ai = 0; ai < 2; ++ai)
#pragma unroll
            for (int m = 0; m < 4; ++m) { const int row = row0 + ai * HALF + m * 16; const size_t off = (size_t)row * 1024 + col0; float s = 0.f;
#pragma unroll
                for (int bj = 0; bj < 2; ++bj) { const size_t o = off + bj * HALF; f32x4 v0, v1;
                    v0 = *(const f32x4*)(basef + o); v1 = *(const f32x4*)(basef + o + 4);
                    v0 = v0 + acc[ai][bj][m][0]; v1 = v1 + acc[ai][bj][m][1];
                    if (OUT_F32) { *(f32x4*)(outf + o) = v0; *(f32x4*)(outf + o + 4) = v1; }
                    if (OUT_XB) { u32x4 w; w.x = cvt_pk_bf16(v0[0], v0[1]); w.y = cvt_pk_bf16(v0[2], v0[3]); w.z = cvt_pk_bf16(v1[0], v1[1]); w.w = cvt_pk_bf16(v1[2], v1[3]); *(u32x4*)(xbo + o) = w; }
                    s += (v0[0] * v0[0] + v0[1] * v0[1]) + (v0[2] * v0[2] + v0[3] * v0[3]) + (v1[0] * v1[0] + v1[1] * v1[1]) + (v1[2] * v1[2] + v1[3] * v1[3]); }
                if (SSQ) { s += __shfl_xor(s, 16); s += __shfl_xor(s, 32); if (fq == 0) atomicAdd(ssq_next + row, s); }
                if (m & 1) asm volatile("" ::: "memory"); }
        }
    }
};

struct EpiQkv {
    static constexpr bool PERM = true, AFTER_DRAIN = false, PREFETCH = false;
    bf16_t* O; const float* ssq; const float* gq; const float* gk;
    __device__ __forceinline__ void operator()(const f32x4 (&acc)[2][2][4][2], const Unit& u, int wr, int wc, int fr, int fq) const {
        const int row0 = u.pm * BM + wr * 64 + fr; const int part = (u.pn * BM) >> 10;
        float rsv[2][4];
#pragma unroll
        for (int ai = 0; ai < 2; ++ai)
#pragma unroll
            for (int m = 0; m < 4; ++m) rsv[ai][m] = ssq[row0 + ai * HALF + m * 16];
        const float* gp = (part == 1 ? gk : gq) + 8 * fq; const float sc0 = part == 0 ? 0.125f * 1.4426950408889634f : 1.0f; const bool nrm = part < 2;
        f32x4 gv[2][2];
#pragma unroll
        for (int bj = 0; bj < 2; ++bj)
#pragma unroll
            for (int n = 0; n < 2; ++n) gv[bj][n] = *(const f32x4*)(gp + 32 * bj + 4 * n);
#pragma unroll
        for (int bj = 0; bj < 2; ++bj)
#pragma unroll
            for (int n = 0; n < 2; ++n)
#pragma unroll
                for (int j = 0; j < 4; ++j) gv[bj][n][j] = nrm ? gv[bj][n][j] * sc0 : 1.0f;
#pragma unroll
        for (int ai = 0; ai < 2; ++ai)
#pragma unroll
            for (int m = 0; m < 4; ++m) { const int row = row0 + ai * HALF + m * 16; const float rs = rsqrtf(rsv[ai][m] * (1.0f / 1024.0f) + 1e-6f);
                f32x4 y[2][2]; float ss = 0.f;
#pragma unroll
                for (int bj = 0; bj < 2; ++bj)
#pragma unroll
                    for (int n = 0; n < 2; ++n) { y[bj][n] = acc[ai][bj][m][n] * rs; const f32x4 t = y[bj][n]; ss += (t[0] * t[0] + t[1] * t[1]) + (t[2] * t[2] + t[3] * t[3]); }
                ss += __shfl_xor(ss, 16); ss += __shfl_xor(ss, 32); const float sc1 = rsqrtf(ss * (1.0f / 64.0f) + 1e-6f), sc = nrm ? sc1 : 1.0f;
#pragma unroll
                for (int bj = 0; bj < 2; ++bj)
#pragma unroll
                    for (int n = 0; n < 2; ++n) y[bj][n] = y[bj][n] * sc * gv[bj][n];
                const int hh = ((u.pn & 3) << 2) + wc;
                bf16_t* rowp = O + (size_t)part * (16384u * 1024u) + ((size_t)((row >> 12) * 16 + hh) * 4096 + (row & 4095)) * 64 + 8 * fq;
#pragma unroll
                for (int bj = 0; bj < 2; ++bj) { u32x4 w; w.x = cvt_pk_bf16(y[bj][0][0], y[bj][0][1]); w.y = cvt_pk_bf16(y[bj][0][2], y[bj][0][3]); w.z = cvt_pk_bf16(y[bj][1][0], y[bj][1][1]); w.w = cvt_pk_bf16(y[bj][1][2], y[bj][1][3]);
                    *(u32x4*)(rowp + 32 * bj) = w; } }
    }
};

template <int CTRL> __device__ __forceinline__ float dppf(float o, float s) { return __int_as_float(__builtin_amdgcn_update_dpp(__float_as_int(o), __float_as_int(s), CTRL, 0xf, 0xf, false)); }
template <int CTRL> __device__ __forceinline__ f32x4 dpp4(f32x4 o, f32x4 s) { f32x4 r; r[0] = dppf<CTRL>(o[0], s[0]); r[1] = dppf<CTRL>(o[1], s[1]); r[2] = dppf<CTRL>(o[2], s[2]); r[3] = dppf<CTRL>(o[3], s[3]); return r; }
__device__ __forceinline__ f32x4 dpp4_shr1(f32x4 o, f32x4 s) { return dpp4<0x111>(o, s); }
__device__ __forceinline__ f32x4 dpp4_shr2(f32x4 o, f32x4 s) { return dpp4<0x112>(o, s); }
__device__ __forceinline__ f32x4 dpp4_shl15(f32x4 o, f32x4 s) { return dpp4<0x10f>(o, s); }
__device__ __forceinline__ f32x4 dpp4_shl14(f32x4 o, f32x4 s) { return dpp4<0x10e>(o, s); }
#define PIN4(x) asm volatile("" : "+v"(x))
#define DPPM " row_mask:0xf bank_mask:0xf bound_ctrl:1\n\t"
__device__ __forceinline__ void conv_taps_cur(f32x4& nv, const f32x4 cur, const f32x4 w1, const f32x4 w0) {
    float n0 = nv[0], n1 = nv[1], n2 = nv[2], n3 = nv[3];
    asm volatile("s_nop 1\n\t"
        "v_fmac_f32_dpp %0, %4, %8 row_shr:1" DPPM "v_fmac_f32_dpp %1, %5, %9 row_shr:1" DPPM "v_fmac_f32_dpp %2, %6, %10 row_shr:1" DPPM "v_fmac_f32_dpp %3, %7, %11 row_shr:1" DPPM
        "v_fmac_f32_dpp %0, %4, %12 row_shr:2" DPPM "v_fmac_f32_dpp %1, %5, %13 row_shr:2" DPPM "v_fmac_f32_dpp %2, %6, %14 row_shr:2" DPPM "v_fmac_f32_dpp %3, %7, %15 row_shr:2" DPPM
        : "+v"(n0), "+v"(n1), "+v"(n2), "+v"(n3)
        : "v"(cur[0]), "v"(cur[1]), "v"(cur[2]), "v"(cur[3]), "v"(w1[0]), "v"(w1[1]), "v"(w1[2]), "v"(w1[3]), "v"(w0[0]), "v"(w0[1]), "v"(w0[2]), "v"(w0[3]));
    nv = (f32x4){n0, n1, n2, n3};
}
__device__ __forceinline__ void conv_taps_prev(f32x4& nv, const f32x4 pv, const f32x4 w1, const f32x4 w0) {
    float n0 = nv[0], n1 = nv[1], n2 = nv[2], n3 = nv[3];
    asm volatile("s_nop 1\n\t"
        "v_fmac_f32_dpp %0, %4, %8 row_shl:15" DPPM "v_fmac_f32_dpp %1, %5, %9 row_shl:15" DPPM "v_fmac_f32_dpp %2, %6, %10 row_shl:15" DPPM "v_fmac_f32_dpp %3, %7, %11 row_shl:15" DPPM
        "v_fmac_f32_dpp %0, %4, %12 row_shl:14" DPPM "v_fmac_f32_dpp %1, %5, %13 row_shl:14" DPPM "v_fmac_f32_dpp %2, %6, %14 row_shl:14" DPPM "v_fmac_f32_dpp %3, %7, %15 row_shl:14" DPPM
        : "+v"(n0), "+v"(n1), "+v"(n2), "+v"(n3)
        : "v"(pv[0]), "v"(pv[1]), "v"(pv[2]), "v"(pv[3]), "v"(w1[0]), "v"(w1[1]), "v"(w1[2]), "v"(w1[3]), "v"(w0[0]), "v"(w0[1]), "v"(w0[2]), "v"(w0[3]));
    nv = (f32x4){n0, n1, n2, n3};
}
struct EpiConvGlu {
    static constexpr bool PERM = true, AFTER_DRAIN = false, PREFETCH = true;
    bf16_t* act; const float* ssq; const float* cw; const float* cb; PG8_LAS float* halo;
    __device__ __forceinline__ void prefetch(const Unit& u, int wid, int lane, int par) const {
        PG8_LAS unsigned char* pf = (PG8_LAS unsigned char*)halo + 12288 + par * 5120;
        if (wid < 4) { const int b = u.pm / 17, it = u.pm - b * 17; int tl = 254 * it - 2 + wid * 64 + lane; tl = tl < 0 ? 0 : (tl > 4095 ? 4095 : tl);
            __builtin_amdgcn_global_load_lds((const unsigned*)(ssq + b * 4096 + tl), (PG8_LAS unsigned*)(pf + 4096 + wid * 256), 4, 0, 0); }
        else { const int seg = (wid - 4) * 2 + (lane >> 5), j = seg >> 1, bj = seg & 1; const float* src = (j < 3 ? cw + j * 5632 : cb) + u.pn * HALF + bj * 2816 + (lane & 31) * 4;
            __builtin_amdgcn_global_load_lds((const unsigned*)src, (PG8_LAS unsigned*)(pf + (wid - 4) * 1024), 16, 0, 0); }
    }
    __device__ __forceinline__ void operator()(f32x4 (&acc)[2][2][4][2], const Unit& u, int wr, int wc, int fr, int fq, int par) const {
        const int b = u.pm / 17, it = u.pm - b * 17; const int tl0 = 254 * it - 2 + wr * 64 + fr;
        const int colg = u.pn * HALF + wc * 32 + 8 * fq;
        float rsv[2][4];
        const PG8_LAS float* pfs = (const PG8_LAS float*)((const PG8_LAS unsigned char*)halo + 12288 + par * 5120 + 4096) + wr * 64 + fr;
        const PG8_LAS unsigned char* pfw = (const PG8_LAS unsigned char*)halo + 12288 + par * 5120 + (wc * 32 + 8 * fq) * 4;
#pragma unroll
        for (int ai = 0; ai < 2; ++ai)
#pragma unroll
            for (int m = 0; m < 4; ++m) rsv[ai][m] = pfs[ai * HALF + m * 16];
#pragma unroll
        for (int ai = 0; ai < 2; ++ai)
#pragma unroll
            for (int m = 0; m < 4; ++m) { const int tl = tl0 + ai * HALF + m * 16; const bool ok = (tl >= 0) && (tl < 4096); const float r0 = rsqrtf(rsv[ai][m] * (1.0f / 1024.0f) + 1e-6f); const float rs = ok ? r0 : 0.f;
#pragma unroll
                for (int bj = 0; bj < 2; ++bj)
#pragma unroll
                    for (int n = 0; n < 2; ++n) { acc[ai][bj][m][n] = acc[ai][bj][m][n] * rs; PIN4(acc[ai][bj][m][n]); } }
        PG8_LAS f32x4* H = (PG8_LAS f32x4*)halo;
        { PG8_LAS f32x4* Hw = H + ((wr ^ 1) * 16 + wc * 4 + fq) + wr * 256 + (fr & 1) * 128;
          if (fr >= 14) {
#pragma unroll
            for (int ai = 0; ai < 2; ++ai)
#pragma unroll
                for (int bj = 0; bj < 2; ++bj)
#pragma unroll
                    for (int n = 0; n < 2; ++n) Hw[ai * 256 + bj * 64 + n * 32] = acc[ai][bj][3][n]; } }
        asm volatile("s_waitcnt lgkmcnt(0)" ::: "memory"); __builtin_amdgcn_s_barrier(); asm volatile("" ::: "memory"); __builtin_amdgcn_sched_barrier(0);
        const PG8_LAS f32x4* Hr = H + (wr * 16 + wc * 4 + fq);
#pragma unroll
        for (int bj = 0; bj < 2; ++bj)
#pragma unroll
            for (int n = 0; n < 2; ++n) { const int c = colg + bj * 2816 + 4 * n;
                f32x4 w0 = *(const PG8_LAS f32x4*)(pfw + (0 + bj) * 512 + n * 16), w1 = *(const PG8_LAS f32x4*)(pfw + (2 + bj) * 512 + n * 16), w2 = *(const PG8_LAS f32x4*)(pfw + (4 + bj) * 512 + n * 16), bb = *(const PG8_LAS f32x4*)(pfw + (6 + bj) * 512 + n * 16);
                PIN4(w0); PIN4(w1); PIN4(w2); PIN4(bb);
#pragma unroll
                for (int ai = 0; ai < 2; ++ai) { const int s = 2 * ai + wr;
                    f32x4 h1 = (f32x4){0.f, 0.f, 0.f, 0.f}, h2 = h1;
                    if (s > 0) { h2 = Hr[ai * 256 + bj * 64 + n * 32]; h1 = Hr[ai * 256 + 128 + bj * 64 + n * 32]; }
                    PIN4(h1); PIN4(h2);
#pragma unroll
                    for (int m = 3; m >= 0; --m) { f32x4 cur = acc[ai][bj][m][n]; PIN4(cur); f32x4 o1, o2;
#ifdef X_SHFL
                        const int ln = (int)(threadIdx.x & 63); f32x4 p1, p2;
                        if (m > 0) { const f32x4 pv = acc[ai][bj][m - 1][n];
                            for (int j = 0; j < 4; ++j) { const float a1 = __shfl(cur[j], ln - 1, 64), b1 = __shfl(pv[j], ln + 15, 64), a2 = __shfl(cur[j], ln - 2, 64), b2 = __shfl(pv[j], ln + 14, 64);
                                p1[j] = fr >= 1 ? a1 : b1; p2[j] = fr >= 2 ? a2 : b2; } }
                        else { for (int j = 0; j < 4; ++j) { const float a1 = __shfl(cur[j], ln - 1, 64), a2 = __shfl(cur[j], ln - 2, 64);
                                p1[j] = fr >= 1 ? a1 : h1[j]; p2[j] = fr >= 2 ? a2 : (fr == 0 ? h2[j] : h1[j]); } }
                        f32x4 nv = w2 * cur + w1 * p1 + w0 * p2 + bb; PIN4(nv);
#elif !defined(X_DPPMOV)
                        f32x4 nv = w2 * cur + bb;
                        if (m > 0) { const f32x4 pv = acc[ai][bj][m - 1][n]; conv_taps_prev(nv, pv, w1, w0); }
                        else { const f32x4 hz = (f32x4){0.f, 0.f, 0.f, 0.f}; const f32x4 t1 = (fr == 0) ? h1 : hz, t2 = (fr == 0) ? h2 : ((fr == 1) ? h1 : hz); nv = nv + w1 * t1 + w0 * t2; }
                        conv_taps_cur(nv, cur, w1, w0);
#else
                        if (m > 0) { const f32x4 pv = acc[ai][bj][m - 1][n]; o1 = dpp4_shl15(pv, pv); o2 = dpp4_shl14(pv, pv); }
                        else { o1 = h1; o2 = (fr == 0) ? h2 : h1; }
                        const f32x4 p1 = dpp4_shr1(o1, cur), p2 = dpp4_shr2(o2, cur);
                        f32x4 nv = w2 * cur + w1 * p1 + w0 * p2 + bb; PIN4(nv);
#endif
                        acc[ai][bj][m][n] = nv; } } }
        __builtin_amdgcn_sched_barrier(0);
#pragma unroll
        for (int ai = 0; ai < 2; ++ai)
#pragma unroll
            for (int m = 0; m < 4; ++m) { const int rl = ai * HALF + wr * 64 + m * 16 + fr; const int tl = 254 * it - 2 + rl;
                f32x4 r[2];
#pragma unroll
                for (int n = 0; n < 2; ++n) { const f32x4 g = acc[ai][0][m][n], up = acc[ai][1][m][n];
#pragma unroll
                    for (int j = 0; j < 4; ++j) { const float e = __builtin_amdgcn_exp2f(g[j] * -1.4426950408889634f); r[n][j] = g[j] * __builtin_amdgcn_rcpf(1.0f + e) * up[j]; } }
                if (rl >= 2 && tl < 4096) { u32x4 w; w.x = cvt_pk_bf16(r[0][0], r[0][1]); w.y = cvt_pk_bf16(r[0][2], r[0][3]); w.z = cvt_pk_bf16(r[1][0], r[1][1]); w.w = cvt_pk_bf16(r[1][2], r[1][3]);
                    *(u32x4*)(act + (size_t)(b * 4096 + tl) * 2816 + colg) = w; }
                asm volatile("" ::: "memory"); }
    }
};
struct OverlapOrder : StaticOrder {
    __device__ __forceinline__ long a_row(const Unit& u) const { const int b = u.pm / 17, it = u.pm - b * 17; return (long)b * 4096 + 254 * it - 2; }
};

template <class Epi, class Sched, bool ALIGN_EPI = false, bool SP2 = false>
__device__ __forceinline__ void gemm_phase(PG8_LAS unsigned char* lds, const Gemm g, const Sched& S, const Epi& E) {
    const int tid = threadIdx.x, wid = __builtin_amdgcn_readfirstlane(tid >> 6), lane = tid & 63, wr = wid >> 2, wc = wid & 3, fr = lane & 15, fq = lane >> 4;
    const int K = g.K, nt = K / BK;
    unsigned voffA[2], voffB[2];
#pragma unroll
    for (int i = 0; i < 2; ++i) { int R, C; stage_rc(tid * 16 + i * 8192, R, C); const int Rb = Epi::PERM ? ((R & ~31) + perm32(R & 31)) : R;
        voffA[i] = (unsigned)(R * K + C) * 2u; voffB[i] = (unsigned)(Rb * K + C) * 2u; }
    const size_t kstep = (size_t)(BK * 2);
    const size_t hstep = (size_t)HALF * K * 2;
    const size_t tstep = 2 * hstep;
    const unsigned ldsw = (unsigned)wid * 1024u;
    const int aoff = lds_byte(wr * 64 + fr, fq * 8), boff = lds_byte(wc * 32 + fr, fq * 8);
#define PG8_SA(b, h) (((b) * 2 + (h)) * HTB)
#define PG8_SB(b, h) ((4 + (b) * 2 + (h)) * HTB)
#define PG8_STAGE(bufoff, gbase, voff) do { _Pragma("unroll") for (int _i = 0; _i < 2; ++_i) \
        __builtin_amdgcn_global_load_lds((const unsigned*)((const char*)(gbase) + (voff)[_i]), (PG8_LAS unsigned*)(lds + (bufoff) + ldsw + _i * 8192), 16, 0, 0); } while (0)
#define PG8_LDA(dst, b, h) do { _Pragma("unroll") for (int m = 0; m < 4; ++m) _Pragma("unroll") for (int k = 0; k < 2; ++k) dst[m][k] = *(const PG8_LAS bf16x8*)(lds + PG8_SA(b, h) + aoff + m * 2048 + k * 1024); } while (0)
#define PG8_LDB(dst, b, h) do { _Pragma("unroll") for (int n = 0; n < 2; ++n) _Pragma("unroll") for (int k = 0; k < 2; ++k) dst[n][k] = *(const PG8_LAS bf16x8*)(lds + PG8_SB(b, h) + boff + n * 2048 + k * 1024); } while (0)
#define PG8_MMA(ai, bj, At, Bt) do { __builtin_amdgcn_s_setprio(1); _Pragma("unroll") for (int m = 0; m < 4; ++m) _Pragma("unroll") for (int n = 0; n < 2; ++n) _Pragma("unroll") for (int k = 0; k < 2; ++k) \
        acc[ai][bj][m][n] = __builtin_amdgcn_mfma_f32_16x16x32_bf16(Bt[n][k], At[m][k], acc[ai][bj][m][n], 0, 0, 0); __builtin_amdgcn_s_setprio(0); } while (0)
#define PG8_WAIT_V(n) asm volatile("s_waitcnt vmcnt(" #n ")" ::: "memory")
#define PG8_WAIT_L(n) asm volatile("s_waitcnt lgkmcnt(" #n ")" ::: "memory")
#define PG8_BAR __builtin_amdgcn_s_barrier()
#define PG8_SCHED __builtin_amdgcn_sched_barrier(0)
    Unit cur, nxt; int ui = 0;
    if (!S.next(0, cur)) return;
    f32x4 acc[2][2][4][2];
#pragma unroll
    for (int a = 0; a < 2; ++a)
#pragma unroll
        for (int b = 0; b < 2; ++b)
#pragma unroll
            for (int m = 0; m < 4; ++m)
#pragma unroll
                for (int n = 0; n < 2; ++n) acc[a][b][m][n] = (f32x4){0.f, 0.f, 0.f, 0.f};
    bf16x8 At[4][2], B0[2][2], B1[2][2];
    const char* cA = (const char*)g.A + (long)S.a_row(cur) * (long)(K * 2); const char* cB = (const char*)g.Bt + (size_t)cur.pn * tstep;
    S.a_ready(cur);
    if constexpr (Epi::PREFETCH) E.prefetch(cur, wid, lane, 0);
    if constexpr (SP2) {
        PG8_STAGE(PG8_SB(0, 0), cB, voffB); PG8_STAGE(PG8_SB(0, 1), cB + hstep, voffB); PG8_STAGE(PG8_SA(0, 0), cA, voffA); PG8_STAGE(PG8_SA(0, 1), cA + hstep, voffA);
        if (wr == 1) PG8_BAR;
        PG8_WAIT_V(2); PG8_BAR;
        PG8_STAGE(PG8_SB(1, 0), cB + kstep, voffB); PG8_STAGE(PG8_SA(1, 0), cA + kstep, voffA); PG8_STAGE(PG8_SB(1, 1), cB + hstep + kstep, voffB);
        PG8_WAIT_V(6); PG8_BAR;
    } else {
        PG8_STAGE(PG8_SB(0, 0), cB, voffB); PG8_STAGE(PG8_SA(0, 0), cA, voffA); PG8_STAGE(PG8_SB(0, 1), cB + hstep, voffB); PG8_STAGE(PG8_SA(0, 1), cA + hstep, voffA);
        if (wr == 1) PG8_BAR;
        PG8_WAIT_V(4); PG8_BAR;
        PG8_STAGE(PG8_SB(1, 0), cB + kstep, voffB); PG8_STAGE(PG8_SA(1, 0), cA + kstep, voffA); PG8_STAGE(PG8_SB(1, 1), cB + hstep + kstep, voffB);
        PG8_WAIT_V(6); PG8_BAR;
    }
    for (;;) {
        const bool has_next = S.next(ui + 1, nxt);
        const char* nA = has_next ? (const char*)g.A + (long)S.a_row(nxt) * (long)(K * 2) : cA; const char* nB = has_next ? (const char*)g.Bt + (size_t)nxt.pn * tstep : cB;
        for (int t = 0; t < nt; t += 2) {
            const bool last = (t == nt - 2);
            const char* a1 = cA + (size_t)(t + 1) * kstep;
            const char* a2 = last ? nA : cA + (size_t)(t + 2) * kstep; const char* b2 = last ? nB : cB + (size_t)(t + 2) * kstep;
            const char* a3 = a2 + kstep; const char* b3 = b2 + kstep;
            if (last && has_next) S.a_ready(nxt);
            if constexpr (SP2) {
            PG8_LDB(B0, 0, 0); PG8_LDB(B1, 0, 1); PG8_SCHED; PG8_LDA(At, 0, 0); PG8_STAGE(PG8_SA(1, 1), a1 + hstep, voffA);
            PG8_WAIT_V(8); PG8_WAIT_L(0); PG8_BAR; PG8_MMA(0, 0, At, B0); PG8_MMA(0, 1, At, B1); PG8_BAR; PG8_SCHED;
            PG8_LDA(At, 0, 1); PG8_STAGE(PG8_SB(0, 0), b2, voffB); PG8_STAGE(PG8_SB(0, 1), b2 + hstep, voffB); PG8_STAGE(PG8_SA(0, 0), a2, voffA);
            PG8_WAIT_V(8); PG8_WAIT_L(0); PG8_BAR; PG8_MMA(1, 0, At, B0); PG8_MMA(1, 1, At, B1); PG8_BAR; PG8_SCHED;
            PG8_LDB(B0, 1, 0); PG8_LDB(B1, 1, 1); PG8_SCHED; PG8_LDA(At, 1, 0); PG8_STAGE(PG8_SA(0, 1), a2 + hstep, voffA);
            PG8_WAIT_V(8); PG8_WAIT_L(0); PG8_BAR; PG8_MMA(0, 0, At, B0); PG8_MMA(0, 1, At, B1); PG8_BAR; PG8_SCHED;
            PG8_LDA(At, 1, 1); PG8_STAGE(PG8_SB(1, 0), b3, voffB); PG8_STAGE(PG8_SB(1, 1), b3 + hstep, voffB); PG8_STAGE(PG8_SA(1, 0), a3, voffA);
            PG8_WAIT_V(8); PG8_WAIT_L(0); PG8_BAR; PG8_MMA(1, 0, At, B0); PG8_MMA(1, 1, At, B1); PG8_BAR; PG8_SCHED;
            } else {
            PG8_LDB(B0, 0, 0); PG8_SCHED; PG8_LDA(At, 0, 0); PG8_STAGE(PG8_SA(1, 1), a1 + hstep, voffA);
            PG8_WAIT_L(8); PG8_BAR; PG8_WAIT_L(0); PG8_MMA(0, 0, At, B0); PG8_BAR; PG8_SCHED;
            PG8_LDB(B1, 0, 1); PG8_STAGE(PG8_SB(0, 0), b2, voffB);
            PG8_BAR; PG8_WAIT_L(0); PG8_MMA(0, 1, At, B1); PG8_BAR;
            PG8_LDA(At, 0, 1); PG8_STAGE(PG8_SA(0, 0), a2, voffA);
            PG8_BAR; PG8_WAIT_L(0); PG8_MMA(1, 0, At, B0); PG8_BAR; PG8_SCHED;
            PG8_STAGE(PG8_SB(0, 1), b2 + hstep, voffB);
            PG8_WAIT_V(6); PG8_BAR; PG8_MMA(1, 1, At, B1); PG8_BAR;
            PG8_LDB(B0, 1, 0); PG8_SCHED; PG8_LDA(At, 1, 0); PG8_STAGE(PG8_SA(0, 1), a2 + hstep, voffA);
            PG8_WAIT_L(8); PG8_BAR; PG8_WAIT_L(0); PG8_MMA(0, 0, At, B0); PG8_BAR; PG8_SCHED;
            PG8_LDB(B1, 1, 1); PG8_STAGE(PG8_SB(1, 0), b3, voffB);
            PG8_BAR; PG8_WAIT_L(0); PG8_MMA(0, 1, At, B1); PG8_BAR;
            PG8_LDA(At, 1, 1); PG8_STAGE(PG8_SA(1, 0), a3, voffA);
            PG8_BAR; PG8_WAIT_L(0); PG8_MMA(1, 0, At, B0); PG8_BAR; PG8_SCHED;
            PG8_STAGE(PG8_SB(1, 1), b3 + hstep, voffB);
            PG8_WAIT_V(6); PG8_BAR; PG8_MMA(1, 1, At, B1); PG8_BAR;
            }
        }
        if constexpr (ALIGN_EPI) { if (wr == 0) PG8_BAR; }
        if constexpr (Epi::PREFETCH) { E(acc, cur, wr, wc, fr, fq, ui & 1); if (has_next) E.prefetch(nxt, wid, lane, (ui + 1) & 1); S.done(cur); }
        else if constexpr (!Epi::AFTER_DRAIN) { E(acc, cur, wr, wc, fr, fq); S.done(cur); }
        if (!has_next) break;
#pragma unroll
        for (int a = 0; a < 2; ++a)
#pragma unroll
            for (int b = 0; b < 2; ++b)
#pragma unroll
                for (int m = 0; m < 4; ++m)
#pragma unroll
                    for (int n = 0; n < 2; ++n) acc[a][b][m][n] = (f32x4){0.f, 0.f, 0.f, 0.f};
        cur = nxt; cA = nA; cB = nB; ++ui;
        if constexpr (ALIGN_EPI) { if (wr == 1) PG8_BAR; }
    }
    PG8_WAIT_V(0);
    if constexpr (!ALIGN_EPI) { if (wr == 0) PG8_BAR; }
    PG8_BAR;
    if constexpr (Epi::AFTER_DRAIN) { E.fused(acc, cur, wr, wc, fr, fq, lds, wid, lane); S.done(cur); }
#undef PG8_SA
#undef PG8_SB
#undef PG8_STAGE
#undef PG8_LDA
#undef PG8_LDB
#undef PG8_MMA
#undef PG8_WAIT_V
#undef PG8_WAIT_L
#undef PG8_BAR
#undef PG8_SCHED
}
}

#define GAS __attribute__((address_space(1)))
#define LAS __attribute__((address_space(3)))
typedef unsigned short bf16;
typedef unsigned v4u __attribute__((ext_vector_type(4)));
typedef float f32x4 __attribute__((ext_vector_type(4)));
typedef short bf16x8 __attribute__((ext_vector_type(8)));
typedef GAS unsigned gu32;
typedef GAS unsigned long long gu64;
#define RLX_AGENT __ATOMIC_RELAXED, __HIP_MEMORY_SCOPE_AGENT
#define LDS_WAIT() asm volatile("s_waitcnt lgkmcnt(0)" ::: "memory")
#define VM_WAIT() asm volatile("s_waitcnt vmcnt(0)" ::: "memory")
__device__ __forceinline__ unsigned long long rt() { return __builtin_amdgcn_s_memrealtime(); }
__device__ __forceinline__ unsigned pk2(float lo, float hi) { return (unsigned)f2bf(lo) | ((unsigned)f2bf(hi) << 16); }
#define XB_TMO      128
#define XB_XCNT(j)  (256  + 64 * (j))
#define XB_XSUB(j)  (1280 + 64 * (j))
#define XB_XGEN(j)  (2304 + 64 * (j))
#define XB_TOP      3328
#define XB_TOPGEN   3392
#define XCD_BAR_WORDS 3456
#define XB_SPIN_CAP (1u << 18)

__device__ __forceinline__ unsigned xb_ld(unsigned* p)              { return __hip_atomic_load(p, __ATOMIC_RELAXED, __HIP_MEMORY_SCOPE_AGENT); }
__device__ __forceinline__ unsigned xb_add(unsigned* p, unsigned v) { return __hip_atomic_fetch_add(p, v, __ATOMIC_RELAXED, __HIP_MEMORY_SCOPE_AGENT); }
__device__ __forceinline__ unsigned xb_xcc_id() { return (unsigned)__builtin_amdgcn_s_getreg((3 << 11) | 20) & 0xFu; }
#define XB_SPIN(cond, bar) do { unsigned _sp = 0; while (cond) { __builtin_amdgcn_s_sleep(1); \
    if ((++_sp & 255u) == 0u) { if (xb_ld(&(bar)[XB_TMO])) break; if (_sp > XB_SPIN_CAP) { atomicAdd(&(bar)[XB_TMO], 1u); break; } } } } while (0)

struct XcdBarrier {
    unsigned* bar; unsigned x;
    volatile LAS unsigned* st;
};

__device__ __forceinline__ XcdBarrier xcd_barrier_post(unsigned* bar, volatile LAS unsigned* st) {
    XcdBarrier b; b.bar = bar; b.x = xb_xcc_id(); b.st = st;
    if (threadIdx.x == 0) (void)xb_add(&bar[XB_XCNT(b.x)], 1u);
    return b;
}
__device__ __forceinline__ void xcd_barrier_complete(unsigned* bar, unsigned x, unsigned& nloc, unsigned& nx) {
    const unsigned G = gridDim.x * gridDim.y * gridDim.z;
    unsigned sum, cnt, mine, sp = 0u;
    for (;;) {
        sum = 0u; cnt = 0u; mine = 0u;
#pragma unroll
        for (unsigned j = 0; j < 16; ++j) { const unsigned c = xb_ld(&bar[XB_XCNT(j)]); sum += c; cnt += (c > 0u) ? 1u : 0u; mine = (j == x) ? c : mine; }
        if (sum == G) break;
        __builtin_amdgcn_s_sleep(1);
        if ((++sp & 255u) == 0u) { if (xb_ld(&bar[XB_TMO])) break; if (sp > XB_SPIN_CAP) { atomicAdd(&bar[XB_TMO], 1u); break; } }
    }
    nloc = mine > 0u ? mine : 1u; nx = cnt > 0u ? cnt : 1u;
}

__device__ __forceinline__ void xcd_barrier_protocol(const XcdBarrier& b) {
        unsigned* bar = b.bar;
        __builtin_amdgcn_s_waitcnt(0);
        unsigned nloc = b.st[0], nx = b.st[1];
        if (nloc == 0u) { xcd_barrier_complete(bar, b.x, nloc, nx); b.st[0] = nloc; b.st[1] = nx; }
        const unsigned old = xb_add(&bar[XB_XSUB(b.x)], 1u);
        const unsigned gen = old / nloc;
        if (old + 1u == (gen + 1u) * nloc) {
            __builtin_amdgcn_fence(__ATOMIC_RELEASE, "agent");
            asm volatile("s_waitcnt vmcnt(0)" ::: "memory");
            const unsigned og = xb_add(&bar[XB_TOP], 1u);
            const unsigned tg = og / nx;
            if (og + 1u == (tg + 1u) * nx) xb_add(&bar[XB_TOPGEN], 1u);
            else XB_SPIN(xb_ld(&bar[XB_TOPGEN]) == tg, bar);
            __builtin_amdgcn_fence(__ATOMIC_ACQUIRE, "agent");
            asm volatile("s_waitcnt vmcnt(0)" ::: "memory");
        } else {
            XB_SPIN(xb_ld(&bar[XB_TOPGEN]) == gen, bar);
            __builtin_amdgcn_fence(__ATOMIC_ACQUIRE, "agent");
            asm volatile("s_waitcnt vmcnt(0)" ::: "memory");
        }
}
__device__ __forceinline__ void xcd_barrier(const XcdBarrier& b) {
    asm volatile("s_waitcnt vmcnt(0)" ::: "memory");
    __syncthreads();
    if (threadIdx.x == 0) xcd_barrier_protocol(b);
    __syncthreads();
}
template <class Work>
__device__ __forceinline__ void xcd_barrier_work(const XcdBarrier& b, int wave, const Work& work) {
    asm volatile("s_waitcnt vmcnt(0)" ::: "memory");
    __syncthreads();
    if (wave == 0) { if (threadIdx.x == 0) xcd_barrier_protocol(b); }
    else work(wave - 1);
    __syncthreads();
}

constexpr int NWAVES = 8;
constexpr int CW_BAR = 163840;
constexpr size_t WS_MH = 540 * 1024;
constexpr size_t WS_RT = 544 * 1024;
constexpr size_t WS_WIN = 1 * MiB, WS_WOUT = 5 * MiB, WS_WQKV = 7 * MiB, WS_WO = 13 * MiB, WS_WUP = 15 * MiB  , WS_WDN = 37 * MiB  , WS_WPOOL = 48 * MiB;
static_assert(WS_WPOOL + 131072 <= WS_XB - 4096 && WS_XB + (size_t)T * D * 2 + 512 * 1024 <= WS_R && WS_END <= 256 * MiB, "d_ws map");
constexpr int RING_OFF = 0, RING_BYTES = 131072, LDSCTL_OFF = RING_BYTES, MISC_OFF = LDSCTL_OFF + 320, HALO_OFF = RING_BYTES + 1024, LDS_BYTES = 154624;
static_assert(HALO_OFF + 12288 + 2 * 5120 <= LDS_BYTES, "LDS map");
static_assert(WS_BIAS + 3 * 129 * 16 * 4 <= WS_MH && WS_MH + 64 <= WS_RT && WS_RT + 16 * 3 * 256 * 4 <= (size_t)CW_BAR * 4 && (size_t)CW_BAR * 4 + 11 * 3456 * 4 <= MiB && WS_SSQ + 4 * T * 4 <= WS_BIAS, "control region map");

struct Frame {
    LAS unsigned char* lds; volatile LAS unsigned* MISC; gu32* ctl;
    int tid, lane, wave, vcu, G;
};
struct Args { const float* in[18]; float* out; unsigned char* ws; int ph_lo, ph_hi, li, pad; };

__device__ __forceinline__ int t5_bucket(int dist) {
    if (dist < 16) return dist;
    int b = 16;
    b += dist >= 22; b += dist >= 30; b += dist >= 40; b += dist >= 54; b += dist >= 73; b += dist >= 99; b += dist >= 134; b += dist >= 182;
    b += dist >= 246; b += dist >= 332; b += dist >= 450; b += dist >= 609; b += dist >= 825; b += dist >= 1117; b += dist >= 1513;
    return b;
}
template <bool HAS_K, bool HAS_N, class DstRow>
__device__ __forceinline__ void p0_item(const float* __restrict__ W, int K, int N, bf16* WT, const float* __restrict__ ksc, const float* __restrict__ nsc, LAS float* scr, int item, int lane, DstRow dst) {
    const int nblk = N / 32, kb = item / nblk, nb = item % nblk, k0 = 64 * kb, n0 = 32 * nb;
    const int c = lane & 7;
    const float* wp = W + (size_t)(k0 + (lane >> 5)) * N + n0 + (lane & 31);
    float v[32];
#pragma unroll
    for (int i = 0; i < 32; ++i) v[i] = wp[(size_t)(2 * i) * N];
    float ns = 1.f; f32x4 ka = {1.f, 1.f, 1.f, 1.f}, kb4 = ka;
    if (HAS_N) ns = nsc[n0 + (lane & 31)];
    if (HAS_K) { ka = *(const f32x4*)(ksc + k0 + 8 * c); kb4 = *(const f32x4*)(ksc + k0 + 8 * c + 4); }
#pragma unroll
    for (int i = 0; i < 32; ++i) scr[(2 * i + (lane >> 5)) * 33 + (lane & 31)] = HAS_N ? v[i] * ns : v[i];
    LDS_WAIT(); asm volatile("" ::: "memory");
#pragma unroll
    for (int j = 0; j < 4; ++j) { const int n = (lane >> 3) + 8 * j; const LAS float* s = scr + (8 * c) * 33 + n;
        v4u o; o.x = pk2(s[0 * 33] * ka[0], s[1 * 33] * ka[1]); o.y = pk2(s[2 * 33] * ka[2], s[3 * 33] * ka[3]); o.z = pk2(s[4 * 33] * kb4[0], s[5 * 33] * kb4[1]); o.w = pk2(s[6 * 33] * kb4[2], s[7 * 33] * kb4[3]);
        *(GAS v4u*)(WT + (size_t)dst(n0 + n) * K + k0 + 8 * c) = o; }
    LDS_WAIT(); asm volatile("" ::: "memory");
}
struct DstId { __device__ __forceinline__ int operator()(int n) const { return n; } };
struct DstQkv { __device__ __forceinline__ int operator()(int c) const { const int cl = c & 255; return (c & ~255) + 128 * ((cl & 63) >> 5) + 32 * (cl >> 6) + (cl & 31); } };
struct DstUp { __device__ __forceinline__ int operator()(int c) const { return c < DFF ? 256 * (c >> 7) + (c & 127) : 256 * ((c - DFF) >> 7) + 128 + ((c - DFF) & 127); } };

constexpr int I_IN = 16 * 64, I_OUT = 16 * 32, I_QKV = 16 * 96, I_O = 16 * 32, I_UP = 16 * 176, I_DN = 44 * 32, I_POOL = 2 * 4;
constexpr int IT_POOL = I_IN, IT_OUT = IT_POOL + 4 * I_POOL, IT_UP0 = IT_OUT + I_OUT, IT_DN0 = IT_UP0 + I_UP, IT_QKV = IT_DN0 + I_DN, IT_O = IT_QKV + I_QKV, IT_UP1 = IT_O + I_O, IT_DN1 = IT_UP1 + I_UP, IT_END = IT_DN1 + I_DN;
__device__ __forceinline__ void convert_item(const Args& a, LAS float* scr, int it, int lane) {
    unsigned char* ws = a.ws;
    if (it < IT_POOL) { p0_item<true, false>(a.in[3], D, EVEN_IN, (bf16*)(ws + WS_WIN), a.in[2], nullptr, scr, it, lane, DstId()); return; }
    if (it < IT_OUT) { const int r = it - IT_POOL, g = r / I_POOL; p0_item<false, true>(a.in[5] + (size_t)g * 128 * 128, 128, 128, (bf16*)(ws + WS_WPOOL) + (size_t)g * 128 * 128, nullptr, a.in[6] + g * 128, scr, r - g * I_POOL, lane, DstId()); return; }
    if (it < IT_UP0) { p0_item<false, false>(a.in[7], D, D, (bf16*)(ws + WS_WOUT), nullptr, nullptr, scr, it - IT_OUT, lane, DstId()); return; }
    if (it < IT_DN0) { p0_item<true, false>(a.in[14], D, DFF2, (bf16*)(ws + WS_WUP), a.in[13], nullptr, scr, it - IT_UP0, lane, DstUp()); return; }
    if (it < IT_QKV) { p0_item<false, false>(a.in[17], DFF, D, (bf16*)(ws + WS_WDN), nullptr, nullptr, scr, it - IT_DN0, lane, DstId()); return; }
    if (it < IT_O) { p0_item<true, false>(a.in[9], D, NQKV, (bf16*)(ws + WS_WQKV), a.in[8], nullptr, scr, it - IT_QKV, lane, DstQkv()); return; }
    if (it < IT_UP1) { p0_item<false, false>(a.in[12], D, D, (bf16*)(ws + WS_WO), nullptr, nullptr, scr, it - IT_O, lane, DstId()); return; }
    if (it < IT_DN1) { p0_item<true, false>(a.in[14] + (size_t)D * DFF2, D, DFF2, (bf16*)(ws + WS_WUP) + (size_t)DFF2 * D, a.in[13] + D, nullptr, scr, it - IT_UP1, lane, DstUp()); return; }
    p0_item<false, false>(a.in[17] + (size_t)DFF * D, DFF, D, (bf16*)(ws + WS_WDN) + (size_t)D * DFF, nullptr, nullptr, scr, it - IT_DN1, lane, DstId());
}
struct ConvertWork { const Args* a; LAS unsigned char* lds; int vcu, G, lane, lo, hi;
    __device__ __forceinline__ void operator()(int w7) const { LAS float* scr = (LAS float*)(lds + (w7 + 1) * 16384);
        for (int it = lo + vcu * 7 + w7; it < hi; it += G * 7) convert_item(*a, scr, it, lane); } };
#ifndef CONVERT_IN_SEAMS
#define CONVERT_IN_SEAMS 1
#endif
__device__ __forceinline__ void p0_prologue(Frame& F, const Args& a) {
    unsigned char* ws = a.ws;
    LAS float* scr = (LAS float*)(F.lds + RING_OFF + F.wave * 16384);
    const int gw = F.vcu * NWAVES + F.wave, NGW = F.G * NWAVES;
    const float* x = a.in[0];
    for (int it = gw; it < (CONVERT_IN_SEAMS ? IT_OUT : IT_END); it += NGW) convert_item(a, scr, it, F.lane);
    float* ssq = (float*)(ws + WS_SSQ); bf16* xb = (bf16*)(ws + WS_XB);
    for (int m = gw; m < T; m += NGW) {
        const GAS f32x4* xr = (const GAS f32x4*)(x + (size_t)m * D) + F.lane; f32x4 v[4]; float s = 0.f;
#pragma unroll
        for (int j = 0; j < 4; ++j) { v[j] = xr[64 * j]; s += (v[j].x * v[j].x + v[j].y * v[j].y) + (v[j].z * v[j].z + v[j].w * v[j].w); }
        s = wave_sum(s);
        GAS unsigned long long* o8 = (GAS unsigned long long*)(xb + (size_t)m * D) + F.lane;
#pragma unroll
        for (int j = 0; j < 4; ++j) o8[64 * j] = (unsigned long long)pk2(v[j].x, v[j].y) | ((unsigned long long)pk2(v[j].z, v[j].w) << 32);
        if (F.lane == 0) ssq[m] = s;
    }
    if (gw == NGW - 1) { GAS v4u* p = (GAS v4u*)(ws + WS_XB - 4096); for (int i = F.lane; i < 256; i += 64) p[i] = (v4u){0u, 0u, 0u, 0u}; }
    if (gw < NH) {
        const int h = gw; const float* rel = a.in[1];
        float gqm = fabsf(a.in[10][F.lane]), gkm = fabsf(a.in[11][F.lane]), rb = F.lane < 32 ? rel[F.lane * 16 + h] : -1e30f;
#pragma unroll
        for (int o = 1; o < 64; o <<= 1) { gqm = fmaxf(gqm, __shfl_xor(gqm, o)); gkm = fmaxf(gkm, __shfl_xor(gkm, o)); rb = fmaxf(rb, __shfl_xor(rb, o)); }
        const float Mh = 8.0f * gqm * gkm * LOG2E * 1.02f + rb * LOG2E;
        if (F.lane == 0) ((float*)(ws + WS_MH))[h] = Mh;
        float* rtab = (float*)(ws + WS_RT) + h * 3 * 256;
        for (int i = F.lane; i < 3 * 256; i += 64) { const int br = i / 256, xx = i % 256, jrel = 191 - xx, dil = br == 0 ? 1 : (br == 1 ? 4 : 16);
            rtab[i] = (jrel >= 0 && jrel <= 128) ? rel[t5_bucket(jrel * dil) * 16 + h] * LOG2E - Mh : -1e30f; }
        float* bias = (float*)(ws + WS_BIAS);
        for (int i = F.lane; i < 3 * 129; i += 64) { const int br = i / 129, j = i % 129, dil = br == 0 ? 1 : (br == 1 ? 4 : 16); bias[(br * 129 + j) * 16 + h] = rel[t5_bucket(j * dil) * 16 + h] * LOG2E; }
    }
}


typedef unsigned u32x4_t __attribute__((ext_vector_type(4)));
typedef float f32x2_t __attribute__((ext_vector_type(2))); typedef __bf16 bf16x2_t __attribute__((ext_vector_type(2)));
__device__ __forceinline__ unsigned cvtpk_c(float lo, float hi) { f32x2_t v = {lo, hi}; bf16x2_t b = __builtin_convertvector(v, bf16x2_t); return __builtin_bit_cast(unsigned, b); }
typedef unsigned u32x2_t __attribute__((ext_vector_type(2)));
__device__ __forceinline__ void ld8(const bf16* p, float (&f)[8]) { const u32x4_t v = *(const u32x4_t*)p;
#pragma unroll
    for (int i = 0; i < 4; ++i) { f[2 * i] = __uint_as_float(v[i] << 16); f[2 * i + 1] = __uint_as_float(v[i] & 0xffff0000u); } }
__device__ __forceinline__ u32x4_t pk8(const float (&f)[8]) { u32x4_t w; w.x = pg8::cvt_pk_bf16(f[0], f[1]); w.y = pg8::cvt_pk_bf16(f[2], f[3]); w.z = pg8::cvt_pk_bf16(f[4], f[5]); w.w = pg8::cvt_pk_bf16(f[6], f[7]); return w; }
__device__ __forceinline__ void unpk8(const u32x4_t v, float (&f)[8]) {
#pragma unroll
    for (int i = 0; i < 4; ++i) { f[2 * i] = __uint_as_float(v[i] << 16); f[2 * i + 1] = __uint_as_float(v[i] & 0xffff0000u); } }
template <int K>
__device__ __forceinline__ void pooled_part(const bf16* __restrict__ pin, int tl0, LAS unsigned char* dst, int pitch) {
    u32x4_t hraw[K - 1], araw[8];
#pragma unroll
    for (int j = 1; j < K; ++j) hraw[j - 1] = *(const u32x4_t*)(pin - (size_t)((tl0 - j >= 0) ? j : 0) * EVEN_IN);
#pragma unroll
    for (int i = 0; i < 8; ++i) araw[i] = *(const u32x4_t*)(pin + (size_t)i * EVEN_IN);
    float sm[8];
#pragma unroll
    for (int e = 0; e < 8; ++e) sm[e] = 0.f;
#pragma unroll
    for (int j = 1; j < K; ++j) { const bool ok = tl0 - j >= 0;
#pragma unroll
        for (int q = 0; q < 4; ++q) hraw[j - 1][q] = ok ? hraw[j - 1][q] : 0u;
        float a[8]; unpk8(hraw[j - 1], a);
#pragma unroll
        for (int e = 0; e < 8; ++e) sm[e] += a[e]; }
#pragma unroll
    for (int i = 0; i < 8; ++i) { const int tl = tl0 + i; float a[8], y[8]; unpk8(araw[i], a);
#pragma unroll
        for (int e = 0; e < 8; ++e) sm[e] += a[e];
        const float inv = (tl + 1 >= K) ? (1.0f / (float)K) : __builtin_amdgcn_rcpf((float)(tl + 1));
#pragma unroll
        for (int e = 0; e < 8; ++e) y[e] = sm[e] * inv - a[e];
        *(LAS u32x4_t*)(dst + i * pitch) = pk8(y);
        if (i < 7) { float r[8]; if (i + 1 - K >= 0) unpk8(araw[i + 1 - K >= 0 ? i + 1 - K : 0], r); else unpk8(hraw[(K - 2 - i) >= 0 ? (K - 2 - i) : 0], r);
#pragma unroll
            for (int e = 0; e < 8; ++e) sm[e] -= r[e]; } }
}
__device__ __forceinline__ void mixer_phase(Frame& F, const bf16* __restrict__ proj, const float* __restrict__ cw, const bf16* __restrict__ wpool, bf16* mix) {
    constexpr int PITCH = 1040;
    LAS unsigned char* P = F.lds + RING_OFF;
    const int tid = F.tid, cc = tid & 63, tg = tid >> 6, c0 = 8 * cc;
    for (int u = F.vcu; u < T / 64; u += F.G) {
        const int t0 = u * 64 + 8 * tg; const int tl0 = t0 & (SEQ - 1);
        const bf16* pr = proj + (size_t)t0 * EVEN_IN;
        {
            float w0[8], w1[8], w2[8];
#pragma unroll
            for (int e = 0; e < 8; ++e) { w0[e] = cw[c0 + e]; w1[e] = cw[AW + c0 + e]; w2[e] = cw[2 * AW + c0 + e]; }
            float pm2[8], pm1[8];
#pragma unroll
            for (int e = 0; e < 8; ++e) { pm2[e] = 0.f; pm1[e] = 0.f; }
            if (tl0 >= 2) { float a[8], c[8]; ld8(pr - 2 * EVEN_IN + c0, a); ld8(pr - 2 * EVEN_IN + 2 * AW + c0, c);
#pragma unroll
                for (int e = 0; e < 8; ++e) pm2[e] = a[e] * c[e];
                ld8(pr - EVEN_IN + c0, a); ld8(pr - EVEN_IN + 2 * AW + c0, c);
#pragma unroll
                for (int e = 0; e < 8; ++e) pm1[e] = a[e] * c[e]; }
#pragma unroll
            for (int j = 0; j < 8; ++j) { float a[8], c[8], gb[8], y[8]; ld8(pr + j * EVEN_IN + c0, a); ld8(pr + j * EVEN_IN + 2 * AW + c0, c); ld8(pr + j * EVEN_IN + AW + c0, gb);
#pragma unroll
                for (int e = 0; e < 8; ++e) { const float pc = a[e] * c[e]; y[e] = gb[e] * (w0[e] * pm2[e] + w1[e] * pm1[e] + w2[e] * pc); pm2[e] = pm1[e]; pm1[e] = pc; }
                *(u32x4_t*)(mix + (size_t)(t0 + j) * D + c0) = pk8(y); }
        }
        {
            const int g = F.wave >> 1, tgp = (F.wave & 1) * 4 + (F.lane >> 4), c0p = 8 * (16 * g + (F.lane & 15));
            const int t0p = u * 64 + 8 * tgp, tl0p = t0p & (SEQ - 1);
            const bf16* pin = proj + (size_t)t0p * EVEN_IN + 3 * AW + c0p; LAS unsigned char* dst = P + (8 * tgp) * PITCH + c0p * 2;
            if (g == 0) pooled_part<2>(pin, tl0p, dst, PITCH); else if (g == 1) pooled_part<4>(pin, tl0p, dst, PITCH); else if (g == 2) pooled_part<8>(pin, tl0p, dst, PITCH); else pooled_part<16>(pin, tl0p, dst, PITCH);
        }
        {
            const int g = F.wave >> 1, th = F.wave & 1, fr = F.lane & 15, fq = F.lane >> 4;
            const bf16* wb = wpool + (size_t)g * 128 * 128 + (size_t)fr * 128 + 8 * fq;
            __builtin_amdgcn_sched_barrier(0);
            pg8::bf16x8 bfa[8][4];
#pragma unroll
            for (int n = 0; n < 6; ++n)
#pragma unroll
                for (int ks = 0; ks < 4; ++ks) bfa[n][ks] = *(const pg8::bf16x8*)(wb + (size_t)n * 16 * 128 + 32 * ks);
            __syncthreads();
            pg8::bf16x8 af[2][4];
#pragma unroll
            for (int m = 0; m < 2; ++m)
#pragma unroll
                for (int ks = 0; ks < 4; ++ks) af[m][ks] = *(const LAS pg8::bf16x8*)(P + (32 * th + 16 * m + fr) * PITCH + (128 * g + 32 * ks + 8 * fq) * 2);
#pragma unroll
            for (int n = 6; n < 8; ++n)
#pragma unroll
                for (int ks = 0; ks < 4; ++ks) bfa[n][ks] = *(const pg8::bf16x8*)(wb + (size_t)n * 16 * 128 + 32 * ks);
            bf16* orow = mix + (size_t)(u * 64 + 32 * th + fr) * D + AW + 128 * g + 4 * fq;
#pragma unroll
            for (int n = 0; n < 8; ++n) {
                pg8::f32x4 a0 = {0.f, 0.f, 0.f, 0.f}, a1 = a0;
#pragma unroll
                for (int ks = 0; ks < 4; ++ks) { a0 = __builtin_amdgcn_mfma_f32_16x16x32_bf16(bfa[n][ks], af[0][ks], a0, 0, 0, 0); a1 = __builtin_amdgcn_mfma_f32_16x16x32_bf16(bfa[n][ks], af[1][ks], a1, 0, 0, 0); }
                u32x2_t w; w.x = pg8::cvt_pk_bf16(a0[0], a0[1]); w.y = pg8::cvt_pk_bf16(a0[2], a0[3]); *(u32x2_t*)(orow + 16 * n) = w;
                w.x = pg8::cvt_pk_bf16(a1[0], a1[1]); w.y = pg8::cvt_pk_bf16(a1[2], a1[3]); *(u32x2_t*)(orow + (size_t)16 * D + 16 * n) = w; }
        }
        __syncthreads();
    }
}

namespace att {
constexpr int OPB = 136, VP = 160, NTAB = 256;
constexpr int LDS_TAB = 0, LDS_V = 3 * NTAB * 4, V_BYTES = 32 * VP, LDS_L = LDS_V + 8 * V_BYTES, LDS_O = LDS_L + 2048, LDS_END = LDS_O + 512 * OPB;
static_assert(LDS_V % 16 == 0 && LDS_O % 16 == 0 && LDS_END <= RING_BYTES, "attention LDS map");
typedef short v4i16_t __attribute__((ext_vector_type(4)));
__device__ __forceinline__ v4i16_t vtr(const LAS unsigned char* p) { return __builtin_amdgcn_ds_read_tr16_b64_v4i16((LAS v4i16_t*)p); }
struct KV { pg8::bf16x8 k[2][2]; u32x4_t v[4]; };
__device__ __forceinline__ pg8::f32x4 bf4_to_f32(u32x2_t w) { return (pg8::f32x4){__uint_as_float(w.x << 16), __uint_as_float(w.x & 0xffff0000u), __uint_as_float(w.y << 16), __uint_as_float(w.y & 0xffff0000u)}; }
template <int MODE, int SH, bool CLAMP, int NT>
__device__ __forceinline__ void item(const bf16* __restrict__ qkv, bf16* __restrict__ ao, LAS unsigned char* lds, int wave, int lane, int b, int h, int p0, int rel) {
    constexpr int DIL = 1 << SH, NS = 4 + NT / 2;
    { int l_ = threadIdx.x & 63; asm volatile("" : "+v"(l_)); lane = l_; }
    const int q = lane & 15, g4 = lane >> 4;
    const int base_pos = p0 + rel, res = base_pos & (DIL - 1), i0 = base_pos >> SH, kmin = 128 - i0;
    const size_t rowbase = (size_t)b * SEQ;
    const bf16* hq = qkv + (size_t)(b * NH + h) * SEQ * HD;
    const bf16* qp = hq + (size_t)(base_pos + DIL * q) * HD + 8 * g4;
    pg8::bf16x8 qf[NT][2];
#pragma unroll
    for (int t = 0; t < NT; ++t) { qf[t][0] = *(const pg8::bf16x8*)(qp + (size_t)t * 16 * DIL * HD); qf[t][1] = *(const pg8::bf16x8*)(qp + (size_t)t * 16 * DIL * HD + 32); }
    const bf16* kbase = hq + (size_t)T * D + 8 * g4;
    const bf16* vbase = hq + (size_t)2 * T * D + 8 * (lane & 7);
    LAS unsigned char* vbuf = lds + LDS_V + wave * V_BYTES;
    LAS unsigned char* vw = vbuf + (lane >> 3) * VP + (lane & 7) * 16;
    const LAS unsigned char* vr = vbuf + (4 * g4 + (q >> 2)) * VP + (q & 3) * 8;
    const LAS float* tab = (const LAS float*)(lds + LDS_TAB) + (SH == 4 ? 2 : (SH == 2 ? 1 : 0)) * NTAB + (15 - q + 4 * g4);
    asm volatile("" : "+v"(tab), "+v"(vw), "+v"(vr));
    pg8::f32x4 o[NT][4]; float lsum[NT];
#pragma unroll
    for (int t = 0; t < NT; ++t) { lsum[t] = 0.f;
#pragma unroll
        for (int dt = 0; dt < 4; ++dt) o[t][dt] = (pg8::f32x4){0.f, 0.f, 0.f, 0.f}; }
    const char* kb_u = (const char*)(hq + (size_t)T * D); const char* vb_u = (const char*)(hq + (size_t)2 * T * D);
    const unsigned koff0 = (unsigned)(((res + ((i0 - 128 + q) << SH)) * HD + 8 * g4) * 2);
    const unsigned voff0 = (unsigned)(((res + ((i0 - 128 + (lane >> 3)) << SH)) * HD + 8 * (lane & 7)) * 2);
    auto load = [&](int st, KV& d) {
#pragma unroll
        for (int j = 0; j < 2; ++j) { const char* kp;
            if (CLAMP) { int ik = i0 - 128 + 32 * st + 16 * j + q; ik = ik < 0 ? 0 : ik; kp = kb_u + (size_t)(unsigned)(((res + (ik << SH)) * HD + 8 * g4) * 2); }
            else kp = kb_u + (size_t)(((32 * st + 16 * j) << SH) * HD * 2) + (size_t)koff0;
            d.k[j][0] = *(const pg8::bf16x8*)kp; d.k[j][1] = *(const pg8::bf16x8*)(kp + 64); }
#pragma unroll
        for (int i = 0; i < 4; ++i) { const char* vp;
            if (CLAMP) { int ik = i0 - 128 + 32 * st + 8 * i + (lane >> 3); ik = ik < 0 ? 0 : ik; vp = vb_u + (size_t)(unsigned)(((res + (ik << SH)) * HD + 8 * (lane & 7)) * 2); }
            else vp = vb_u + (size_t)(((32 * st + 8 * i) << SH) * HD * 2) + (size_t)voff0;
            d.v[i] = *(const u32x4_t*)vp; }
    };
    KV cur; load(0, cur);
#pragma unroll
    for (int st = 0; st < NS; ++st) {
#pragma unroll
        for (int i = 0; i < 4; ++i) *(LAS u32x4_t*)(vw + 8 * i * VP) = cur.v[i];
        asm volatile("" ::: "memory");
        KV nxt; if (st < NS - 1) { load(st + 1, nxt); __builtin_amdgcn_sched_barrier(0); }
        pg8::bf16x8 pb[NT];
        const LAS float* tabs = tab + 32 * st; asm volatile("" : "+v"(tabs));
        pg8::f32x4 bq[2];
        { const LAS float* tabt = tabs + 16 * 3; if (NT > 2) asm volatile("" : "+v"(tabt));
#pragma unroll
          for (int j = 0; j < 2; ++j) if (2 * st + j >= 0 && 2 * st + j <= 8) bq[j] = (pg8::f32x4){tabt[16 * j], tabt[16 * j + 1], tabt[16 * j + 2], tabt[16 * j + 3]}; }
#pragma unroll
        for (int t = 0; t < NT; ++t) { pg8::f32x4 sT[2], bc[2]; bc[0] = bq[0]; bc[1] = bq[1];
            if (t + 1 < NT) { const LAS float* tabt = tabs + 16 * (3 - (t + 1)); if (NT > 2) asm volatile("" : "+v"(tabt));
#pragma unroll
                for (int j = 0; j < 2; ++j) if (2 * st + j >= t + 1 && 2 * st + j <= t + 9) bq[j] = (pg8::f32x4){tabt[16 * j], tabt[16 * j + 1], tabt[16 * j + 2], tabt[16 * j + 3]}; }
#pragma unroll
            for (int j = 0; j < 2; ++j) { if (2 * st + j >= t && 2 * st + j <= t + 8) {
                sT[j] = __builtin_amdgcn_mfma_f32_16x16x32_bf16(cur.k[j][0], qf[t][0], bc[j], 0, 0, 0);
                sT[j] = __builtin_amdgcn_mfma_f32_16x16x32_bf16(cur.k[j][1], qf[t][1], sT[j], 0, 0, 0); } }
            float p[2][4];
#pragma unroll
            for (int j = 0; j < 2; ++j)
#pragma unroll
                for (int r = 0; r < 4; ++r) { if (2 * st + j >= t && 2 * st + j <= t + 8) { const int kk = 32 * st + 16 * j + 4 * g4 + r; float sv = sT[j][r]; if (CLAMP) sv = kk < kmin ? -1e30f : sv;
                    p[j][r] = __builtin_amdgcn_exp2f(sv); lsum[t] += p[j][r]; } else p[j][r] = 0.f; }
            u32x4_t pw; pw.x = cvtpk_c(p[0][0], p[0][1]); pw.y = cvtpk_c(p[0][2], p[0][3]); pw.z = cvtpk_c(p[1][0], p[1][1]); pw.w = cvtpk_c(p[1][2], p[1][3]);
            pb[t] = __builtin_bit_cast(pg8::bf16x8, pw); if (NT > 2) { asm volatile("" : "+v"(lsum[t])); __builtin_amdgcn_sched_barrier(0); } }
#pragma unroll
        for (int dt = 0; dt < 4; ++dt) { const v4i16_t lo = vtr(vr + dt * 32), hi = vtr(vr + 16 * VP + dt * 32);
            const pg8::bf16x8 va = (pg8::bf16x8){lo[0], lo[1], lo[2], lo[3], hi[0], hi[1], hi[2], hi[3]};
#pragma unroll
            for (int t = 0; t < NT; ++t) if (2 * st + 1 >= t && 2 * st <= t + 8) o[t][dt] = __builtin_amdgcn_mfma_f32_16x16x32_bf16(va, pb[t], o[t][dt], 0, 0, 0); }
        asm volatile("" ::: "memory"); __builtin_amdgcn_sched_barrier(0);
        if (st < NS - 1) cur = nxt;
    }
#pragma unroll
    for (int t = 0; t < NT; ++t) { float ls = lsum[t]; ls += __shfl_xor(ls, 16); ls += __shfl_xor(ls, 32);
        const int posu = rel + DIL * (16 * t + q), slot = (posu & ~0xF) | ((posu ^ (posu >> 4)) & 0xF);
        LAS unsigned char* Ol = lds + LDS_O + slot * OPB + 8 * g4; LAS float* Ll = (LAS float*)(lds + LDS_L) + slot;
        if (MODE == 0) {
#pragma unroll
            for (int dt = 0; dt < 4; ++dt) { u32x2_t w; w.x = cvtpk_c(o[t][dt][0], o[t][dt][1]); w.y = cvtpk_c(o[t][dt][2], o[t][dt][3]); *(LAS u32x2_t*)(Ol + 32 * dt) = w; }
            if (g4 == 0) *Ll = ls;
        } else if (MODE == 1) {
#pragma unroll
            for (int dt = 0; dt < 4; ++dt) { const pg8::f32x4 v = bf4_to_f32(*(LAS u32x2_t*)(Ol + 32 * dt)) + o[t][dt]; u32x2_t w; w.x = cvtpk_c(v[0], v[1]); w.y = cvtpk_c(v[2], v[3]); *(LAS u32x2_t*)(Ol + 32 * dt) = w; }
            if (g4 == 0) *Ll = *Ll + ls;
        } else {
            const float inv = 1.0f / (*Ll + ls);
            bf16* op = ao + (rowbase + p0 + posu) * D + h * HD + 4 * g4;
#pragma unroll
            for (int dt = 0; dt < 4; ++dt) { const pg8::f32x4 v = (bf4_to_f32(*(LAS u32x2_t*)(Ol + 32 * dt)) + o[t][dt]) * inv;
                u32x2_t w; w.x = cvtpk_c(v[0], v[1]); w.y = cvtpk_c(v[2], v[3]); *(u32x2_t*)(op + 16 * dt) = w; }
        }
    }
}
}
__device__ __forceinline__ void attn_phase(Frame& F, const bf16* qkv, const float* rt, bf16* ao) {
    LAS unsigned char* lds = F.lds + RING_OFF;
    const int nunits = BATCH * NH * (SEQ / 512);
    for (int i = 0; i * F.G < nunits; ++i) {
        int bh, blk;
        if (F.G == 256) { const int x = F.vcu >> 5, loc = F.vcu & 31; bh = 8 * x + 4 * i + (loc >> 3); blk = loc & 7; }
        else { const int u = i * F.G + F.vcu; if (u >= nunits) break; bh = u >> 3; blk = u & 7; }
        const int b = bh / NH, h = bh % NH, p0 = blk * 512;
        for (int j = F.tid; j < 3 * att::NTAB; j += NWAVES * 64) ((LAS float*)(lds + att::LDS_TAB))[j] = rt[h * 3 * att::NTAB + j];
        __syncthreads();
#pragma unroll 1
        for (int k = 0; k < 2; ++k) { const int g = 2 * F.wave + k;
            if (((p0 + g) >> 4) < 128) att::item<0, 4, true, 2>(qkv, ao, lds, F.wave, F.lane, b, h, p0, g); else att::item<0, 4, false, 2>(qkv, ao, lds, F.wave, F.lane, b, h, p0, g); }
        __syncthreads();
        { const int g = F.wave; const int rel = 256 * (g >> 2) + (g & 3);
            if (((p0 + rel) >> 2) < 128) { att::item<1, 2, true, 2>(qkv, ao, lds, F.wave, F.lane, b, h, p0, rel); att::item<1, 2, true, 2>(qkv, ao, lds, F.wave, F.lane, b, h, p0, rel + 128); }
            else att::item<1, 2, false, 4>(qkv, ao, lds, F.wave, F.lane, b, h, p0, rel); }
        __syncthreads();
        { const int rel = 64 * F.wave;
            if ((p0 + rel) < 128) { att::item<2, 0, true, 2>(qkv, ao, lds, F.wave, F.lane, b, h, p0, rel); att::item<2, 0, true, 2>(qkv, ao, lds, F.wave, F.lane, b, h, p0, rel + 32); }
            else att::item<2, 0, false, 4>(qkv, ao, lds, F.wave, F.lane, b, h, p0, rel); }
        __syncthreads();
    }
}

__global__ void __launch_bounds__(NWAVES * 64, 2) mega_fwd(Args args) {
    extern __shared__ __attribute__((aligned(16))) unsigned char lds[];
    Frame F;
    F.lds = (LAS unsigned char*)lds; F.MISC = (volatile LAS unsigned*)(F.lds + MISC_OFF);
    F.tid = threadIdx.x; F.lane = F.tid & 63; F.wave = __builtin_amdgcn_readfirstlane(F.tid >> 6);
    F.G = gridDim.x; { const int bx = blockIdx.x; F.vcu = (F.G % 8 == 0) ? (bx % 8) * (F.G / 8) + bx / 8 : bx; }
    unsigned char* ws = args.ws; F.ctl = (gu32*)(ws + WS_CTL);
    for (int u = F.tid; u < (LDS_BYTES - LDSCTL_OFF) / 4; u += NWAVES * 64) ((LAS unsigned*)(F.lds + LDSCTL_OFF))[u] = 0u;
    __syncthreads();
    const int lo = args.ph_lo, hi = args.ph_hi; const bool use_bar = (hi - lo) > 1;
    XcdBarrier bar; bar.bar = (unsigned*)(F.ctl + CW_BAR) + args.li * XCD_BAR_WORDS; bar.x = 0; bar.st = nullptr;
    if (use_bar) bar = xcd_barrier_post((unsigned*)(F.ctl + CW_BAR) + args.li * XCD_BAR_WORDS, F.MISC + 8);
#ifndef PHASES_COMPILED
#define PHASES_COMPILED 0x7FF
#endif
#define IN(k) ((((PHASES_COMPILED) >> (k)) & 1) && lo <= (k) && (k) < hi)
#ifndef REP_MASK
#define REP_MASK 0
#endif
#define REPS(k) for (int rep_ = 0; rep_ < ((((REP_MASK) >> (k)) & 1) ? 2 : 1); ++rep_)
#ifndef SEAM_REPS
#define SEAM_REPS 1
#endif
#define SEAM_WORK(k, lo_, hi_) do { if (IN(k) && IN((k) + 1)) { if (CONVERT_IN_SEAMS) { ConvertWork cw_{&args, F.lds + RING_OFF, F.vcu, F.G, F.lane, (lo_), (hi_)}; xcd_barrier_work(bar, F.wave, cw_); } else xcd_barrier(bar); } } while (0)
#define SEAM_PLAIN(k) do { if (IN(k) && IN((k) + 1)) { for (int sr_ = 0; sr_ < SEAM_REPS; ++sr_) xcd_barrier(bar); } } while (0)
constexpr int CHUNK = (IT_END - IT_OUT + 7) / 8;
static_assert(IT_UP0 <= IT_OUT + 2 * CHUNK && IT_DN0 <= IT_OUT + 3 * CHUNK && IT_QKV <= IT_OUT + 4 * CHUNK && IT_O <= IT_OUT + 5 * CHUNK && IT_UP1 <= IT_OUT + 7 * CHUNK && IT_DN1 <= IT_OUT + 8 * CHUNK, "conversion deadlines");
#define SEAM(k) do { if ((k) < 8) SEAM_WORK(k, IT_OUT + (k) * CHUNK, (IT_OUT + ((k) + 1) * CHUNK) < IT_END ? (IT_OUT + ((k) + 1) * CHUNK) : IT_END); else SEAM_PLAIN(k); } while (0)
    float* ssq = (float*)(ws + WS_SSQ); float* out = args.out;
    bf16* xb = (bf16*)(ws + WS_XB); bf16* proj = (bf16*)(ws + WS_PROJ); bf16* mix = (bf16*)(ws + WS_MIX); bf16* qkv = (bf16*)(ws + WS_QKV); bf16* ao = (bf16*)(ws + WS_AO); bf16* act = (bf16*)(ws + WS_ACT);
    PG8_LAS unsigned char* ring = F.lds + RING_OFF;

    if (IN(0)) REPS(0) { p0_prologue(F, args); } SEAM(0);
    if (IN(1)) REPS(1) { pg8::Gemm g{xb, (const bf16*)(ws + WS_WIN), T, EVEN_IN, D}; pg8::StaticOrder S; S.init(T, EVEN_IN, F.G, (int)blockIdx.x);
        pg8::EpiRowScale E{proj, EVEN_IN, ssq};
        pg8::gemm_phase<pg8::EpiRowScale, pg8::StaticOrder, true, true>(ring, g, S, E); } SEAM(1);
    if (IN(2)) REPS(2) { mixer_phase(F, proj, args.in[4], (const bf16*)(ws + WS_WPOOL), mix); } SEAM(2);
#define PHASE_UP(pu, l) do { if (IN(pu)) REPS(pu) { pg8::Gemm g{xb, (const bf16*)(ws + WS_WUP) + (size_t)(l) * DFF2 * D, 68 * 256, DFF2, D}; pg8::OverlapOrder S; S.init(68 * 256, DFF2, F.G, (int)blockIdx.x); \
        pg8::EpiConvGlu E{act, ssq + ((l) == 0 ? T : 3 * T), args.in[15] + (size_t)(l) * 3 * DFF2, args.in[16] + (size_t)(l) * DFF2, (PG8_LAS float*)(F.lds + HALO_OFF)}; \
        pg8::gemm_phase<pg8::EpiConvGlu, pg8::OverlapOrder, true, true>(ring, g, S, E); } SEAM(pu); } while (0)
#define PHASE_RES(p, BF, OF, OX, SQ, Aptr, Wptr, Kdim, basefptr, outfptr, xbptr, ssqptr) do { if (IN(p)) { pg8::Gemm g{(Aptr), (Wptr), T, D, (Kdim)}; pg8::StaticOrder S; S.init(T, D, F.G, (int)blockIdx.x); \
        typedef pg8::EpiResidual<BF, OF, OX, SQ> Epi_; Epi_ E{(basefptr), xb, (outfptr), (xbptr), (ssqptr)}; \
        pg8::gemm_phase<Epi_, pg8::StaticOrder, false, true>(ring, g, S, E); } SEAM(p); } while (0)
    PHASE_RES(3, false, false, true, true, mix, (const bf16*)(ws + WS_WOUT), D, (const float*)nullptr, (float*)nullptr, xb, ssq + T);
    PHASE_UP(4, 0);
    PHASE_RES(5, false, false, true, true, act, (const bf16*)(ws + WS_WDN), DFF, (const float*)nullptr, (float*)nullptr, xb, ssq + 2 * T);
    if (IN(6)) REPS(6) { pg8::Gemm g{xb, (const bf16*)(ws + WS_WQKV), T, NQKV, D}; pg8::StaticOrder S; S.init(T, NQKV, F.G, (int)blockIdx.x);
        pg8::EpiQkv E{qkv, ssq + 2 * T, args.in[10], args.in[11]};
        pg8::gemm_phase<pg8::EpiQkv, pg8::StaticOrder, true, true>(ring, g, S, E); } SEAM(6);
    if (IN(7)) REPS(7) { attn_phase(F, qkv, (const float*)(ws + WS_RT), ao); } SEAM(7);
    PHASE_RES(8, false, false, true, true, ao, (const bf16*)(ws + WS_WO), D, (const float*)nullptr, (float*)nullptr, xb, ssq + 3 * T);
    PHASE_UP(9, 1);
    PHASE_RES(10, false, true, false, false, act, (const bf16*)(ws + WS_WDN) + (size_t)D * DFF, DFF, (const float*)nullptr, out, (bf16*)nullptr, (float*)nullptr);
#undef IN
#undef SEAM
}

#ifndef FAST_MASK
#define FAST_MASK 0x7FF
#endif
extern "C" void kernel_launch(void* const* d_in, const int* in_sizes, int n_in, void* d_out, int out_size, void* d_ws, size_t ws_size, hipStream_t stream) {
    static int grid = 0;
    if (grid == 0) {
        if (n_in != 18 || out_size != T * D || ws_size < WS_END) { fprintf(stderr, "kernel_launch: unexpected shapes n_in %d out %d ws %zu\n", n_in, out_size, ws_size); grid = -1; return; }
        int dev = 0, cus = 0;
        if (hipGetDevice(&dev) != hipSuccess || hipDeviceGetAttribute(&cus, hipDeviceAttributeMultiprocessorCount, dev) != hipSuccess) { grid = -1; return; }
        if (hipFuncSetAttribute((const void*)mega_fwd, hipFuncAttributeMaxDynamicSharedMemorySize, LDS_BYTES) != hipSuccess) { fprintf(stderr, "kernel_launch: hipFuncSetAttribute failed\n"); grid = -1; return; }
        (void)hipFuncSetAttribute((const void*)n_gemm_rowscale, hipFuncAttributeMaxDynamicSharedMemorySize, 18 * 4096);
        (void)hipFuncSetAttribute((const void*)n_gemm_residual, hipFuncAttributeMaxDynamicSharedMemorySize, 18 * 4096);
        (void)hipFuncSetAttribute((const void*)n_ffn_up, hipFuncAttributeMaxDynamicSharedMemorySize, 18 * 4096);
        (void)hipFuncSetAttribute((const void*)n_qkv, hipFuncAttributeMaxDynamicSharedMemorySize, 18 * 4096);
        (void)hipGetLastError();
        grid = cus;
    }
    if (grid < 0) return;
    const float* x = (const float*)d_in[0];
    const float* even_norm = (const float*)d_in[2]; const float* w_in = (const float*)d_in[3]; const float* even_cw = (const float*)d_in[4];
    const float* pool_w = (const float*)d_in[5]; const float* pool_s = (const float*)d_in[6]; const float* w_out = (const float*)d_in[7];
    const float* odd_norm = (const float*)d_in[8]; const float* w_qkv = (const float*)d_in[9]; const float* gq = (const float*)d_in[10]; const float* gk = (const float*)d_in[11];
    const float* w_o = (const float*)d_in[12]; const float* ffn_norm = (const float*)d_in[13]; const float* w_up = (const float*)d_in[14];
    const float* ffn_cw = (const float*)d_in[15]; const float* ffn_cb = (const float*)d_in[16]; const float* w_dn = (const float*)d_in[17];
    unsigned char* ws = (unsigned char*)d_ws; float* out = (float*)d_out;
    float* ssq = (float*)(ws + WS_SSQ); float* bias = (float*)(ws + WS_BIAS);
    bf16_t* xb = (bf16_t*)(ws + WS_XB); bf16_t* proj = (bf16_t*)(ws + WS_PROJ); bf16_t* mix = (bf16_t*)(ws + WS_MIX);
    bf16_t* qkv = (bf16_t*)(ws + WS_QKV); bf16_t* ao = (bf16_t*)(ws + WS_AO); bf16_t* act = (bf16_t*)(ws + WS_ACT);
    const size_t LDSB = 18 * 4096;
    (void)hipMemsetAsync(ws + WS_CTL, 0, 1 * MiB, stream);
    Args a{};
    for (int i = 0; i < 18; ++i) a.in[i] = (const float*)d_in[i];
    a.out = out; a.ws = ws;
    const unsigned fast = FAST_MASK;
    int p = 0, li = 0;
    while (p < 11) {
        if ((fast >> p) & 1u) {
            int q = p; while (q < 11 && ((fast >> q) & 1u)) ++q;
            a.ph_lo = p; a.ph_hi = q; a.li = li++;
            hipLaunchKernelGGL(mega_fwd, dim3(grid), dim3(NWAVES * 64), LDS_BYTES, stream, a);
            p = q; continue;
        }
        switch (p) {
            case 0: n_prologue<<<T / 4, 256, 0, stream>>>(x, ssq, xb); n_bias<<<(3 * 129 * 16 + 255) / 256, 256, 0, stream>>>((const float*)d_in[1], bias); break;
            case 1: n_gemm_rowscale<<<dim3(EVEN_IN / 256, T / 16), 256, LDSB, stream>>>(xb, even_norm, w_in, EVEN_IN, D, ssq, proj); break;
            case 2: n_mixer<<<T / 16, 512, 0, stream>>>(proj, even_cw, pool_w, pool_s, mix); break;
            case 3: n_gemm_residual<<<dim3(D / 256, T / 16), 256, LDSB, stream>>>(mix, w_out, D, x, out, xb, ssq + T); break;
            case 4: n_ffn_up<<<dim3(DFF / 256, T / 16), 256, LDSB, stream>>>(xb, ffn_norm, w_up, ssq + T, ffn_cw, ffn_cb, act); break;
            case 5: n_gemm_residual<<<dim3(D / 256, T / 16), 256, LDSB, stream>>>(act, w_dn, DFF, out, out, xb, ssq + 2 * T); break;
            case 6: n_qkv<<<dim3(NQKV / 256, T / 16), 256, LDSB, stream>>>(xb, odd_norm, w_qkv, ssq + 2 * T, gq, gk, qkv); break;
            case 7: n_attn<<<T * NH / 4, 256, 0, stream>>>(qkv, bias, ao); break;
            case 8: n_gemm_residual<<<dim3(D / 256, T / 16), 256, LDSB, stream>>>(ao, w_o, D, out, out, xb, ssq + 3 * T); break;
            case 9: n_ffn_up<<<dim3(DFF / 256, T / 16), 256, LDSB, stream>>>(xb, ffn_norm + D, w_up + (size_t)D * DFF2, ssq + 3 * T, ffn_cw + 3 * DFF2, ffn_cb + DFF2, act); break;
            case 10: n_gemm_residual<<<dim3(D / 256, T / 16), 256, LDSB, stream>>>(act, w_dn + (size_t)DFF * D, DFF, out, out, nullptr, nullptr); break;
        }
        ++p;
    }
}
```

```cpp
#include <hip/hip_runtime.h>
#include <cstdio>
#include <cstdint>

typedef unsigned short bf16_t;
constexpr int BATCH = 4, SEQ = 4096, D = 1024, T = BATCH * SEQ;
constexpr int EVEN_IN = 2048, AW = 512, DFF = 2816, DFF2 = 5632, NH = 16, HD = 64, NQKV = 3072;
constexpr float EPS = 1e-6f;
constexpr float LOG2E = 1.4426950408889634f;

__device__ __forceinline__ float bf2f(bf16_t v) { return __uint_as_float((unsigned)v << 16); }
__device__ __forceinline__ bf16_t f2bf(float f) { unsigned u = __float_as_uint(f); return (bf16_t)((u + 0x7fffu + ((u >> 16) & 1u)) >> 16); }
__device__ __forceinline__ float wave_sum(float v) {
#pragma unroll
    for (int o = 1; o < 64; o <<= 1) v += __shfl_xor(v, o);
    return v;
}

constexpr size_t MiB = 1u << 20;
constexpr size_t WS_CTL = 0;
constexpr size_t WS_SSQ = 64 * 1024;
constexpr size_t WS_BIAS = 512 * 1024;
constexpr size_t WS_XB = 50 * MiB;
constexpr size_t WS_R = 84 * MiB;
constexpr size_t WS_PROJ = WS_R;
constexpr size_t WS_MIX = WS_R + 96 * MiB;
constexpr size_t WS_QKV = WS_R;
constexpr size_t WS_AO = WS_R + 96 * MiB;
constexpr size_t WS_ACT = WS_R;
constexpr size_t WS_END = WS_R + 128 * MiB;

__global__ void __launch_bounds__(256) n_prologue(const float* __restrict__ x, float* ssq, bf16_t* xb) {
    const int wave = (blockIdx.x * 256 + threadIdx.x) >> 6, lane = threadIdx.x & 63;
    if (wave >= T) return;
    const float* xr = x + (size_t)wave * D; float s = 0.f;
    for (int j = lane; j < D; j += 64) { float v = xr[j]; s += v * v; xb[(size_t)wave * D + j] = f2bf(v); }
    s = wave_sum(s);
    if (lane == 0) ssq[wave] = s;
}
__global__ void n_bias(const float* __restrict__ rel, float* bias) {
    const int i = blockIdx.x * blockDim.x + threadIdx.x;
    if (i >= 3 * 129 * 16) return;
    const int h = i % 16, j = (i / 16) % 129, br = i / (16 * 129);
    const int dil = br == 0 ? 1 : (br == 1 ? 4 : 16);
    const int dist = j * dil; int b;
    if (dist < 16) b = dist; else { int l = 16 + (int)(log((double)dist / 16.0) / log(128.0) * 16.0); b = l < 31 ? l : 31; }
    bias[i] = rel[b * 16 + h] * LOG2E;
}

template <int NR>
__device__ __forceinline__ void naive_tile(const bf16_t* __restrict__ A, int K, const int* rows, const float* __restrict__ g,
                                           const float* __restrict__ W, int N, int col, float* acc, float* sA  ) {
    for (int r = 0; r < NR; ++r) acc[r] = 0.f;
    for (int k0 = 0; k0 < K; k0 += 1024) {
        const int kc = (K - k0) < 1024 ? (K - k0) : 1024;
        __syncthreads();
        for (int i = threadIdx.x; i < NR * kc; i += 256) { const int r = i / kc, k = i % kc; const int row = rows[r];
            float v = row >= 0 ? bf2f(A[(size_t)row * K + k0 + k]) : 0.f; if (g) v *= g[k0 + k]; sA[r * 1024 + k] = v; }
        __syncthreads();
        for (int k = 0; k < kc; k += 4) {
            const float w0 = W[(size_t)(k0 + k) * N + col], w1 = W[(size_t)(k0 + k + 1) * N + col], w2 = W[(size_t)(k0 + k + 2) * N + col], w3 = W[(size_t)(k0 + k + 3) * N + col];
#pragma unroll
            for (int r = 0; r < NR; ++r) { const float4 a = *(const float4*)(sA + r * 1024 + k); acc[r] += a.x * w0 + a.y * w1 + a.z * w2 + a.w * w3; }
        }
    }
}

__global__ void __launch_bounds__(256) n_gemm_rowscale(const bf16_t* __restrict__ A, const float* __restrict__ g, const float* __restrict__ W, int N, int K,
                                                        const float* __restrict__ ssq, bf16_t* out) {
    extern __shared__ float sA[];
    __shared__ int rows[16];
    const int row0 = blockIdx.y * 16, col = blockIdx.x * 256 + threadIdx.x;
    if (threadIdx.x < 16) rows[threadIdx.x] = row0 + threadIdx.x;
    __syncthreads();
    float acc[16];
    naive_tile<16>(A, K, rows, g, W, N, col, acc, sA);
    for (int r = 0; r < 16; ++r) { const float rs = rsqrtf(ssq[row0 + r] * (1.f / D) + EPS); out[(size_t)(row0 + r) * N + col] = f2bf(acc[r] * rs); }
}
__global__ void __launch_bounds__(256) n_gemm_residual(const bf16_t* __restrict__ A, const float* __restrict__ W, int K,
                                                        const float* base, float* out, bf16_t* xb, float* ssq_next) {
    extern __shared__ float sA[];
    __shared__ int rows[16];
    const int row0 = blockIdx.y * 16, col = blockIdx.x * 256 + threadIdx.x;
    if (threadIdx.x < 16) rows[threadIdx.x] = row0 + threadIdx.x;
    __syncthreads();
    float acc[16];
    naive_tile<16>(A, K, rows, nullptr, W, D, col, acc, sA);
    for (int r = 0; r < 16; ++r) { const size_t o = (size_t)(row0 + r) * D + col; const float v = base[o] + acc[r]; out[o] = v;
        if (xb) xb[o] = f2bf(v);
        if (ssq_next) { const float s = wave_sum(v * v); if ((threadIdx.x & 63) == 0) atomicAdd(ssq_next + row0 + r, s); } }
}
__global__ void __launch_bounds__(256) n_ffn_up(const bf16_t* __restrict__ A, const float* __restrict__ g, const float* __restrict__ W,
                                                 const float* __restrict__ ssq, const float* __restrict__ cw, const float* __restrict__ cb, bf16_t* act) {
    extern __shared__ float sA[];
    __shared__ int rows[18];
    const int row0 = blockIdx.y * 16, c = blockIdx.x * 256 + threadIdx.x;
    if (threadIdx.x < 18) { const int r = row0 - 2 + threadIdx.x; rows[threadIdx.x] = ((row0 % SEQ) == 0 && threadIdx.x < 2) ? -1 : r; }
    __syncthreads();
    float ag[18], au[18];
    naive_tile<18>(A, D, rows, g, W, DFF2, c, ag, sA);
    naive_tile<18>(A, D, rows, g, W, DFF2, c + DFF, au, sA);
    for (int r = 0; r < 18; ++r) { const float rs = rows[r] >= 0 ? rsqrtf(ssq[rows[r]] * (1.f / D) + EPS) : 0.f; ag[r] *= rs; au[r] *= rs; }
    const float g0 = cw[c], g1 = cw[DFF2 + c], g2 = cw[2 * DFF2 + c], gb = cb[c];
    const float u0 = cw[c + DFF], u1 = cw[DFF2 + c + DFF], u2 = cw[2 * DFF2 + c + DFF], ub = cb[c + DFF];
    for (int r = 0; r < 16; ++r) {
        const float gt = g0 * ag[r] + g1 * ag[r + 1] + g2 * ag[r + 2] + gb;
        const float ut = u0 * au[r] + u1 * au[r + 1] + u2 * au[r + 2] + ub;
        const float s = gt / (1.f + __expf(-gt));
        act[(size_t)(row0 + r) * DFF + c] = f2bf(s * ut);
    }
}
__global__ void __launch_bounds__(256) n_qkv(const bf16_t* __restrict__ A, const float* __restrict__ g, const float* __restrict__ W,
                                              const float* __restrict__ ssq, const float* __restrict__ gq, const float* __restrict__ gk, bf16_t* qkv) {
    extern __shared__ float sA[];
    __shared__ int rows[16];
    const int row0 = blockIdx.y * 16, col = blockIdx.x * 256 + threadIdx.x;
    if (threadIdx.x < 16) rows[threadIdx.x] = row0 + threadIdx.x;
    __syncthreads();
    float acc[16];
    naive_tile<16>(A, D, rows, g, W, NQKV, col, acc, sA);
    const int part = col / D;
    for (int r = 0; r < 16; ++r) {
        const float rs = rsqrtf(ssq[row0 + r] * (1.f / D) + EPS); float y = acc[r] * rs;
        if (part < 2) { const float ms = wave_sum(y * y) * (1.f / HD); y = y * rsqrtf(ms + EPS) * (part == 0 ? gq[col & 63] * (0.125f * LOG2E) : gk[col & 63]); }
        qkv[(size_t)(row0 + r) * NQKV + col] = f2bf(y);
    }
}
__global__ void __launch_bounds__(512) n_mixer(const bf16_t* __restrict__ proj, const float* __restrict__ cw, const float* __restrict__ pw,
                                                const float* __restrict__ ps, bf16_t* mix) {
    __shared__ float pooled[16][512];
    const int t0 = blockIdx.x * 16, c = threadIdx.x;
    for (int r = 0; r < 16; ++r) {
        const int t = t0 + r, tl = t % SEQ;
        float conv = 0.f;
        for (int i = 0; i < 3; ++i) { const int tt = tl - 2 + i; if (tt >= 0) { const size_t o = (size_t)(t - 2 + i) * EVEN_IN; conv += cw[i * AW + c] * (bf2f(proj[o + 2 * AW + c]) * bf2f(proj[o + c])); } }
        const float ya = bf2f(proj[(size_t)t * EVEN_IN + AW + c]) * conv;
        mix[(size_t)t * D + c] = f2bf(ya);
        const int gI = c >> 7, k = 2 << gI; const int cnt = (tl + 1) < k ? (tl + 1) : k; float s = 0.f;
        for (int j = 0; j < cnt; ++j) s += bf2f(proj[(size_t)(t - j) * EVEN_IN + 3 * AW + c]);
        pooled[r][c] = s / (float)cnt - bf2f(proj[(size_t)t * EVEN_IN + 3 * AW + c]);
    }
    __syncthreads();
    const int gI = c >> 7, d = c & 127;
    float acc[16];
    for (int r = 0; r < 16; ++r) acc[r] = 0.f;
    for (int cc = 0; cc < 128; ++cc) { const float w = pw[(size_t)(gI * 128 + cc) * 128 + d];
        for (int r = 0; r < 16; ++r) acc[r] += pooled[r][gI * 128 + cc] * w; }
    for (int r = 0; r < 16; ++r) mix[(size_t)(t0 + r) * D + AW + c] = f2bf(acc[r] * ps[c]);
}
__global__ void __launch_bounds__(256) n_attn(const bf16_t* __restrict__ qkv, const float* __restrict__ bias, bf16_t* ao) {
    __shared__ float sp[4][3 * 129 + 5];
    __shared__ float sq[4][64];
    const int w = threadIdx.x >> 6, lane = threadIdx.x & 63;
    const int item = blockIdx.x * 4 + w; const int t = item / NH, h = item % NH; const int tl = t % SEQ;
    sq[w][lane] = bf2f(qkv[(size_t)t * NQKV + h * HD + lane]);
    __syncthreads();
    float mx = -1e30f;
    for (int i = lane; i < 3 * 129; i += 64) {
        const int br = i / 129, j = i % 129, dil = br == 0 ? 1 : (br == 1 ? 4 : 16); const int tk = tl - j * dil;
        float s = -1e30f;
        if (tk >= 0) { const bf16_t* kr = qkv + (size_t)(t - j * dil) * NQKV + D + h * HD; float a = 0.f;
            for (int e = 0; e < 64; ++e) a += sq[w][e] * bf2f(kr[e]);
            s = a + bias[(br * 129 + j) * 16 + h]; }
        sp[w][i] = s; mx = fmaxf(mx, s);
    }
#pragma unroll
    for (int o = 1; o < 64; o <<= 1) mx = fmaxf(mx, __shfl_xor(mx, o));
    __syncthreads();
    float l = 0.f, o = 0.f;
    for (int i = 0; i < 3 * 129; ++i) {
        const float s = sp[w][i]; if (s < -1e29f) continue;
        const int br = i / 129, j = i % 129, dil = br == 0 ? 1 : (br == 1 ? 4 : 16);
        const float p = exp2f(s - mx); l += p;
        o += p * bf2f(qkv[(size_t)(t - j * dil) * NQKV + 2 * D + h * HD + lane]);
    }
    ao[(size_t)t * D + h * HD + lane] = f2bf(o / l);
}


namespace pg8 {
#define PG8_LAS __attribute__((address_space(3)))
typedef unsigned short bf16_t;
typedef short bf16x8 __attribute__((ext_vector_type(8)));
typedef float f32x4 __attribute__((ext_vector_type(4)));
typedef unsigned u32x4 __attribute__((ext_vector_type(4)));
constexpr int BM = 256, BK = 64, HALF = 128, HTB = HALF * BK * 2  , STAGE_BYTES = 8 * HTB, NXCD = 8, WGM = 8;

__host__ __device__ __forceinline__ int lds_byte(int r, int c) { const int st = (r >> 4) * 2 + (c >> 5), rr = r & 15, cc = c & 31, ob = rr * 64 + cc * 2; return st * 1024 + (ob ^ (((ob >> 9) & 1) << 5)); }
__host__ __device__ __forceinline__ void stage_rc(int b, int& R, int& C) { const int st = b / 1024, sb = b % 1024, swz = sb ^ (((sb >> 9) & 1) << 5); R = (st >> 1) * 16 + swz / 64; C = (st & 1) * 32 + (swz % 64) / 2; }
__host__ __device__ __forceinline__ int perm32(int rho) { const int n = rho >> 4, i = rho & 15; return 8 * (i >> 2) + 4 * n + (i & 3); }

struct Unit { int pm, pn; };
struct Gemm { const bf16_t* A; const bf16_t* Bt; int M, N, K; };

struct StaticOrder {
    int nM, nN, nwg, G, c;
    __host__ __device__ void init(int M, int N, int G_, int c_) { nM = M / BM; nN = N / BM; nwg = nM * nN; G = G_; c = c_; }
    __host__ __device__ bool next(int i, Unit& u) const {
        const long L = (long)i * G + c; if (L >= nwg) return false;
        int wgid = (int)L; { const int q = nwg / NXCD, r = nwg % NXCD, xcd = wgid % NXCD, off = wgid / NXCD; wgid = (xcd < r ? xcd * (q + 1) : r * (q + 1) + (xcd - r) * q) + off; }
        const int nig = WGM * nN, gid = wgid / nig, fm = gid * WGM, gsz = (nM - fm) < WGM ? (nM - fm) : WGM;
        u.pm = fm + ((wgid % nig) % gsz); u.pn = (wgid % nig) / gsz; return true;
    }
    __device__ __forceinline__ long a_row(const Unit& u) const { return (long)u.pm * BM; }
    __device__ __forceinline__ void a_ready(const Unit&) const {}
    __device__ __forceinline__ void done(const Unit&) const {}
};

typedef float f32x2c_t __attribute__((ext_vector_type(2))); typedef __bf16 bf16x2c_t __attribute__((ext_vector_type(2)));
__device__ __forceinline__ unsigned cvt_pk_bf16(float lo, float hi) { f32x2c_t v = {lo, hi}; bf16x2c_t b = __builtin_convertvector(v, bf16x2c_t); return __builtin_bit_cast(unsigned, b); }
typedef unsigned u32x2 __attribute__((ext_vector_type(2)));
__device__ __forceinline__ float row_rs(const float* ssq, int row) { return rsqrtf(ssq[row] * (1.0f / 1024.0f) + 1e-6f); }

struct EpiRowScale {
    static constexpr bool PERM = true, AFTER_DRAIN = false, PREFETCH = false;
    bf16_t* O; int ldc; const float* ssq;
    __device__ __forceinline__ void operator()(const f32x4 (&acc)[2][2][4][2], const Unit& u, int wr, int wc, int fr, int fq) const {
        const int row0 = u.pm * BM + wr * 64 + fr, col0 = u.pn * BM + wc * 32 + 8 * fq;
        float rsv[2][4];
#pragma unroll
        for (int ai = 0; ai < 2; ++ai)
#pragma unroll
            for (int m = 0; m < 4; ++m) rsv[ai][m] = ssq[row0 + ai * HALF + m * 16];
#pragma unroll
        for (int ai = 0; ai < 2; ++ai)
#pragma unroll
            for (int m = 0; m < 4; ++m) { const int row = row0 + ai * HALF + m * 16; const float rs = rsqrtf(rsv[ai][m] * (1.0f / 1024.0f) + 1e-6f); bf16_t* rowp = O + (size_t)row * ldc + col0;
#pragma unroll
                for (int bj = 0; bj < 2; ++bj) { const f32x4 v0 = acc[ai][bj][m][0] * rs, v1 = acc[ai][bj][m][1] * rs;
                    u32x4 w; w.x = cvt_pk_bf16(v0[0], v0[1]); w.y = cvt_pk_bf16(v0[2], v0[3]); w.z = cvt_pk_bf16(v1[0], v1[1]); w.w = cvt_pk_bf16(v1[2], v1[3]);
                    *(u32x4*)(rowp + bj * HALF) = w; } }
    }
};

template <bool BASE_F32, bool OUT_F32, bool OUT_XB, bool SSQ>
struct EpiResidual {
    static constexpr bool PERM = true, AFTER_DRAIN = false, PREFETCH = false;
    const float* basef; const bf16_t* baseb; float* outf; bf16_t* xbo; float* ssq_next;
    __device__ __forceinline__ void operator()(const f32x4 (&acc)[2][2][4][2], const Unit& u, int wr, int wc, int fr, int fq) const {
        const int row0 = u.pm * BM + wr * 64 + fr, col0 = u.pn * BM + wc * 32 + 8 * fq;
        if constexpr (!BASE_F32) {
            u32x4 bw[2][4][2]; float ss[2][4];
#pragma unroll
            for (int ai = 0; ai < 2; ++ai)
#pragma unroll
                for (int m = 0; m < 4; ++m)
#pragma unroll
                    for (int bj = 0; bj < 2; ++bj) bw[ai][m][bj] = *(const u32x4*)(baseb + (size_t)(row0 + ai * HALF + m * 16) * 1024 + col0 + bj * HALF);
#pragma unroll
            for (int ai = 0; ai < 2; ++ai)
#pragma unroll
                for (int m = 0; m < 4; ++m) { const int row = row0 + ai * HALF + m * 16; const size_t off = (size_t)row * 1024 + col0; float s = 0.f;
#pragma unroll
                    for (int bj = 0; bj < 2; ++bj) { const size_t o = off + bj * HALF; const u32x4 w = bw[ai][m][bj];
                        f32x4 v0 = (f32x4){__uint_as_float(w.x << 16), __uint_as_float(w.x & 0xffff0000u), __uint_as_float(w.y << 16), __uint_as_float(w.y & 0xffff0000u)};
                        f32x4 v1 = (f32x4){__uint_as_float(w.z << 16), __uint_as_float(w.z & 0xffff0000u), __uint_as_float(w.w << 16), __uint_as_float(w.w & 0xffff0000u)};
                        v0 = v0 + acc[ai][bj][m][0]; v1 = v1 + acc[ai][bj][m][1];
                        if (OUT_F32) { *(f32x4*)(outf + o) = v0; *(f32x4*)(outf + o + 4) = v1; }
                        if (OUT_XB) { u32x4 wo; wo.x = cvt_pk_bf16(v0[0], v0[1]); wo.y = cvt_pk_bf16(v0[2], v0[3]); wo.z = cvt_pk_bf16(v1[0], v1[1]); wo.w = cvt_pk_bf16(v1[2], v1[3]); *(u32x4*)(xbo + o) = wo; }
                        s += (v0[0] * v0[0] + v0[1] * v0[1]) + (v0[2] * v0[2] + v0[3] * v0[3]) + (v1[0] * v1[0] + v1[1] * v1[1]) + (v1[2] * v1[2] + v1[3] * v1[3]); }
                    if (SSQ) { s += __shfl_xor(s, 16); s += __shfl_xor(s, 32); }
                    ss[ai][m] = s; }
            if (SSQ) { if (fq == 0) {
#pragma unroll
                for (int ai = 0; ai < 2; ++ai)
#pragma unroll
                    for (int m = 0; m < 4; ++m) atomicAdd(ssq_next + row0 + ai * HALF + m * 16, ss[ai][m]); } }
        } else {
#pragma unroll
        for (int ai = 0; ai < 2; ++ai)
#pragma unroll
            for (int m = 0; m < 4; ++m) { const int row = row0 + ai * HALF + m * 16; const size_t off = (size_t)row * 1024 + col0; float s = 0.f;
#pragma unroll
                for (int bj = 0; bj < 2; ++bj) { const size_t o = off + bj * HALF; f32x4 v0, v1;
                    v0 = *(const f32x4*)(basef + o); v1 = *(const f32x4*)(basef + o + 4);
                    v0 = v0 + acc[ai][bj][m][0]; v1 = v1 + acc[ai][bj][m][1];
                    if (OUT_F32) { *(f32x4*)(outf + o) = v0; *(f32x4*)(outf + o + 4) = v1; }
                    if (OUT_XB) { u32x4 w; w.x = cvt_pk_bf16(v0[0], v0[1]); w.y = cvt_pk_bf16(v0[2], v0[3]); w.z = cvt_pk_bf16(v1[0], v1[1]); w.w = cvt_pk_bf16(v1[2], v1[3]); *(u32x4*)(xbo + o) = w; }
                    s += (v0[0] * v0[0] + v0[1] * v0[1]) + (v0[2] * v0[2] + v0[3] * v0[3]) + (v1[0] * v1[0] + v1[1] * v1[1]) + (v1[2] * v1[2] + v1[3] * v1[3]); }
                if (SSQ) { s += __shfl_xor(s, 16); s += __shfl_xor(s, 32); if (fq == 0) atomicAdd(ssq_next + row, s); }
                if (m & 1) asm volatile("" ::: "memory"); }
        }
    }
};

struct EpiQkv {
    static constexpr bool PERM = true, AFTER_DRAIN = false, PREFETCH = false;
    bf16_t* O; const float* ssq; const float* gq; const float* gk;
    __device__ __forceinline__ void operator()(const f32x4 (&acc)[2][2][4][2], const Unit& u, int wr, int wc, int fr, int fq) const {
        const int row0 = u.pm * BM + wr * 64 + fr; const int part = (u.pn * BM) >> 10;
        float rsv[2][4];
#pragma unroll
        for (int ai = 0; ai < 2; ++ai)
#pragma unroll
            for (int m = 0; m < 4; ++m) rsv[ai][m] = ssq[row0 + ai * HALF + m * 16];
        const float* gp = (part == 1 ? gk : gq) + 8 * fq; const float sc0 = part == 0 ? 0.125f * 1.4426950408889634f : 1.0f; const bool nrm = part < 2;
        f32x4 gv[2][2];
#pragma unroll
        for (int bj = 0; bj < 2; ++bj)
#pragma unroll
            for (int n = 0; n < 2; ++n) gv[bj][n] = *(const f32x4*)(gp + 32 * bj + 4 * n);
#pragma unroll
        for (int bj = 0; bj < 2; ++bj)
#pragma unroll
            for (int n = 0; n < 2; ++n)
#pragma unroll
                for (int j = 0; j < 4; ++j) gv[bj][n][j] = nrm ? gv[bj][n][j] * sc0 : 1.0f;
#pragma unroll
        for (int ai = 0; ai < 2; ++ai)
#pragma unroll
            for (int m = 0; m < 4; ++m) { const int row = row0 + ai * HALF + m * 16; const float rs = rsqrtf(rsv[ai][m] * (1.0f / 1024.0f) + 1e-6f);
                f32x4 y[2][2]; float ss = 0.f;
#pragma unroll
                for (int bj = 0; bj < 2; ++bj)
#pragma unroll
                    for (int n = 0; n < 2; ++n) { y[bj][n] = acc[ai][bj][m][n] * rs; const f32x4 t = y[bj][n]; ss += (t[0] * t[0] + t[1] * t[1]) + (t[2] * t[2] + t[3] * t[3]); }
                ss += __shfl_xor(ss, 16); ss += __shfl_xor(ss, 32); const float sc1 = rsqrtf(ss * (1.0f / 64.0f) + 1e-6f), sc = nrm ? sc1 : 1.0f;
#pragma unroll
                for (int bj = 0; bj < 2; ++bj)
#pragma unroll
                    for (int n = 0; n < 2; ++n) y[bj][n] = y[bj][n] * sc * gv[bj][n];
                const int hh = ((u.pn & 3) << 2) + wc;
                bf16_t* rowp = O + (size_t)part * (16384u * 1024u) + ((size_t)((row >> 12) * 16 + hh) * 4096 + (row & 4095)) * 64 + 8 * fq;
#pragma unroll
                for (int bj = 0; bj < 2; ++bj) { u32x4 w; w.x = cvt_pk_bf16(y[bj][0][0], y[bj][0][1]); w.y = cvt_pk_bf16(y[bj][0][2], y[bj][0][3]); w.z = cvt_pk_bf16(y[bj][1][0], y[bj][1][1]); w.w = cvt_pk_bf16(y[bj][1][2], y[bj][1][3]);
                    *(u32x4*)(rowp + 32 * bj) = w; } }
    }
};

template <int CTRL> __device__ __forceinline__ float dppf(float o, float s) { return __int_as_float(__builtin_amdgcn_update_dpp(__float_as_int(o), __float_as_int(s), CTRL, 0xf, 0xf, false)); }
template <int CTRL> __device__ __forceinline__ f32x4 dpp4(f32x4 o, f32x4 s) { f32x4 r; r[0] = dppf<CTRL>(o[0], s[0]); r[1] = dppf<CTRL>(o[1], s[1]); r[2] = dppf<CTRL>(o[2], s[2]); r[3] = dppf<CTRL>(o[3], s[3]); return r; }
__device__ __forceinline__ f32x4 dpp4_shr1(f32x4 o, f32x4 s) { return dpp4<0x111>(o, s); }
__device__ __forceinline__ f32x4 dpp4_shr2(f32x4 o, f32x4 s) { return dpp4<0x112>(o, s); }
__device__ __forceinline__ f32x4 dpp4_shl15(f32x4 o, f32x4 s) { return dpp4<0x10f>(o, s); }
__device__ __forceinline__ f32x4 dpp4_shl14(f32x4 o, f32x4 s) { return dpp4<0x10e>(o, s); }
#define PIN4(x) asm volatile("" : "+v"(x))
#define DPPM " row_mask:0xf bank_mask:0xf bound_ctrl:1\n\t"
__device__ __forceinline__ void conv_taps_cur(f32x4& nv, const f32x4 cur, const f32x4 w1, const f32x4 w0) {
    float n0 = nv[0], n1 = nv[1], n2 = nv[2], n3 = nv[3];
    asm volatile("s_nop 1\n\t"
        "v_fmac_f32_dpp %0, %4, %8 row_shr:1" DPPM "v_fmac_f32_dpp %1, %5, %9 row_shr:1" DPPM "v_fmac_f32_dpp %2, %6, %10 row_shr:1" DPPM "v_fmac_f32_dpp %3, %7, %11 row_shr:1" DPPM
        "v_fmac_f32_dpp %0, %4, %12 row_shr:2" DPPM "v_fmac_f32_dpp %1, %5, %13 row_shr:2" DPPM "v_fmac_f32_dpp %2, %6, %14 row_shr:2" DPPM "v_fmac_f32_dpp %3, %7, %15 row_shr:2" DPPM
        : "+v"(n0), "+v"(n1), "+v"(n2), "+v"(n3)
        : "v"(cur[0]), "v"(cur[1]), "v"(cur[2]), "v"(cur[3]), "v"(w1[0]), "v"(w1[1]), "v"(w1[2]), "v"(w1[3]), "v"(w0[0]), "v"(w0[1]), "v"(w0[2]), "v"(w0[3]));
    nv = (f32x4){n0, n1, n2, n3};
}
__device__ __forceinline__ void conv_taps_prev(f32x4& nv, const f32x4 pv, const f32x4 w1, const f32x4 w0) {
    float n0 = nv[0], n1 = nv[1], n2 = nv[2], n3 = nv[3];
    asm volatile("s_nop 1\n\t"
        "v_fmac_f32_dpp %0, %4, %8 row_shl:15" DPPM "v_fmac_f32_dpp %1, %5, %9 row_shl:15" DPPM "v_fmac_f32_dpp %2, %6, %10 row_shl:15" DPPM "v_fmac_f32_dpp %3, %7, %11 row_shl:15" DPPM
        "v_fmac_f32_dpp %0, %4, %12 row_shl:14" DPPM "v_fmac_f32_dpp %1, %5, %13 row_shl:14" DPPM "v_fmac_f32_dpp %2, %6, %14 row_shl:14" DPPM "v_fmac_f32_dpp %3, %7, %15 row_shl:14" DPPM
        : "+v"(n0), "+v"(n1), "+v"(n2), "+v"(n3)
        : "v"(pv[0]), "v"(pv[1]), "v"(pv[2]), "v"(pv[3]), "v"(w1[0]), "v"(w1[1]), "v"(w1[2]), "v"(w1[3]), "v"(w0[0]), "v"(w0[1]), "v"(w0[2]), "v"(w0[3]));
    nv = (f32x4){n0, n1, n2, n3};
}
struct EpiConvGlu {
    static constexpr bool PERM = true, AFTER_DRAIN = false, PREFETCH = true;
    bf16_t* act; const float* ssq; const float* cw; const float* cb; PG8_LAS float* halo;
    __device__ __forceinline__ void prefetch(const Unit& u, int wid, int lane, int par) const {
        PG8_LAS unsigned char* pf = (PG8_LAS unsigned char*)halo + 12288 + par * 5120;
        if (wid < 4) { const int b = u.pm / 17, it = u.pm - b * 17; int tl = 254 * it - 2 + wid * 64 + lane; tl = tl < 0 ? 0 : (tl > 4095 ? 4095 : tl);
            __builtin_amdgcn_global_load_lds((const unsigned*)(ssq + b * 4096 + tl), (PG8_LAS unsigned*)(pf + 4096 + wid * 256), 4, 0, 0); }
        else { const int seg = (wid - 4) * 2 + (lane >> 5), j = seg >> 1, bj = seg & 1; const float* src = (j < 3 ? cw + j * 5632 : cb) + u.pn * HALF + bj * 2816 + (lane & 31) * 4;
            __builtin_amdgcn_global_load_lds((const unsigned*)src, (PG8_LAS unsigned*)(pf + (wid - 4) * 1024), 16, 0, 0); }
    }
    __device__ __forceinline__ void operator()(f32x4 (&acc)[2][2][4][2], const Unit& u, int wr, int wc, int fr, int fq, int par) const {
        const int b = u.pm / 17, it = u.pm - b * 17; const int tl0 = 254 * it - 2 + wr * 64 + fr;
        const int colg = u.pn * HALF + wc * 32 + 8 * fq;
        float rsv[2][4];
        const PG8_LAS float* pfs = (const PG8_LAS float*)((const PG8_LAS unsigned char*)halo + 12288 + par * 5120 + 4096) + wr * 64 + fr;
        const PG8_LAS unsigned char* pfw = (const PG8_LAS unsigned char*)halo + 12288 + par * 5120 + (wc * 32 + 8 * fq) * 4;
#pragma unroll
        for (int ai = 0; ai < 2; ++ai)
#pragma unroll
            for (int m = 0; m < 4; ++m) rsv[ai][m] = pfs[ai * HALF + m * 16];
#pragma unroll
        for (int ai = 0; ai < 2; ++ai)
#pragma unroll
            for (int m = 0; m < 4; ++m) { const int tl = tl0 + ai * HALF + m * 16; const bool ok = (tl >= 0) && (tl < 4096); const float r0 = rsqrtf(rsv[ai][m] * (1.0f / 1024.0f) + 1e-6f); const float rs = ok ? r0 : 0.f;
#pragma unroll
                for (int bj = 0; bj < 2; ++bj)
#pragma unroll
                    for (int n = 0; n < 2; ++n) { acc[ai][bj][m][n] = acc[ai][bj][m][n] * rs; PIN4(acc[ai][bj][m][n]); } }
        PG8_LAS f32x4* H = (PG8_LAS f32x4*)halo;
        { PG8_LAS f32x4* Hw = H + ((wr ^ 1) * 16 + wc * 4 + fq) + wr * 256 + (fr & 1) * 128;
          if (fr >= 14) {
#pragma unroll
            for (int ai = 0; ai < 2; ++ai)
#pragma unroll
                for (int bj = 0; bj < 2; ++bj)
#pragma unroll
                    for (int n = 0; n < 2; ++n) Hw[ai * 256 + bj * 64 + n * 32] = acc[ai][bj][3][n]; } }
        asm volatile("s_waitcnt lgkmcnt(0)" ::: "memory"); __builtin_amdgcn_s_barrier(); asm volatile("" ::: "memory"); __builtin_amdgcn_sched_barrier(0);
        const PG8_LAS f32x4* Hr = H + (wr * 16 + wc * 4 + fq);
#pragma unroll
        for (int bj = 0; bj < 2; ++bj)
#pragma unroll
            for (int n = 0; n < 2; ++n) { const int c = colg + bj * 2816 + 4 * n;
                f32x4 w0 = *(const PG8_LAS f32x4*)(pfw + (0 + bj) * 512 + n * 16), w1 = *(const PG8_LAS f32x4*)(pfw + (2 + bj) * 512 + n * 16), w2 = *(const PG8_LAS f32x4*)(pfw + (4 + bj) * 512 + n * 16), bb = *(const PG8_LAS f32x4*)(pfw + (6 + bj) * 512 + n * 16);
                PIN4(w0); PIN4(w1); PIN4(w2); PIN4(bb);
#pragma unroll
                for (int ai = 0; ai < 2; ++ai) { const int s = 2 * ai + wr;
                    f32x4 h1 = (f32x4){0.f, 0.f, 0.f, 0.f}, h2 = h1;
                    if (s > 0) { h2 = Hr[ai * 256 + bj * 64 + n * 32]; h1 = Hr[ai * 256 + 128 + bj * 64 + n * 32]; }
                    PIN4(h1); PIN4(h2);
#pragma unroll
                    for (int m = 3; m >= 0; --m) { f32x4 cur = acc[ai][bj][m][n]; PIN4(cur); f32x4 o1, o2;
#ifdef X_SHFL
                        const int ln = (int)(threadIdx.x & 63); f32x4 p1, p2;
                        if (m > 0) { const f32x4 pv = acc[ai][bj][m - 1][n];
                            for (int j = 0; j < 4; ++j) { const float a1 = __shfl(cur[j], ln - 1, 64), b1 = __shfl(pv[j], ln + 15, 64), a2 = __shfl(cur[j], ln - 2, 64), b2 = __shfl(pv[j], ln + 14, 64);
                                p1[j] = fr >= 1 ? a1 : b1; p2[j] = fr >= 2 ? a2 : b2; } }
                        else { for (int j = 0; j < 4; ++j) { const float a1 = __shfl(cur[j], ln - 1, 64), a2 = __shfl(cur[j], ln - 2, 64);
                                p1[j] = fr >= 1 ? a1 : h1[j]; p2[j] = fr >= 2 ? a2 : (fr == 0 ? h2[j] : h1[j]); } }
                        f32x4 nv = w2 * cur + w1 * p1 + w0 * p2 + bb; PIN4(nv);
#elif !defined(X_DPPMOV)
                        f32x4 nv = w2 * cur + bb;
                        if (m > 0) { const f32x4 pv = acc[ai][bj][m - 1][n]; conv_taps_prev(nv, pv, w1, w0); }
                        else { const f32x4 hz = (f32x4){0.f, 0.f, 0.f, 0.f}; const f32x4 t1 = (fr == 0) ? h1 : hz, t2 = (fr == 0) ? h2 : ((fr == 1) ? h1 : hz); nv = nv + w1 * t1 + w0 * t2; }
                        conv_taps_cur(nv, cur, w1, w0);
#else
                        if (m > 0) { const f32x4 pv = acc[ai][bj][m - 1][n]; o1 = dpp4_shl15(pv, pv); o2 = dpp4_shl14(pv, pv); }
                        else { o1 = h1; o2 = (fr == 0) ? h2 : h1; }
                        const f32x4 p1 = dpp4_shr1(o1, cur), p2 = dpp4_shr2(o2, cur);
                        f32x4 nv = w2 * cur + w1 * p1 + w0 * p2 + bb; PIN4(nv);
#endif
                        acc[ai][bj][m][n] = nv; } } }
        __builtin_amdgcn_sched_barrier(0);
#pragma unroll
        for (int ai = 0; ai < 2; ++ai)
#pragma unroll
            for (int m = 0; m < 4; ++m) { const int rl = ai * HALF + wr * 64 + m * 16 + fr; const int tl = 254 * it - 2 + rl;
                f32x4 r[2];
#pragma unroll
                for (int n = 0; n < 2; ++n) { const f32x4 g = acc[ai][0][m][n], up = acc[ai][1][m][n];
#pragma unroll
                    for (int j = 0; j < 4; ++j) { const float e = __builtin_amdgcn_exp2f(g[j] * -1.4426950408889634f); r[n][j] = g[j] * __builtin_amdgcn_rcpf(1.0f + e) * up[j]; } }
                if (rl >= 2 && tl < 4096) { u32x4 w; w.x = cvt_pk_bf16(r[0][0], r[0][1]); w.y = cvt_pk_bf16(r[0][2], r[0][3]); w.z = cvt_pk_bf16(r[1][0], r[1][1]); w.w = cvt_pk_bf16(r[1][2], r[1][3]);
                    *(u32x4*)(act + (size_t)(b * 4096 + tl) * 2816 + colg) = w; }
                asm volatile("" ::: "memory"); }
    }
};
struct OverlapOrder : StaticOrder {
    __device__ __forceinline__ long a_row(const Unit& u) const { const int b = u.pm / 17, it = u.pm - b * 17; return (long)b * 4096 + 254 * it - 2; }
};

template <class Epi, class Sched, bool ALIGN_EPI = false, bool SP2 = false>
__device__ __forceinline__ void gemm_phase(PG8_LAS unsigned char* lds, const Gemm g, const Sched& S, const Epi& E) {
    const int tid = threadIdx.x, wid = __builtin_amdgcn_readfirstlane(tid >> 6), lane = tid & 63, wr = wid >> 2, wc = wid & 3, fr = lane & 15, fq = lane >> 4;
    const int K = g.K, nt = K / BK;
    unsigned voffA[2], voffB[2];
#pragma unroll
    for (int i = 0; i < 2; ++i) { int R, C; stage_rc(tid * 16 + i * 8192, R, C); const int Rb = Epi::PERM ? ((R & ~31) + perm32(R & 31)) : R;
        voffA[i] = (unsigned)(R * K + C) * 2u; voffB[i] = (unsigned)(Rb * K + C) * 2u; }
    const size_t kstep = (size_t)(BK * 2);
    const size_t hstep = (size_t)HALF * K * 2;
    const size_t tstep = 2 * hstep;
    const unsigned ldsw = (unsigned)wid * 1024u;
    const int aoff = lds_byte(wr * 64 + fr, fq * 8), boff = lds_byte(wc * 32 + fr, fq * 8);
#define PG8_SA(b, h) (((b) * 2 + (h)) * HTB)
#define PG8_SB(b, h) ((4 + (b) * 2 + (h)) * HTB)
#define PG8_STAGE(bufoff, gbase, voff) do { _Pragma("unroll") for (int _i = 0; _i < 2; ++_i) \
        __builtin_amdgcn_global_load_lds((const unsigned*)((const char*)(gbase) + (voff)[_i]), (PG8_LAS unsigned*)(lds + (bufoff) + ldsw + _i * 8192), 16, 0, 0); } while (0)
#define PG8_LDA(dst, b, h) do { _Pragma("unroll") for (int m = 0; m < 4; ++m) _Pragma("unroll") for (int k = 0; k < 2; ++k) dst[m][k] = *(const PG8_LAS bf16x8*)(lds + PG8_SA(b, h) + aoff + m * 2048 + k * 1024); } while (0)
#define PG8_LDB(dst, b, h) do { _Pragma("unroll") for (int n = 0; n < 2; ++n) _Pragma("unroll") for (int k = 0; k < 2; ++k) dst[n][k] = *(const PG8_LAS bf16x8*)(lds + PG8_SB(b, h) + boff + n * 2048 + k * 1024); } while (0)
#define PG8_MMA(ai, bj, At, Bt) do { __builtin_amdgcn_s_setprio(1); _Pragma("unroll") for (int m = 0; m < 4; ++m) _Pragma("unroll") for (int n = 0; n < 2; ++n) _Pragma("unroll") for (int k = 0; k < 2; ++k) \
        acc[ai][bj][m][n] = __builtin_amdgcn_mfma_f32_16x16x32_bf16(Bt[n][k], At[m][k], acc[ai][bj][m][n], 0, 0, 0); __builtin_amdgcn_s_setprio(0); } while (0)
#define PG8_WAIT_V(n) asm volatile("s_waitcnt vmcnt(" #n ")" ::: "memory")
#define PG8_WAIT_L(n) asm volatile("s_waitcnt lgkmcnt(" #n ")" ::: "memory")
#define PG8_BAR __builtin_amdgcn_s_barrier()
#define PG8_SCHED __builtin_amdgcn_sched_barrier(0)
    Unit cur, nxt; int ui = 0;
    if (!S.next(0, cur)) return;
    f32x4 acc[2][2][4][2];
#pragma unroll
    for (int a = 0; a < 2; ++a)
#pragma unroll
        for (int b = 0; b < 2; ++b)
#pragma unroll
            for (int m = 0; m < 4; ++m)
#pragma unroll
                for (int n = 0; n < 2; ++n) acc[a][b][m][n] = (f32x4){0.f, 0.f, 0.f, 0.f};
    bf16x8 At[4][2], B0[2][2], B1[2][2];
    const char* cA = (const char*)g.A + (long)S.a_row(cur) * (long)(K * 2); const char* cB = (const char*)g.Bt + (size_t)cur.pn * tstep;
    S.a_ready(cur);
    if constexpr (Epi::PREFETCH) E.prefetch(cur, wid, lane, 0);
    if constexpr (SP2) {
        PG8_STAGE(PG8_SB(0, 0), cB, voffB); PG8_STAGE(PG8_SB(0, 1), cB + hstep, voffB); PG8_STAGE(PG8_SA(0, 0), cA, voffA); PG8_STAGE(PG8_SA(0, 1), cA + hstep, voffA);
        if (wr == 1) PG8_BAR;
        PG8_WAIT_V(2); PG8_BAR;
        PG8_STAGE(PG8_SB(1, 0), cB + kstep, voffB); PG8_STAGE(PG8_SA(1, 0), cA + kstep, voffA); PG8_STAGE(PG8_SB(1, 1), cB + hstep + kstep, voffB);
        PG8_WAIT_V(6); PG8_BAR;
    } else {
        PG8_STAGE(PG8_SB(0, 0), cB, voffB); PG8_STAGE(PG8_SA(0, 0), cA, voffA); PG8_STAGE(PG8_SB(0, 1), cB + hstep, voffB); PG8_STAGE(PG8_SA(0, 1), cA + hstep, voffA);
        if (wr == 1) PG8_BAR;
        PG8_WAIT_V(4); PG8_BAR;
        PG8_STAGE(PG8_SB(1, 0), cB + kstep, voffB); PG8_STAGE(PG8_SA(1, 0), cA + kstep, voffA); PG8_STAGE(PG8_SB(1, 1), cB + hstep + kstep, voffB);
        PG8_WAIT_V(6); PG8_BAR;
    }
    for (;;) {
        const bool has_next = S.next(ui + 1, nxt);
        const char* nA = has_next ? (const char*)g.A + (long)S.a_row(nxt) * (long)(K * 2) : cA; const char* nB = has_next ? (const char*)g.Bt + (size_t)nxt.pn * tstep : cB;
        for (int t = 0; t < nt; t += 2) {
            const bool last = (t == nt - 2);
            const char* a1 = cA + (size_t)(t + 1) * kstep;
            const char* a2 = last ? nA : cA + (size_t)(t + 2) * kstep; const char* b2 = last ? nB : cB + (size_t)(t + 2) * kstep;
            const char* a3 = a2 + kstep; const char* b3 = b2 + kstep;
            if (last && has_next) S.a_ready(nxt);
            if constexpr (SP2) {
            PG8_LDB(B0, 0, 0); PG8_LDB(B1, 0, 1); PG8_SCHED; PG8_LDA(At, 0, 0); PG8_STAGE(PG8_SA(1, 1), a1 + hstep, voffA);
            PG8_WAIT_V(8); PG8_WAIT_L(0); PG8_BAR; PG8_MMA(0, 0, At, B0); PG8_MMA(0, 1, At, B1); PG8_BAR; PG8_SCHED;
            PG8_LDA(At, 0, 1); PG8_STAGE(PG8_SB(0, 0), b2, voffB); PG8_STAGE(PG8_SB(0, 1), b2 + hstep, voffB); PG8_STAGE(PG8_SA(0, 0), a2, voffA);
            PG8_WAIT_V(8); PG8_WAIT_L(0); PG8_BAR; PG8_MMA(1, 0, At, B0); PG8_MMA(1, 1, At, B1); PG8_BAR; PG8_SCHED;
            PG8_LDB(B0, 1, 0); PG8_LDB(B1, 1, 1); PG8_SCHED; PG8_LDA(At, 1, 0); PG8_STAGE(PG8_SA(0, 1), a2 + hstep, voffA);
            PG8_WAIT_V(8); PG8_WAIT_L(0); PG8_BAR; PG8_MMA(0, 0, At, B0); PG8_MMA(0, 1, At, B1); PG8_BAR; PG8_SCHED;
            PG8_LDA(At, 1, 1); PG8_STAGE(PG8_SB(1, 0), b3, voffB); PG8_STAGE(PG8_SB(1, 1), b3 + hstep, voffB); PG8_STAGE(PG8_SA(1, 0), a3, voffA);
            PG8_WAIT_V(8); PG8_WAIT_L(0); PG8_BAR; PG8_MMA(1, 0, At, B0); PG8_MMA(1, 1, At, B1); PG8_BAR; PG8_SCHED;
            } else {
            PG8_LDB(B0, 0, 0); PG8_SCHED; PG8_LDA(At, 0, 0); PG8_STAGE(PG8_SA(1, 1), a1 + hstep, voffA);
            PG8_WAIT_L(8); PG8_BAR; PG8_WAIT_L(0); PG8_MMA(0, 0, At, B0); PG8_BAR; PG8_SCHED;
            PG8_LDB(B1, 0, 1); PG8_STAGE(PG8_SB(0, 0), b2, voffB);
            PG8_BAR; PG8_WAIT_L(0); PG8_MMA(0, 1, At, B1); PG8_BAR;
            PG8_LDA(At, 0, 1); PG8_STAGE(PG8_SA(0, 0), a2, voffA);
            PG8_BAR; PG8_WAIT_L(0); PG8_MMA(1, 0, At, B0); PG8_BAR; PG8_SCHED;
            PG8_STAGE(PG8_SB(0, 1), b2 + hstep, voffB);
            PG8_WAIT_V(6); PG8_BAR; PG8_MMA(1, 1, At, B1); PG8_BAR;
            PG8_LDB(B0, 1, 0); PG8_SCHED; PG8_LDA(At, 1, 0); PG8_STAGE(PG8_SA(0, 1), a2 + hstep, voffA);
            PG8_WAIT_L(8); PG8_BAR; PG8_WAIT_L(0); PG8_MMA(0, 0, At, B0); PG8_BAR; PG8_SCHED;
            PG8_LDB(B1, 1, 1); PG8_STAGE(PG8_SB(1, 0), b3, voffB);
            PG8_BAR; PG8_WAIT_L(0); PG8_MMA(0, 1, At, B1); PG8_BAR;
            PG8_LDA(At, 1, 1); PG8_STAGE(PG8_SA(1, 0), a3, voffA);
            PG8_BAR; PG8_WAIT_L(0); PG8_MMA(1, 0, At, B0); PG8_BAR; PG8_SCHED;
            PG8_STAGE(PG8_SB(1, 1), b3 + hstep, voffB);
            PG8_WAIT_V(6); PG8_BAR; PG8_MMA(1, 1, At, B1); PG8_BAR;
            }
        }
        if constexpr (ALIGN_EPI) { if (wr == 0) PG8_BAR; }
        if constexpr (Epi::PREFETCH) { E(acc, cur, wr, wc, fr, fq, ui & 1); if (has_next) E.prefetch(nxt, wid, lane, (ui + 1) & 1); S.done(cur); }
        else if constexpr (!Epi::AFTER_DRAIN) { E(acc, cur, wr, wc, fr, fq); S.done(cur); }
        if (!has_next) break;
#pragma unroll
        for (int a = 0; a < 2; ++a)
#pragma unroll
            for (int b = 0; b < 2; ++b)
#pragma unroll
                for (int m = 0; m < 4; ++m)
#pragma unroll
                    for (int n = 0; n < 2; ++n) acc[a][b][m][n] = (f32x4){0.f, 0.f, 0.f, 0.f};
        cur = nxt; cA = nA; cB = nB; ++ui;
        if constexpr (ALIGN_EPI) { if (wr == 1) PG8_BAR; }
    }
    PG8_WAIT_V(0);
    if constexpr (!ALIGN_EPI) { if (wr == 0) PG8_BAR; }
    PG8_BAR;
    if constexpr (Epi::AFTER_DRAIN) { E.fused(acc, cur, wr, wc, fr, fq, lds, wid, lane); S.done(cur); }
#undef PG8_SA
#undef PG8_SB
#undef PG8_STAGE
#undef PG8_LDA
#undef PG8_LDB
#undef PG8_MMA
#undef PG8_WAIT_V
#undef PG8_WAIT_L
#undef PG8_BAR
#undef PG8_SCHED
}
}

#define GAS __attribute__((address_space(1)))
#define LAS __attribute__((address_space(3)))
typedef unsigned short bf16;
typedef unsigned v4u __attribute__((ext_vector_type(4)));
typedef float f32x4 __attribute__((ext_vector_type(4)));
typedef short bf16x8 __attribute__((ext_vector_type(8)));
typedef GAS unsigned gu32;
typedef GAS unsigned long long gu64;
#define RLX_AGENT __ATOMIC_RELAXED, __HIP_MEMORY_SCOPE_AGENT
#define LDS_WAIT() asm volatile("s_waitcnt lgkmcnt(0)" ::: "memory")
#define VM_WAIT() asm volatile("s_waitcnt vmcnt(0)" ::: "memory")
__device__ __forceinline__ unsigned long long rt() { return __builtin_amdgcn_s_memrealtime(); }
__device__ __forceinline__ unsigned pk2(float lo, float hi) { return (unsigned)f2bf(lo) | ((unsigned)f2bf(hi) << 16); }
#define XB_TMO      128
#define XB_XCNT(j)  (256  + 64 * (j))
#define XB_XSUB(j)  (1280 + 64 * (j))
#define XB_XGEN(j)  (2304 + 64 * (j))
#define XB_TOP      3328
#define XB_TOPGEN   3392
#define XCD_BAR_WORDS 3456
#define XB_SPIN_CAP (1u << 18)

__device__ __forceinline__ unsigned xb_ld(unsigned* p)              { return __hip_atomic_load(p, __ATOMIC_RELAXED, __HIP_MEMORY_SCOPE_AGENT); }
__device__ __forceinline__ unsigned xb_add(unsigned* p, unsigned v) { return __hip_atomic_fetch_add(p, v, __ATOMIC_RELAXED, __HIP_MEMORY_SCOPE_AGENT); }
__device__ __forceinline__ unsigned xb_xcc_id() { return (unsigned)__builtin_amdgcn_s_getreg((3 << 11) | 20) & 0xFu; }
#define XB_SPIN(cond, bar) do { unsigned _sp = 0; while (cond) { __builtin_amdgcn_s_sleep(1); \
    if ((++_sp & 255u) == 0u) { if (xb_ld(&(bar)[XB_TMO])) break; if (_sp > XB_SPIN_CAP) { atomicAdd(&(bar)[XB_TMO], 1u); break; } } } } while (0)

struct XcdBarrier {
    unsigned* bar; unsigned x;
    volatile LAS unsigned* st;
};

__device__ __forceinline__ XcdBarrier xcd_barrier_post(unsigned* bar, volatile LAS unsigned* st) {
    XcdBarrier b; b.bar = bar; b.x = xb_xcc_id(); b.st = st;
    if (threadIdx.x == 0) (void)xb_add(&bar[XB_XCNT(b.x)], 1u);
    return b;
}
__device__ __forceinline__ void xcd_barrier_complete(unsigned* bar, unsigned x, unsigned& nloc, unsigned& nx) {
    const unsigned G = gridDim.x * gridDim.y * gridDim.z;
    unsigned sum, cnt, mine, sp = 0u;
    for (;;) {
        sum = 0u; cnt = 0u; mine = 0u;
#pragma unroll
        for (unsigned j = 0; j < 16; ++j) { const unsigned c = xb_ld(&bar[XB_XCNT(j)]); sum += c; cnt += (c > 0u) ? 1u : 0u; mine = (j == x) ? c : mine; }
        if (sum == G) break;
        __builtin_amdgcn_s_sleep(1);
        if ((++sp & 255u) == 0u) { if (xb_ld(&bar[XB_TMO])) break; if (sp > XB_SPIN_CAP) { atomicAdd(&bar[XB_TMO], 1u); break; } }
    }
    nloc = mine > 0u ? mine : 1u; nx = cnt > 0u ? cnt : 1u;
}

__device__ __forceinline__ void xcd_barrier_protocol(const XcdBarrier& b) {
        unsigned* bar = b.bar;
        __builtin_amdgcn_s_waitcnt(0);
        unsigned nloc = b.st[0], nx = b.st[1];
        if (nloc == 0u) { xcd_barrier_complete(bar, b.x, nloc, nx); b.st[0] = nloc; b.st[1] = nx; }
        const unsigned old = xb_add(&bar[XB_XSUB(b.x)], 1u);
        const unsigned gen = old / nloc;
        if (old + 1u == (gen + 1u) * nloc) {
            __builtin_amdgcn_fence(__ATOMIC_RELEASE, "agent");
            asm volatile("s_waitcnt vmcnt(0)" ::: "memory");
            const unsigned og = xb_add(&bar[XB_TOP], 1u);
            const unsigned tg = og / nx;
            if (og + 1u == (tg + 1u) * nx) xb_add(&bar[XB_TOPGEN], 1u);
            else XB_SPIN(xb_ld(&bar[XB_TOPGEN]) == tg, bar);
            __builtin_amdgcn_fence(__ATOMIC_ACQUIRE, "agent");
            asm volatile("s_waitcnt vmcnt(0)" ::: "memory");
        } else {
            XB_SPIN(xb_ld(&bar[XB_TOPGEN]) == gen, bar);
            __builtin_amdgcn_fence(__ATOMIC_ACQUIRE, "agent");
            asm volatile("s_waitcnt vmcnt(0)" ::: "memory");
        }
}
__device__ __forceinline__ void xcd_barrier(const XcdBarrier& b) {
    asm volatile("s_waitcnt vmcnt(0)" ::: "memory");
    __syncthreads();
    if (threadIdx.x == 0) xcd_barrier_protocol(b);
    __syncthreads();
}
template <class Work>
__device__ __forceinline__ void xcd_barrier_work(const XcdBarrier& b, int wave, const Work& work) {
    asm volatile("s_waitcnt vmcnt(0)" ::: "memory");
    __syncthreads();
    if (wave == 0) { if (threadIdx.x == 0) xcd_barrier_protocol(b); }
    else work(wave - 1);
    __syncthreads();
}

constexpr int NWAVES = 8;
constexpr int CW_BAR = 163840;
constexpr size_t WS_MH = 540 * 1024;
constexpr size_t WS_RT = 544 * 1024;
constexpr size_t WS_WIN = 1 * MiB, WS_WOUT = 5 * MiB, WS_WQKV = 7 * MiB, WS_WO = 13 * MiB, WS_WUP = 15 * MiB  , WS_WDN = 37 * MiB  , WS_WPOOL = 48 * MiB;
static_assert(WS_WPOOL + 131072 <= WS_XB - 4096 && WS_XB + (size_t)T * D * 2 + 512 * 1024 <= WS_R && WS_END <= 256 * MiB, "d_ws map");
constexpr int RING_OFF = 0, RING_BYTES = 131072, LDSCTL_OFF = RING_BYTES, MISC_OFF = LDSCTL_OFF + 320, HALO_OFF = RING_BYTES + 1024, LDS_BYTES = 154624;
static_assert(HALO_OFF + 12288 + 2 * 5120 <= LDS_BYTES, "LDS map");
static_assert(WS_BIAS + 3 * 129 * 16 * 4 <= WS_MH && WS_MH + 64 <= WS_RT && WS_RT + 16 * 3 * 256 * 4 <= (size_t)CW_BAR * 4 && (size_t)CW_BAR * 4 + 11 * 3456 * 4 <= MiB && WS_SSQ + 4 * T * 4 <= WS_BIAS, "control region map");

struct Frame {
    LAS unsigned char* lds; volatile LAS unsigned* MISC; gu32* ctl;
    int tid, lane, wave, vcu, G;
};
struct Args { const float* in[18]; float* out; unsigned char* ws; int ph_lo, ph_hi, li, pad; };

__device__ __forceinline__ int t5_bucket(int dist) {
    if (dist < 16) return dist;
    int b = 16;
    b += dist >= 22; b += dist >= 30; b += dist >= 40; b += dist >= 54; b += dist >= 73; b += dist >= 99; b += dist >= 134; b += dist >= 182;
    b += dist >= 246; b += dist >= 332; b += dist >= 450; b += dist >= 609; b += dist >= 825; b += dist >= 1117; b += dist >= 1513;
    return b;
}
template <bool HAS_K, bool HAS_N, class DstRow>
__device__ __forceinline__ void p0_item(const float* __restrict__ W, int K, int N, bf16* WT, const float* __restrict__ ksc, const float* __restrict__ nsc, LAS float* scr, int item, int lane, DstRow dst) {
    const int nblk = N / 32, kb = item / nblk, nb = item % nblk, k0 = 64 * kb, n0 = 32 * nb;
    const int c = lane & 7;
    const float* wp = W + (size_t)(k0 + (lane >> 5)) * N + n0 + (lane & 31);
    float v[32];
#pragma unroll
    for (int i = 0; i < 32; ++i) v[i] = wp[(size_t)(2 * i) * N];
    float ns = 1.f; f32x4 ka = {1.f, 1.f, 1.f, 1.f}, kb4 = ka;
    if (HAS_N) ns = nsc[n0 + (lane & 31)];
    if (HAS_K) { ka = *(const f32x4*)(ksc + k0 + 8 * c); kb4 = *(const f32x4*)(ksc + k0 + 8 * c + 4); }
#pragma unroll
    for (int i = 0; i < 32; ++i) scr[(2 * i + (lane >> 5)) * 33 + (lane & 31)] = HAS_N ? v[i] * ns : v[i];
    LDS_WAIT(); asm volatile("" ::: "memory");
#pragma unroll
    for (int j = 0; j < 4; ++j) { const int n = (lane >> 3) + 8 * j; const LAS float* s = scr + (8 * c) * 33 + n;
        v4u o; o.x = pk2(s[0 * 33] * ka[0], s[1 * 33] * ka[1]); o.y = pk2(s[2 * 33] * ka[2], s[3 * 33] * ka[3]); o.z = pk2(s[4 * 33] * kb4[0], s[5 * 33] * kb4[1]); o.w = pk2(s[6 * 33] * kb4[2], s[7 * 33] * kb4[3]);
        *(GAS v4u*)(WT + (size_t)dst(n0 + n) * K + k0 + 8 * c) = o; }
    LDS_WAIT(); asm volatile("" ::: "memory");
}
struct DstId { __device__ __forceinline__ int operator()(int n) const { return n; } };
struct DstQkv { __device__ __forceinline__ int operator()(int c) const { const int cl = c & 255; return (c & ~255) + 128 * ((cl & 63) >> 5) + 32 * (cl >> 6) + (cl & 31); } };
struct DstUp { __device__ __forceinline__ int operator()(int c) const { return c < DFF ? 256 * (c >> 7) + (c & 127) : 256 * ((c - DFF) >> 7) + 128 + ((c - DFF) & 127); } };

constexpr int I_IN = 16 * 64, I_OUT = 16 * 32, I_QKV = 16 * 96, I_O = 16 * 32, I_UP = 16 * 176, I_DN = 44 * 32, I_POOL = 2 * 4;
constexpr int IT_POOL = I_IN, IT_OUT = IT_POOL + 4 * I_POOL, IT_UP0 = IT_OUT + I_OUT, IT_DN0 = IT_UP0 + I_UP, IT_QKV = IT_DN0 + I_DN, IT_O = IT_QKV + I_QKV, IT_UP1 = IT_O + I_O, IT_DN1 = IT_UP1 + I_UP, IT_END = IT_DN1 + I_DN;
__device__ __forceinline__ void convert_item(const Args& a, LAS float* scr, int it, int lane) {
    unsigned char* ws = a.ws;
    if (it < IT_POOL) { p0_item<true, false>(a.in[3], D, EVEN_IN, (bf16*)(ws + WS_WIN), a.in[2], nullptr, scr, it, lane, DstId()); return; }
    if (it < IT_OUT) { const int r = it - IT_POOL, g = r / I_POOL; p0_item<false, true>(a.in[5] + (size_t)g * 128 * 128, 128, 128, (bf16*)(ws + WS_WPOOL) + (size_t)g * 128 * 128, nullptr, a.in[6] + g * 128, scr, r - g * I_POOL, lane, DstId()); return; }
    if (it < IT_UP0) { p0_item<false, false>(a.in[7], D, D, (bf16*)(ws + WS_WOUT), nullptr, nullptr, scr, it - IT_OUT, lane, DstId()); return; }
    if (it < IT_DN0) { p0_item<true, false>(a.in[14], D, DFF2, (bf16*)(ws + WS_WUP), a.in[13], nullptr, scr, it - IT_UP0, lane, DstUp()); return; }
    if (it < IT_QKV) { p0_item<false, false>(a.in[17], DFF, D, (bf16*)(ws + WS_WDN), nullptr, nullptr, scr, it - IT_DN0, lane, DstId()); return; }
    if (it < IT_O) { p0_item<true, false>(a.in[9], D, NQKV, (bf16*)(ws + WS_WQKV), a.in[8], nullptr, scr, it - IT_QKV, lane, DstQkv()); return; }
    if (it < IT_UP1) { p0_item<false, false>(a.in[12], D, D, (bf16*)(ws + WS_WO), nullptr, nullptr, scr, it - IT_O, lane, DstId()); return; }
    if (it < IT_DN1) { p0_item<true, false>(a.in[14] + (size_t)D * DFF2, D, DFF2, (bf16*)(ws + WS_WUP) + (size_t)DFF2 * D, a.in[13] + D, nullptr, scr, it - IT_UP1, lane, DstUp()); return; }
    p0_item<false, false>(a.in[17] + (size_t)DFF * D, DFF, D, (bf16*)(ws + WS_WDN) + (size_t)D * DFF, nullptr, nullptr, scr, it - IT_DN1, lane, DstId());
}
struct ConvertWork { const Args* a; LAS unsigned char* lds; int vcu, G, lane, lo, hi;
    __device__ __forceinline__ void operator()(int w7) const { LAS float* scr = (LAS float*)(lds + (w7 + 1) * 16384);
        for (int it = lo + vcu * 7 + w7; it < hi; it += G * 7) convert_item(*a, scr, it, lane); } };
#ifndef CONVERT_IN_SEAMS
#define CONVERT_IN_SEAMS 1
#endif
__device__ __forceinline__ void p0_prologue(Frame& F, const Args& a) {
    unsigned char* ws = a.ws;
    LAS float* scr = (LAS float*)(F.lds + RING_OFF + F.wave * 16384);
    const int gw = F.vcu * NWAVES + F.wave, NGW = F.G * NWAVES;
    const float* x = a.in[0];
    for (int it = gw; it < (CONVERT_IN_SEAMS ? IT_OUT : IT_END); it += NGW) convert_item(a, scr, it, F.lane);
    float* ssq = (float*)(ws + WS_SSQ); bf16* xb = (bf16*)(ws + WS_XB);
    for (int m = gw; m < T; m += NGW) {
        const GAS f32x4* xr = (const GAS f32x4*)(x + (size_t)m * D) + F.lane; f32x4 v[4]; float s = 0.f;
#pragma unroll
        for (int j = 0; j < 4; ++j) { v[j] = xr[64 * j]; s += (v[j].x * v[j].x + v[j].y * v[j].y) + (v[j].z * v[j].z + v[j].w * v[j].w); }
        s = wave_sum(s);
        GAS unsigned long long* o8 = (GAS unsigned long long*)(xb + (size_t)m * D) + F.lane;
#pragma unroll
        for (int j = 0; j < 4; ++j) o8[64 * j] = (unsigned long long)pk2(v[j].x, v[j].y) | ((unsigned long long)pk2(v[j].z, v[j].w) << 32);
        if (F.lane == 0) ssq[m] = s;
    }
    if (gw == NGW - 1) { GAS v4u* p = (GAS v4u*)(ws + WS_XB - 4096); for (int i = F.lane; i < 256; i += 64) p[i] = (v4u){0u, 0u, 0u, 0u}; }
    if (gw < NH) {
        const int h = gw; const float* rel = a.in[1];
        float gqm = fabsf(a.in[10][F.lane]), gkm = fabsf(a.in[11][F.lane]), rb = F.lane < 32 ? rel[F.lane * 16 + h] : -1e30f;
#pragma unroll
        for (int o = 1; o < 64; o <<= 1) { gqm = fmaxf(gqm, __shfl_xor(gqm, o)); gkm = fmaxf(gkm, __shfl_xor(gkm, o)); rb = fmaxf(rb, __shfl_xor(rb, o)); }
        const float Mh = 8.0f * gqm * gkm * LOG2E * 1.02f + rb * LOG2E;
        if (F.lane == 0) ((float*)(ws + WS_MH))[h] = Mh;
        float* rtab = (float*)(ws + WS_RT) + h * 3 * 256;
        for (int i = F.lane; i < 3 * 256; i += 64) { const int br = i / 256, xx = i % 256, jrel = 191 - xx, dil = br == 0 ? 1 : (br == 1 ? 4 : 16);
            rtab[i] = (jrel >= 0 && jrel <= 128) ? rel[t5_bucket(jrel * dil) * 16 + h] * LOG2E - Mh : -1e30f; }
        float* bias = (float*)(ws + WS_BIAS);
        for (int i = F.lane; i < 3 * 129; i += 64) { const int br = i / 129, j = i % 129, dil = br == 0 ? 1 : (br == 1 ? 4 : 16); bias[(br * 129 + j) * 16 + h] = rel[t5_bucket(j * dil) * 16 + h] * LOG2E; }
    }
}


typedef unsigned u32x4_t __attribute__((ext_vector_type(4)));
typedef float f32x2_t __attribute__((ext_vector_type(2))); typedef __bf16 bf16x2_t __attribute__((ext_vector_type(2)));
__device__ __forceinline__ unsigned cvtpk_c(float lo, float hi) { f32x2_t v = {lo, hi}; bf16x2_t b = __builtin_convertvector(v, bf16x2_t); return __builtin_bit_cast(unsigned, b); }
typedef unsigned u32x2_t __attribute__((ext_vector_type(2)));
__device__ __forceinline__ void ld8(const bf16* p, float (&f)[8]) { const u32x4_t v = *(const u32x4_t*)p;
#pragma unroll
    for (int i = 0; i < 4; ++i) { f[2 * i] = __uint_as_float(v[i] << 16); f[2 * i + 1] = __uint_as_float(v[i] & 0xffff0000u); } }
__device__ __forceinline__ u32x4_t pk8(const float (&f)[8]) { u32x4_t w; w.x = pg8::cvt_pk_bf16(f[0], f[1]); w.y = pg8::cvt_pk_bf16(f[2], f[3]); w.z = pg8::cvt_pk_bf16(f[4], f[5]); w.w = pg8::cvt_pk_bf16(f[6], f[7]); return w; }
__device__ __forceinline__ void unpk8(const u32x4_t v, float (&f)[8]) {
#pragma unroll
    for (int i = 0; i < 4; ++i) { f[2 * i] = __uint_as_float(v[i] << 16); f[2 * i + 1] = __uint_as_float(v[i] & 0xffff0000u); } }
template <int K>
__device__ __forceinline__ void pooled_part(const bf16* __restrict__ pin, int tl0, LAS unsigned char* dst, int pitch) {
    u32x4_t hraw[K - 1], araw[8];
#pragma unroll
    for (int j = 1; j < K; ++j) hraw[j - 1] = *(const u32x4_t*)(pin - (size_t)((tl0 - j >= 0) ? j : 0) * EVEN_IN);
#pragma unroll
    for (int i = 0; i < 8; ++i) araw[i] = *(const u32x4_t*)(pin + (size_t)i * EVEN_IN);
    float sm[8];
#pragma unroll
    for (int e = 0; e < 8; ++e) sm[e] = 0.f;
#pragma unroll
    for (int j = 1; j < K; ++j) { const bool ok = tl0 - j >= 0;
#pragma unroll
        for (int q = 0; q < 4; ++q) hraw[j - 1][q] = ok ? hraw[j - 1][q] : 0u;
        float a[8]; unpk8(hraw[j - 1], a);
#pragma unroll
        for (int e = 0; e < 8; ++e) sm[e] += a[e]; }
#pragma unroll
    for (int i = 0; i < 8; ++i) { const int tl = tl0 + i; float a[8], y[8]; unpk8(araw[i], a);
#pragma unroll
        for (int e = 0; e < 8; ++e) sm[e] += a[e];
        const float inv = (tl + 1 >= K) ? (1.0f / (float)K) : __builtin_amdgcn_rcpf((float)(tl + 1));
#pragma unroll
        for (int e = 0; e < 8; ++e) y[e] = sm[e] * inv - a[e];
        *(LAS u32x4_t*)(dst + i * pitch) = pk8(y);
        if (i < 7) { float r[8]; if (i + 1 - K >= 0) unpk8(araw[i + 1 - K >= 0 ? i + 1 - K : 0], r); else unpk8(hraw[(K - 2 - i) >= 0 ? (K - 2 - i) : 0], r);
#pragma unroll
            for (int e = 0; e < 8; ++e) sm[e] -= r[e]; } }
}
__device__ __forceinline__ void mixer_phase(Frame& F, const bf16* __restrict__ proj, const float* __restrict__ cw, const bf16* __restrict__ wpool, bf16* mix) {
    constexpr int PITCH = 1040;
    LAS unsigned char* P = F.lds + RING_OFF;
    const int tid = F.tid, cc = tid & 63, tg = tid >> 6, c0 = 8 * cc;
    for (int u = F.vcu; u < T / 64; u += F.G) {
        const int t0 = u * 64 + 8 * tg; const int tl0 = t0 & (SEQ - 1);
        const bf16* pr = proj + (size_t)t0 * EVEN_IN;
        {
            float w0[8], w1[8], w2[8];
#pragma unroll
            for (int e = 0; e < 8; ++e) { w0[e] = cw[c0 + e]; w1[e] = cw[AW + c0 + e]; w2[e] = cw[2 * AW + c0 + e]; }
            float pm2[8], pm1[8];
#pragma unroll
            for (int e = 0; e < 8; ++e) { pm2[e] = 0.f; pm1[e] = 0.f; }
            if (tl0 >= 2) { float a[8], c[8]; ld8(pr - 2 * EVEN_IN + c0, a); ld8(pr - 2 * EVEN_IN + 2 * AW + c0, c);
#pragma unroll
                for (int e = 0; e < 8; ++e) pm2[e] = a[e] * c[e];
                ld8(pr - EVEN_IN + c0, a); ld8(pr - EVEN_IN + 2 * AW + c0, c);
#pragma unroll
                for (int e = 0; e < 8; ++e) pm1[e] = a[e] * c[e]; }
#pragma unroll
            for (int j = 0; j < 8; ++j) { float a[8], c[8], gb[8], y[8]; ld8(pr + j * EVEN_IN + c0, a); ld8(pr + j * EVEN_IN + 2 * AW + c0, c); ld8(pr + j * EVEN_IN + AW + c0, gb);
#pragma unroll
                for (int e = 0; e < 8; ++e) { const float pc = a[e] * c[e]; y[e] = gb[e] * (w0[e] * pm2[e] + w1[e] * pm1[e] + w2[e] * pc); pm2[e] = pm1[e]; pm1[e] = pc; }
                *(u32x4_t*)(mix + (size_t)(t0 + j) * D + c0) = pk8(y); }
        }
        {
            const int g = F.wave >> 1, tgp = (F.wave & 1) * 4 + (F.lane >> 4), c0p = 8 * (16 * g + (F.lane & 15));
            const int t0p = u * 64 + 8 * tgp, tl0p = t0p & (SEQ - 1);
            const bf16* pin = proj + (size_t)t0p * EVEN_IN + 3 * AW + c0p; LAS unsigned char* dst = P + (8 * tgp) * PITCH + c0p * 2;
            if (g == 0) pooled_part<2>(pin, tl0p, dst, PITCH); else if (g == 1) pooled_part<4>(pin, tl0p, dst, PITCH); else if (g == 2) pooled_part<8>(pin, tl0p, dst, PITCH); else pooled_part<16>(pin, tl0p, dst, PITCH);
        }
        {
            const int g = F.wave >> 1, th = F.wave & 1, fr = F.lane & 15, fq = F.lane >> 4;
            const bf16* wb = wpool + (size_t)g * 128 * 128 + (size_t)fr * 128 + 8 * fq;
            __builtin_amdgcn_sched_barrier(0);
            pg8::bf16x8 bfa[8][4];
#pragma unroll
            for (int n = 0; n < 6; ++n)
#pragma unroll
                for (int ks = 0; ks < 4; ++ks) bfa[n][ks] = *(const pg8::bf16x8*)(wb + (size_t)n * 16 * 128 + 32 * ks);
            __syncthreads();
            pg8::bf16x8 af[2][4];
#pragma unroll
            for (int m = 0; m < 2; ++m)
#pragma unroll
                for (int ks = 0; ks < 4; ++ks) af[m][ks] = *(const LAS pg8::bf16x8*)(P + (32 * th + 16 * m + fr) * PITCH + (128 * g + 32 * ks + 8 * fq) * 2);
#pragma unroll
            for (int n = 6; n < 8; ++n)
#pragma unroll
                for (int ks = 0; ks < 4; ++ks) bfa[n][ks] = *(const pg8::bf16x8*)(wb + (size_t)n * 16 * 128 + 32 * ks);
            bf16* orow = mix + (size_t)(u * 64 + 32 * th + fr) * D + AW + 128 * g + 4 * fq;
#pragma unroll
            for (int n = 0; n < 8; ++n) {
                pg8::f32x4 a0 = {0.f, 0.f, 0.f, 0.f}, a1 = a0;
#pragma unroll
                for (int ks = 0; ks < 4; ++ks) { a0 = __builtin_amdgcn_mfma_f32_16x16x32_bf16(bfa[n][ks], af[0][ks], a0, 0, 0, 0); a1 = __builtin_amdgcn_mfma_f32_16x16x32_bf16(bfa[n][ks], af[1][ks], a1, 0, 0, 0); }
                u32x2_t w; w.x = pg8::cvt_pk_bf16(a0[0], a0[1]); w.y = pg8::cvt_pk_bf16(a0[2], a0[3]); *(u32x2_t*)(orow + 16 * n) = w;
                w.x = pg8::cvt_pk_bf16(a1[0], a1[1]); w.y = pg8::cvt_pk_bf16(a1[2], a1[3]); *(u32x2_t*)(orow + (size_t)16 * D + 16 * n) = w; }
        }
        __syncthreads();
    }
}

namespace att {
constexpr int OPB = 136, VP = 160, NTAB = 256;
constexpr int LDS_TAB = 0, LDS_V = 3 * NTAB * 4, V_BYTES = 32 * VP, LDS_L = LDS_V + 8 * V_BYTES, LDS_O = LDS_L + 2048, LDS_END = LDS_O + 512 * OPB;
static_assert(LDS_V % 16 == 0 && LDS_O % 16 == 0 && LDS_END <= RING_BYTES, "attention LDS map");
typedef short v4i16_t __attribute__((ext_vector_type(4)));
__device__ __forceinline__ v4i16_t vtr(const LAS unsigned char* p) { return __builtin_amdgcn_ds_read_tr16_b64_v4i16((LAS v4i16_t*)p); }
struct KV { pg8::bf16x8 k[2][2]; u32x4_t v[4]; };
__device__ __forceinline__ pg8::f32x4 bf4_to_f32(u32x2_t w) { return (pg8::f32x4){__uint_as_float(w.x << 16), __uint_as_float(w.x & 0xffff0000u), __uint_as_float(w.y << 16), __uint_as_float(w.y & 0xffff0000u)}; }
template <int MODE, int SH, bool CLAMP, int NT>
__device__ __forceinline__ void item(const bf16* __restrict__ qkv, bf16* __restrict__ ao, LAS unsigned char* lds, int wave, int lane, int b, int h, int p0, int rel) {
    constexpr int DIL = 1 << SH, NS = 4 + NT / 2;
    { int l_ = threadIdx.x & 63; asm volatile("" : "+v"(l_)); lane = l_; }
    const int q = lane & 15, g4 = lane >> 4;
    const int base_pos = p0 + rel, res = base_pos & (DIL - 1), i0 = base_pos >> SH, kmin = 128 - i0;
    const size_t rowbase = (size_t)b * SEQ;
    const bf16* hq = qkv + (size_t)(b * NH + h) * SEQ * HD;
    const bf16* qp = hq + (size_t)(base_pos + DIL * q) * HD + 8 * g4;
    pg8::bf16x8 qf[NT][2];
#pragma unroll
    for (int t = 0; t < NT; ++t) { qf[t][0] = *(const pg8::bf16x8*)(qp + (size_t)t * 16 * DIL * HD); qf[t][1] = *(const pg8::bf16x8*)(qp + (size_t)t * 16 * DIL * HD + 32); }
    const bf16* kbase = hq + (size_t)T * D + 8 * g4;
    const bf16* vbase = hq + (size_t)2 * T * D + 8 * (lane & 7);
    LAS unsigned char* vbuf = lds + LDS_V + wave * V_BYTES;
    LAS unsigned char* vw = vbuf + (lane >> 3) * VP + (lane & 7) * 16;
    const LAS unsigned char* vr = vbuf + (4 * g4 + (q >> 2)) * VP + (q & 3) * 8;
    const LAS float* tab = (const LAS float*)(lds + LDS_TAB) + (SH == 4 ? 2 : (SH == 2 ? 1 : 0)) * NTAB + (15 - q + 4 * g4);
    asm volatile("" : "+v"(tab), "+v"(vw), "+v"(vr));
    pg8::f32x4 o[NT][4]; float lsum[NT];
#pragma unroll
    for (int t = 0; t < NT; ++t) { lsum[t] = 0.f;
#pragma unroll
        for (int dt = 0; dt < 4; ++dt) o[t][dt] = (pg8::f32x4){0.f, 0.f, 0.f, 0.f}; }
    const char* kb_u = (const char*)(hq + (size_t)T * D); const char* vb_u = (const char*)(hq + (size_t)2 * T * D);
    const unsigned koff0 = (unsigned)(((res + ((i0 - 128 + q) << SH)) * HD + 8 * g4) * 2);
    const unsigned voff0 = (unsigned)(((res + ((i0 - 128 + (lane >> 3)) << SH)) * HD + 8 * (lane & 7)) * 2);
    auto load = [&](int st, KV& d) {
#pragma unroll
        for (int j = 0; j < 2; ++j) { const char* kp;
            if (CLAMP) { int ik = i0 - 128 + 32 * st + 16 * j + q; ik = ik < 0 ? 0 : ik; kp = kb_u + (size_t)(unsigned)(((res + (ik << SH)) * HD + 8 * g4) * 2); }
            else kp = kb_u + (size_t)(((32 * st + 16 * j) << SH) * HD * 2) + (size_t)koff0;
            d.k[j][0] = *(const pg8::bf16x8*)kp; d.k[j][1] = *(const pg8::bf16x8*)(kp + 64); }
#pragma unroll
        for (int i = 0; i < 4; ++i) { const char* vp;
            if (CLAMP) { int ik = i0 - 128 + 32 * st + 8 * i + (lane >> 3); ik = ik < 0 ? 0 : ik; vp = vb_u + (size_t)(unsigned)(((res + (ik << SH)) * HD + 8 * (lane & 7)) * 2); }
            else vp = vb_u + (size_t)(((32 * st + 8 * i) << SH) * HD * 2) + (size_t)voff0;
            d.v[i] = *(const u32x4_t*)vp; }
    };
    KV cur; load(0, cur);
#pragma unroll
    for (int st = 0; st < NS; ++st) {
#pragma unroll
        for (int i = 0; i < 4; ++i) *(LAS u32x4_t*)(vw + 8 * i * VP) = cur.v[i];
        asm volatile("" ::: "memory");
        KV nxt; if (st < NS - 1) { load(st + 1, nxt); __builtin_amdgcn_sched_barrier(0); }
        pg8::bf16x8 pb[NT];
        const LAS float* tabs = tab + 32 * st; asm volatile("" : "+v"(tabs));
        pg8::f32x4 bq[2] = {(pg8::f32x4){0.f, 0.f, 0.f, 0.f}, (pg8::f32x4){0.f, 0.f, 0.f, 0.f}};
        { const LAS float* tabt = tabs + 16 * 3; if (NT > 2) asm volatile("" : "+v"(tabt));
#pragma unroll
          for (int j = 0; j < 2; ++j) if (2 * st + j >= 0 && 2 * st + j <= 8) bq[j] = (pg8::f32x4){tabt[16 * j], tabt[16 * j + 1], tabt[16 * j + 2], tabt[16 * j + 3]}; }
#pragma unroll
        for (int t = 0; t < NT; ++t) { pg8::f32x4 sT[2], bc[2]; bc[0] = bq[0]; bc[1] = bq[1];
            if (t + 1 < NT) { const LAS float* tabt = tabs + 16 * (3 - (t + 1)); if (NT > 2) asm volatile("" : "+v"(tabt));
#pragma unroll
                for (int j = 0; j < 2; ++j) if (2 * st + j >= t + 1 && 2 * st + j <= t + 9) bq[j] = (pg8::f32x4){tabt[16 * j], tabt[16 * j + 1], tabt[16 * j + 2], tabt[16 * j + 3]}; }
#pragma unroll
            for (int j = 0; j < 2; ++j) { if (2 * st + j >= t && 2 * st + j <= t + 8) {
                sT[j] = __builtin_amdgcn_mfma_f32_16x16x32_bf16(cur.k[j][0], qf[t][0], bc[j], 0, 0, 0);
                sT[j] = __builtin_amdgcn_mfma_f32_16x16x32_bf16(cur.k[j][1], qf[t][1], sT[j], 0, 0, 0); } }
            float p[2][4];
#pragma unroll
            for (int j = 0; j < 2; ++j)
#pragma unroll
                for (int r = 0; r < 4; ++r) { if (2 * st + j >= t && 2 * st + j <= t + 8) { const int kk = 32 * st + 16 * j + 4 * g4 + r; float sv = sT[j][r]; if (CLAMP) sv = kk < kmin ? -1e30f : sv;
                    p[j][r] = __builtin_amdgcn_exp2f(sv); lsum[t] += p[j][r]; } else p[j][r] = 0.f; }
            u32x4_t pw; pw.x = cvtpk_c(p[0][0], p[0][1]); pw.y = cvtpk_c(p[0][2], p[0][3]); pw.z = cvtpk_c(p[1][0], p[1][1]); pw.w = cvtpk_c(p[1][2], p[1][3]);
            pb[t] = __builtin_bit_cast(pg8::bf16x8, pw); if (NT > 2) { asm volatile("" : "+v"(lsum[t])); __builtin_amdgcn_sched_barrier(0); } }
#pragma unroll
        for (int dt = 0; dt < 4; ++dt) { const v4i16_t lo = vtr(vr + dt * 32), hi = vtr(vr + 16 * VP + dt * 32);
            const pg8::bf16x8 va = (pg8::bf16x8){lo[0], lo[1], lo[2], lo[3], hi[0], hi[1], hi[2], hi[3]};
#pragma unroll
            for (int t = 0; t < NT; ++t) if (2 * st + 1 >= t && 2 * st <= t + 8) o[t][dt] = __builtin_amdgcn_mfma_f32_16x16x32_bf16(va, pb[t], o[t][dt], 0, 0, 0); }
        asm volatile("" ::: "memory"); __builtin_amdgcn_sched_barrier(0);
        if (st < NS - 1) cur = nxt;
    }
#pragma unroll
    for (int t = 0; t < NT; ++t) { float ls = lsum[t]; ls += __shfl_xor(ls, 16); ls += __shfl_xor(ls, 32);
        const int posu = rel + DIL * (16 * t + q), slot = (posu & ~0xF) | ((posu ^ (posu >> 4)) & 0xF);
        LAS unsigned char* Ol = lds + LDS_O + slot * OPB + 8 * g4; LAS float* Ll = (LAS float*)(lds + LDS_L) + slot;
        if (MODE == 0) {
#pragma unroll
            for (int dt = 0; dt < 4; ++dt) { u32x2_t w; w.x = cvtpk_c(o[t][dt][0], o[t][dt][1]); w.y = cvtpk_c(o[t][dt][2], o[t][dt][3]); *(LAS u32x2_t*)(Ol + 32 * dt) = w; }
            if (g4 == 0) *Ll = ls;
        } else if (MODE == 1) {
#pragma unroll
            for (int dt = 0; dt < 4; ++dt) { const pg8::f32x4 v = bf4_to_f32(*(LAS u32x2_t*)(Ol + 32 * dt)) + o[t][dt]; u32x2_t w; w.x = cvtpk_c(v[0], v[1]); w.y = cvtpk_c(v[2], v[3]); *(LAS u32x2_t*)(Ol + 32 * dt) = w; }
            if (g4 == 0) *Ll = *Ll + ls;
        } else {
            const float inv = 1.0f / (*Ll + ls);
            bf16* op = ao + (rowbase + p0 + posu) * D + h * HD + 4 * g4;
#pragma unroll
            for (int dt = 0; dt < 4; ++dt) { const pg8::f32x4 v = (bf4_to_f32(*(LAS u32x2_t*)(Ol + 32 * dt)) + o[t][dt]) * inv;
                u32x2_t w; w.x = cvtpk_c(v[0], v[1]); w.y = cvtpk_c(v[2], v[3]); *(u32x2_t*)(op + 16 * dt) = w; }
        }
    }
}
}
__device__ __forceinline__ void attn_phase(Frame& F, const bf16* qkv, const float* rt, bf16* ao) {
    LAS unsigned char* lds = F.lds + RING_OFF;
    const int nunits = BATCH * NH * (SEQ / 512);
    for (int i = 0; i * F.G < nunits; ++i) {
        int bh, blk;
        if (F.G == 256) { const int x = F.vcu >> 5, loc = F.vcu & 31; bh = 8 * x + 4 * i + (loc >> 3); blk = loc & 7; }
        else { const int u = i * F.G + F.vcu; if (u >= nunits) break; bh = u >> 3; blk = u & 7; }
        const int b = bh / NH, h = bh % NH, p0 = blk * 512;
        for (int j = F.tid; j < 3 * att::NTAB; j += NWAVES * 64) ((LAS float*)(lds + att::LDS_TAB))[j] = rt[h * 3 * att::NTAB + j];
        __syncthreads();
#pragma unroll 1
        for (int k = 0; k < 2; ++k) { const int g = 2 * F.wave + k;
            if (((p0 + g) >> 4) < 128) att::item<0, 4, true, 2>(qkv, ao, lds, F.wave, F.lane, b, h, p0, g); else att::item<0, 4, false, 2>(qkv, ao, lds, F.wave, F.lane, b, h, p0, g); }
        __syncthreads();
        { const int g = F.wave; const int rel = 256 * (g >> 2) + (g & 3);
            if (((p0 + rel) >> 2) < 128) { att::item<1, 2, true, 2>(qkv, ao, lds, F.wave, F.lane, b, h, p0, rel); att::item<1, 2, true, 2>(qkv, ao, lds, F.wave, F.lane, b, h, p0, rel + 128); }
            else att::item<1, 2, false, 4>(qkv, ao, lds, F.wave, F.lane, b, h, p0, rel); }
        __syncthreads();
        { const int rel = 64 * F.wave;
            if ((p0 + rel) < 128) { att::item<2, 0, true, 2>(qkv, ao, lds, F.wave, F.lane, b, h, p0, rel); att::item<2, 0, true, 2>(qkv, ao, lds, F.wave, F.lane, b, h, p0, rel + 32); }
            else att::item<2, 0, false, 4>(qkv, ao, lds, F.wave, F.lane, b, h, p0, rel); }
        __syncthreads();
    }
}

__global__ void __launch_bounds__(NWAVES * 64, 2) mega_fwd(Args args) {
    extern __shared__ __attribute__((aligned(16))) unsigned char lds[];
    Frame F;
    F.lds = (LAS unsigned char*)lds; F.MISC = (volatile LAS unsigned*)(F.lds + MISC_OFF);
    F.tid = threadIdx.x; F.lane = F.tid & 63; F.wave = __builtin_amdgcn_readfirstlane(F.tid >> 6);
    F.G = gridDim.x; { const int bx = blockIdx.x; F.vcu = (F.G % 8 == 0) ? (bx % 8) * (F.G / 8) + bx / 8 : bx; }
    unsigned char* ws = args.ws; F.ctl = (gu32*)(ws + WS_CTL);
    for (int u = F.tid; u < (LDS_BYTES - LDSCTL_OFF) / 4; u += NWAVES * 64) ((LAS unsigned*)(F.lds + LDSCTL_OFF))[u] = 0u;
    __syncthreads();
    const int lo = args.ph_lo, hi = args.ph_hi; const bool use_bar = (hi - lo) > 1;
    XcdBarrier bar; bar.bar = (unsigned*)(F.ctl + CW_BAR) + args.li * XCD_BAR_WORDS; bar.x = 0; bar.st = nullptr;
    if (use_bar) bar = xcd_barrier_post((unsigned*)(F.ctl + CW_BAR) + args.li * XCD_BAR_WORDS, F.MISC + 8);
#ifndef PHASES_COMPILED
#define PHASES_COMPILED 0x7FF
#endif
#define IN(k) ((((PHASES_COMPILED) >> (k)) & 1) && lo <= (k) && (k) < hi)
#ifndef REP_MASK
#define REP_MASK 0
#endif
#define REPS(k) for (int rep_ = 0; rep_ < ((((REP_MASK) >> (k)) & 1) ? 2 : 1); ++rep_)
#ifndef SEAM_REPS
#define SEAM_REPS 1
#endif
#define SEAM_WORK(k, lo_, hi_) do { if (IN(k) && IN((k) + 1)) { if (CONVERT_IN_SEAMS) { ConvertWork cw_{&args, F.lds + RING_OFF, F.vcu, F.G, F.lane, (lo_), (hi_)}; xcd_barrier_work(bar, F.wave, cw_); } else xcd_barrier(bar); } } while (0)
#define SEAM_PLAIN(k) do { if (IN(k) && IN((k) + 1)) { for (int sr_ = 0; sr_ < SEAM_REPS; ++sr_) xcd_barrier(bar); } } while (0)
constexpr int CHUNK = (IT_END - IT_OUT + 7) / 8;
static_assert(IT_UP0 <= IT_OUT + 2 * CHUNK && IT_DN0 <= IT_OUT + 3 * CHUNK && IT_QKV <= IT_OUT + 4 * CHUNK && IT_O <= IT_OUT + 5 * CHUNK && IT_UP1 <= IT_OUT + 7 * CHUNK && IT_DN1 <= IT_OUT + 8 * CHUNK, "conversion deadlines");
#define SEAM(k) do { if ((k) < 8) SEAM_WORK(k, IT_OUT + (k) * CHUNK, (IT_OUT + ((k) + 1) * CHUNK) < IT_END ? (IT_OUT + ((k) + 1) * CHUNK) : IT_END); else SEAM_PLAIN(k); } while (0)
    float* ssq = (float*)(ws + WS_SSQ); float* out = args.out;
    bf16* xb = (bf16*)(ws + WS_XB); bf16* proj = (bf16*)(ws + WS_PROJ); bf16* mix = (bf16*)(ws + WS_MIX); bf16* qkv = (bf16*)(ws + WS_QKV); bf16* ao = (bf16*)(ws + WS_AO); bf16* act = (bf16*)(ws + WS_ACT);
    PG8_LAS unsigned char* ring = F.lds + RING_OFF;

    if (IN(0)) REPS(0) { p0_prologue(F, args); } SEAM(0);
    if (IN(1)) REPS(1) { pg8::Gemm g{xb, (const bf16*)(ws + WS_WIN), T, EVEN_IN, D}; pg8::StaticOrder S; S.init(T, EVEN_IN, F.G, (int)blockIdx.x);
        pg8::EpiRowScale E{proj, EVEN_IN, ssq};
        pg8::gemm_phase<pg8::EpiRowScale, pg8::StaticOrder, true, true>(ring, g, S, E); } SEAM(1);
    if (IN(2)) REPS(2) { mixer_phase(F, proj, args.in[4], (const bf16*)(ws + WS_WPOOL), mix); } SEAM(2);
#define PHASE_UP(pu, l) do { if (IN(pu)) REPS(pu) { pg8::Gemm g{xb, (const bf16*)(ws + WS_WUP) + (size_t)(l) * DFF2 * D, 68 * 256, DFF2, D}; pg8::OverlapOrder S; S.init(68 * 256, DFF2, F.G, (int)blockIdx.x); \
        pg8::EpiConvGlu E{act, ssq + ((l) == 0 ? T : 3 * T), args.in[15] + (size_t)(l) * 3 * DFF2, args.in[16] + (size_t)(l) * DFF2, (PG8_LAS float*)(F.lds + HALO_OFF)}; \
        pg8::gemm_phase<pg8::EpiConvGlu, pg8::OverlapOrder, true, true>(ring, g, S, E); } SEAM(pu); } while (0)
#define PHASE_RES(p, BF, OF, OX, SQ, Aptr, Wptr, Kdim, basefptr, outfptr, xbptr, ssqptr) do { if (IN(p)) { pg8::Gemm g{(Aptr), (Wptr), T, D, (Kdim)}; pg8::StaticOrder S; S.init(T, D, F.G, (int)blockIdx.x); \
        typedef pg8::EpiResidual<BF, OF, OX, SQ> Epi_; Epi_ E{(basefptr), xb, (outfptr), (xbptr), (ssqptr)}; \
        pg8::gemm_phase<Epi_, pg8::StaticOrder, false, true>(ring, g, S, E); } SEAM(p); } while (0)
    PHASE_RES(3, false, false, true, true, mix, (const bf16*)(ws + WS_WOUT), D, (const float*)nullptr, (float*)nullptr, xb, ssq + T);
    PHASE_UP(4, 0);
    PHASE_RES(5, false, false, true, true, act, (const bf16*)(ws + WS_WDN), DFF, (const float*)nullptr, (float*)nullptr, xb, ssq + 2 * T);
    if (IN(6)) REPS(6) { pg8::Gemm g{xb, (const bf16*)(ws + WS_WQKV), T, NQKV, D}; pg8::StaticOrder S; S.init(T, NQKV, F.G, (int)blockIdx.x);
        pg8::EpiQkv E{qkv, ssq + 2 * T, args.in[10], args.in[11]};
        pg8::gemm_phase<pg8::EpiQkv, pg8::StaticOrder, true, true>(ring, g, S, E); } SEAM(6);
    if (IN(7)) REPS(7) { attn_phase(F, qkv, (const float*)(ws + WS_RT), ao); } SEAM(7);
    PHASE_RES(8, false, false, true, true, ao, (const bf16*)(ws + WS_WO), D, (const float*)nullptr, (float*)nullptr, xb, ssq + 3 * T);
    PHASE_UP(9, 1);
    PHASE_RES(10, false, true, false, false, act, (const bf16*)(ws + WS_WDN) + (size_t)D * DFF, DFF, (const float*)nullptr, out, (bf16*)nullptr, (float*)nullptr);
#undef IN
#undef SEAM
}

#ifndef FAST_MASK
#define FAST_MASK 0x7FF
#endif
extern "C" void kernel_launch(void* const* d_in, const int* in_sizes, int n_in, void* d_out, int out_size, void* d_ws, size_t ws_size, hipStream_t stream) {
    static int grid = 0;
    if (grid == 0) {
        if (n_in != 18 || out_size != T * D || ws_size < WS_END) { fprintf(stderr, "kernel_launch: unexpected shapes n_in %d out %d ws %zu\n", n_in, out_size, ws_size); grid = -1; return; }
        int dev = 0, cus = 0;
        if (hipGetDevice(&dev) != hipSuccess || hipDeviceGetAttribute(&cus, hipDeviceAttributeMultiprocessorCount, dev) != hipSuccess) { grid = -1; return; }
        if (hipFuncSetAttribute((const void*)mega_fwd, hipFuncAttributeMaxDynamicSharedMemorySize, LDS_BYTES) != hipSuccess) { fprintf(stderr, "kernel_launch: hipFuncSetAttribute failed\n"); grid = -1; return; }
        (void)hipFuncSetAttribute((const void*)n_gemm_rowscale, hipFuncAttributeMaxDynamicSharedMemorySize, 18 * 4096);
        (void)hipFuncSetAttribute((const void*)n_gemm_residual, hipFuncAttributeMaxDynamicSharedMemorySize, 18 * 4096);
        (void)hipFuncSetAttribute((const void*)n_ffn_up, hipFuncAttributeMaxDynamicSharedMemorySize, 18 * 4096);
        (void)hipFuncSetAttribute((const void*)n_qkv, hipFuncAttributeMaxDynamicSharedMemorySize, 18 * 4096);
        (void)hipGetLastError();
        grid = cus;
    }
    if (grid < 0) return;
    const float* x = (const float*)d_in[0];
    const float* even_norm = (const float*)d_in[2]; const float* w_in = (const float*)d_in[3]; const float* even_cw = (const float*)d_in[4];
    const float* pool_w = (const float*)d_in[5]; const float* pool_s = (const float*)d_in[6]; const float* w_out = (const float*)d_in[7];
    const float* odd_norm = (const float*)d_in[8]; const float* w_qkv = (const float*)d_in[9]; const float* gq = (const float*)d_in[10]; const float* gk = (const float*)d_in[11];
    const float* w_o = (const float*)d_in[12]; const float* ffn_norm = (const float*)d_in[13]; const float* w_up = (const float*)d_in[14];
    const float* ffn_cw = (const float*)d_in[15]; const float* ffn_cb = (const float*)d_in[16]; const float* w_dn = (const float*)d_in[17];
    unsigned char* ws = (unsigned char*)d_ws; float* out = (float*)d_out;
    float* ssq = (float*)(ws + WS_SSQ); float* bias = (float*)(ws + WS_BIAS);
    bf16_t* xb = (bf16_t*)(ws + WS_XB); bf16_t* proj = (bf16_t*)(ws + WS_PROJ); bf16_t* mix = (bf16_t*)(ws + WS_MIX);
    bf16_t* qkv = (bf16_t*)(ws + WS_QKV); bf16_t* ao = (bf16_t*)(ws + WS_AO); bf16_t* act = (bf16_t*)(ws + WS_ACT);
    const size_t LDSB = 18 * 4096;
    (void)hipMemsetAsync(ws + WS_CTL, 0, 1 * MiB, stream);
    Args a{};
    for (int i = 0; i < 18; ++i) a.in[i] = (const float*)d_in[i];
    a.out = out; a.ws = ws;
    const unsigned fast = FAST_MASK;
    int p = 0, li = 0;
    while (p < 11) {
        if ((fast >> p) & 1u) {
            int q = p; while (q < 11 && ((fast >> q) & 1u)) ++q;
            a.ph_lo = p; a.ph_hi = q; a.li = li++;
            hipLaunchKernelGGL(mega_fwd, dim3(grid), dim3(NWAVES * 64), LDS_BYTES, stream, a);
            p = q; continue;
        }
        switch (p) {
            case 0: n_prologue<<<T / 4, 256, 0, stream>>>(x, ssq, xb); n_bias<<<(3 * 129 * 16 + 255) / 256, 256, 0, stream>>>((const float*)d_in[1], bias); break;
            case 1: n_gemm_rowscale<<<dim3(EVEN_IN / 256, T / 16), 256, LDSB, stream>>>(xb, even_norm, w_in, EVEN_IN, D, ssq, proj); break;
            case 2: n_mixer<<<T / 16, 512, 0, stream>>>(proj, even_cw, pool_w, pool_s, mix); break;
            case 3: n_gemm_residual<<<dim3(D / 256, T / 16), 256, LDSB, stream>>>(mix, w_out, D, x, out, xb, ssq + T); break;
            case 4: n_ffn_up<<<dim3(DFF / 256, T / 16), 256, LDSB, stream>>>(xb, ffn_norm, w_up, ssq + T, ffn_cw, ffn_cb, act); break;
            case 5: n_gemm_residual<<<dim3(D / 256, T / 16), 256, LDSB, stream>>>(act, w_dn, DFF, out, out, xb, ssq + 2 * T); break;
            case 6: n_qkv<<<dim3(NQKV / 256, T / 16), 256, LDSB, stream>>>(xb, odd_norm, w_qkv, ssq + 2 * T, gq, gk, qkv); break;
            case 7: n_attn<<<T * NH / 4, 256, 0, stream>>>(qkv, bias, ao); break;
            case 8: n_gemm_residual<<<dim3(D / 256, T / 16), 256, LDSB, stream>>>(ao, w_o, D, out, out, xb, ssq + 3 * T); break;
            case 9: n_ffn_up<<<dim3(DFF / 256, T / 16), 256, LDSB, stream>>>(xb, ffn_norm + D, w_up + (size_t)D * DFF2, ssq + 3 * T, ffn_cw + 3 * DFF2, ffn_cb + DFF2, act); break;
            case 10: n_gemm_residual<<<dim3(D / 256, T / 16), 256, LDSB, stream>>>(act, w_dn + (size_t)DFF * D, DFF, out, out, nullptr, nullptr); break;
        }
        ++p;
    }
}
```

```cpp
#include <hip/hip_runtime.h>
#include <cstdio>
#include <cstdint>

typedef unsigned short bf16_t;
constexpr int BATCH = 4, SEQ = 4096, D = 1024, T = BATCH * SEQ;
constexpr int EVEN_IN = 2048, AW = 512, DFF = 2816, DFF2 = 5632, NH = 16, HD = 64, NQKV = 3072;
constexpr int PW = 1536;
constexpr float EPS = 1e-6f;
constexpr float LOG2E = 1.4426950408889634f;

__device__ __forceinline__ float bf2f(bf16_t v) { return __uint_as_float((unsigned)v << 16); }
__device__ __forceinline__ bf16_t f2bf(float f) { unsigned u = __float_as_uint(f); return (bf16_t)((u + 0x7fffu + ((u >> 16) & 1u)) >> 16); }
__device__ __forceinline__ float wave_sum(float v) {
#pragma unroll
    for (int o = 1; o < 64; o <<= 1) v += __shfl_xor(v, o);
    return v;
}

constexpr size_t MiB = 1u << 20;
constexpr size_t WS_CTL = 0;
constexpr size_t WS_SSQ = 64 * 1024;
constexpr size_t WS_BIAS = 512 * 1024;
constexpr size_t WS_XB = 50 * MiB;
constexpr size_t WS_R = 84 * MiB;
constexpr size_t WS_PROJ = WS_R;
constexpr size_t WS_MIX = WS_R + 96 * MiB;
constexpr size_t WS_QKV = WS_R;
constexpr size_t WS_AO = WS_R + 96 * MiB;
constexpr size_t WS_ACT = WS_R;
constexpr size_t WS_SIDE = WS_R + 128 * MiB;
constexpr size_t WS_END = WS_SIDE + MiB;

__global__ void __launch_bounds__(256) n_prologue(const float* __restrict__ x, float* ssq, bf16_t* xb) {
    const int wave = (blockIdx.x * 256 + threadIdx.x) >> 6, lane = threadIdx.x & 63;
    if (wave >= T) return;
    const float* xr = x + (size_t)wave * D; float s = 0.f;
    for (int j = lane; j < D; j += 64) { float v = xr[j]; s += v * v; xb[(size_t)wave * D + j] = f2bf(v); }
    s = wave_sum(s);
    if (lane == 0) ssq[wave] = s;
}
__global__ void n_bias(const float* __restrict__ rel, float* bias) {
    const int i = blockIdx.x * blockDim.x + threadIdx.x;
    if (i >= 3 * 129 * 16) return;
    const int h = i % 16, j = (i / 16) % 129, br = i / (16 * 129);
    const int dil = br == 0 ? 1 : (br == 1 ? 4 : 16);
    const int dist = j * dil; int b;
    if (dist < 16) b = dist; else { int l = 16 + (int)(log((double)dist / 16.0) / log(128.0) * 16.0); b = l < 31 ? l : 31; }
    bias[i] = rel[b * 16 + h] * LOG2E;
}

template <int NR>
__device__ __forceinline__ void naive_tile(const bf16_t* __restrict__ A, int K, const int* rows, const float* __restrict__ g,
                                           const float* __restrict__ W, int N, int col, float* acc, float* sA  ) {
    for (int r = 0; r < NR; ++r) acc[r] = 0.f;
    for (int k0 = 0; k0 < K; k0 += 1024) {
        const int kc = (K - k0) < 1024 ? (K - k0) : 1024;
        __syncthreads();
        for (int i = threadIdx.x; i < NR * kc; i += 256) { const int r = i / kc, k = i % kc; const int row = rows[r];
            float v = row >= 0 ? bf2f(A[(size_t)row * K + k0 + k]) : 0.f; if (g) v *= g[k0 + k]; sA[r * 1024 + k] = v; }
        __syncthreads();
        for (int k = 0; k < kc; k += 4) {
            const float w0 = W[(size_t)(k0 + k) * N + col], w1 = W[(size_t)(k0 + k + 1) * N + col], w2 = W[(size_t)(k0 + k + 2) * N + col], w3 = W[(size_t)(k0 + k + 3) * N + col];
#pragma unroll
            for (int r = 0; r < NR; ++r) { const float4 a = *(const float4*)(sA + r * 1024 + k); acc[r] += a.x * w0 + a.y * w1 + a.z * w2 + a.w * w3; }
        }
    }
}

__global__ void __launch_bounds__(256) n_gemm_rowscale(const bf16_t* __restrict__ A, const float* __restrict__ g, const float* __restrict__ W, int N, int K,
                                                        const float* __restrict__ ssq, bf16_t* out) {
    extern __shared__ float sA[];
    __shared__ int rows[16];
    const int row0 = blockIdx.y * 16, col = blockIdx.x * 256 + threadIdx.x;
    if (threadIdx.x < 16) rows[threadIdx.x] = row0 + threadIdx.x;
    __syncthreads();
    float acc[16];
    naive_tile<16>(A, K, rows, g, W, N, col, acc, sA);
    for (int r = 0; r < 16; ++r) { const float rs = rsqrtf(ssq[row0 + r] * (1.f / D) + EPS); out[(size_t)(row0 + r) * N + col] = f2bf(acc[r] * rs); }
}
__global__ void __launch_bounds__(256) n_gemm_residual(const bf16_t* __restrict__ A, const float* __restrict__ W, int K,
                                                        const float* base, float* out, bf16_t* xb, float* ssq_next) {
    extern __shared__ float sA[];
    __shared__ int rows[16];
    const int row0 = blockIdx.y * 16, col = blockIdx.x * 256 + threadIdx.x;
    if (threadIdx.x < 16) rows[threadIdx.x] = row0 + threadIdx.x;
    __syncthreads();
    float acc[16];
    naive_tile<16>(A, K, rows, nullptr, W, D, col, acc, sA);
    for (int r = 0; r < 16; ++r) { const size_t o = (size_t)(row0 + r) * D + col; const float v = base[o] + acc[r]; out[o] = v;
        if (xb) xb[o] = f2bf(v);
        if (ssq_next) { const float s = wave_sum(v * v); if ((threadIdx.x & 63) == 0) atomicAdd(ssq_next + row0 + r, s); } }
}
__global__ void __launch_bounds__(256) n_ffn_up(const bf16_t* __restrict__ A, const float* __restrict__ g, const float* __restrict__ W,
                                                 const float* __restrict__ ssq, const float* __restrict__ cw, const float* __restrict__ cb, bf16_t* act) {
    extern __shared__ float sA[];
    __shared__ int rows[18];
    const int row0 = blockIdx.y * 16, c = blockIdx.x * 256 + threadIdx.x;
    if (threadIdx.x < 18) { const int r = row0 - 2 + threadIdx.x; rows[threadIdx.x] = ((row0 % SEQ) == 0 && threadIdx.x < 2) ? -1 : r; }
    __syncthreads();
    float ag[18], au[18];
    naive_tile<18>(A, D, rows, g, W, DFF2, c, ag, sA);
    naive_tile<18>(A, D, rows, g, W, DFF2, c + DFF, au, sA);
    for (int r = 0; r < 18; ++r) { const float rs = rows[r] >= 0 ? rsqrtf(ssq[rows[r]] * (1.f / D) + EPS) : 0.f; ag[r] *= rs; au[r] *= rs; }
    const float g0 = cw[c], g1 = cw[DFF2 + c], g2 = cw[2 * DFF2 + c], gb = cb[c];
    const float u0 = cw[c + DFF], u1 = cw[DFF2 + c + DFF], u2 = cw[2 * DFF2 + c + DFF], ub = cb[c + DFF];
    for (int r = 0; r < 16; ++r) {
        const float gt = g0 * ag[r] + g1 * ag[r + 1] + g2 * ag[r + 2] + gb;
        const float ut = u0 * au[r] + u1 * au[r + 1] + u2 * au[r + 2] + ub;
        const float s = gt / (1.f + __expf(-gt));
        act[(size_t)(row0 + r) * DFF + c] = f2bf(s * ut);
    }
}
__global__ void __launch_bounds__(256) n_qkv(const bf16_t* __restrict__ A, const float* __restrict__ g, const float* __restrict__ W,
                                              const float* __restrict__ ssq, const float* __restrict__ gq, const float* __restrict__ gk, bf16_t* qkv) {
    extern __shared__ float sA[];
    __shared__ int rows[16];
    const int row0 = blockIdx.y * 16, col = blockIdx.x * 256 + threadIdx.x;
    if (threadIdx.x < 16) rows[threadIdx.x] = row0 + threadIdx.x;
    __syncthreads();
    float acc[16];
    naive_tile<16>(A, D, rows, g, W, NQKV, col, acc, sA);
    const int part = col / D;
    for (int r = 0; r < 16; ++r) {
        const float rs = rsqrtf(ssq[row0 + r] * (1.f / D) + EPS); float y = acc[r] * rs;
        if (part < 2) { const float ms = wave_sum(y * y) * (1.f / HD); y = y * rsqrtf(ms + EPS) * (part == 0 ? gq[col & 63] * (0.125f * LOG2E) : gk[col & 63]); }
        qkv[(size_t)(row0 + r) * NQKV + col] = f2bf(y);
    }
}
__global__ void __launch_bounds__(512) n_mixer(const bf16_t* __restrict__ proj, const float* __restrict__ cw, const float* __restrict__ pw,
                                                const float* __restrict__ ps, bf16_t* mix) {
    __shared__ float pooled[16][512];
    const int t0 = blockIdx.x * 16, c = threadIdx.x;
    for (int r = 0; r < 16; ++r) {
        const int t = t0 + r, tl = t % SEQ;
        float conv = 0.f;
        for (int i = 0; i < 3; ++i) { const int tt = tl - 2 + i; if (tt >= 0) { const size_t o = (size_t)(t - 2 + i) * EVEN_IN; conv += cw[i * AW + c] * (bf2f(proj[o + 2 * AW + c]) * bf2f(proj[o + c])); } }
        const float ya = bf2f(proj[(size_t)t * EVEN_IN + AW + c]) * conv;
        mix[(size_t)t * D + c] = f2bf(ya);
        const int gI = c >> 7, k = 2 << gI; const int cnt = (tl + 1) < k ? (tl + 1) : k; float s = 0.f;
        for (int j = 0; j < cnt; ++j) s += bf2f(proj[(size_t)(t - j) * EVEN_IN + 3 * AW + c]);
        pooled[r][c] = s / (float)cnt - bf2f(proj[(size_t)t * EVEN_IN + 3 * AW + c]);
    }
    __syncthreads();
    const int gI = c >> 7, d = c & 127;
    float acc[16];
    for (int r = 0; r < 16; ++r) acc[r] = 0.f;
    for (int cc = 0; cc < 128; ++cc) { const float w = pw[(size_t)(gI * 128 + cc) * 128 + d];
        for (int r = 0; r < 16; ++r) acc[r] += pooled[r][gI * 128 + cc] * w; }
    for (int r = 0; r < 16; ++r) mix[(size_t)(t0 + r) * D + AW + c] = f2bf(acc[r] * ps[c]);
}
__global__ void __launch_bounds__(256) n_attn(const bf16_t* __restrict__ qkv, const float* __restrict__ bias, bf16_t* ao) {
    __shared__ float sp[4][3 * 129 + 5];
    __shared__ float sq[4][64];
    const int w = threadIdx.x >> 6, lane = threadIdx.x & 63;
    const int item = blockIdx.x * 4 + w; const int t = item / NH, h = item % NH; const int tl = t % SEQ;
    sq[w][lane] = bf2f(qkv[(size_t)t * NQKV + h * HD + lane]);
    __syncthreads();
    float mx = -1e30f;
    for (int i = lane; i < 3 * 129; i += 64) {
        const int br = i / 129, j = i % 129, dil = br == 0 ? 1 : (br == 1 ? 4 : 16); const int tk = tl - j * dil;
        float s = -1e30f;
        if (tk >= 0) { const bf16_t* kr = qkv + (size_t)(t - j * dil) * NQKV + D + h * HD; float a = 0.f;
            for (int e = 0; e < 64; ++e) a += sq[w][e] * bf2f(kr[e]);
            s = a + bias[(br * 129 + j) * 16 + h]; }
        sp[w][i] = s; mx = fmaxf(mx, s);
    }
#pragma unroll
    for (int o = 1; o < 64; o <<= 1) mx = fmaxf(mx, __shfl_xor(mx, o));
    __syncthreads();
    float l = 0.f, o = 0.f;
    for (int i = 0; i < 3 * 129; ++i) {
        const float s = sp[w][i]; if (s < -1e29f) continue;
        const int br = i / 129, j = i % 129, dil = br == 0 ? 1 : (br == 1 ? 4 : 16);
        const float p = exp2f(s - mx); l += p;
        o += p * bf2f(qkv[(size_t)(t - j * dil) * NQKV + 2 * D + h * HD + lane]);
    }
    ao[(size_t)t * D + h * HD + lane] = f2bf(o / l);
}


namespace pg8 {
#define PG8_LAS __attribute__((address_space(3)))
typedef unsigned short bf16_t;
typedef short bf16x8 __attribute__((ext_vector_type(8)));
typedef float f32x4 __attribute__((ext_vector_type(4)));
typedef unsigned u32x4 __attribute__((ext_vector_type(4)));
constexpr int BM = 256, BK = 64, HALF = 128, HTB = HALF * BK * 2  , STAGE_BYTES = 8 * HTB, NXCD = 8, WGM = 4;

__host__ __device__ __forceinline__ int lds_byte(int r, int c) { const int st = (r >> 4) * 2 + (c >> 5), rr = r & 15, cc = c & 31, ob = rr * 64 + cc * 2; return st * 1024 + (ob ^ (((ob >> 9) & 1) << 5)); }
__host__ __device__ __forceinline__ void stage_rc(int b, int& R, int& C) { const int st = b / 1024, sb = b % 1024, swz = sb ^ (((sb >> 9) & 1) << 5); R = (st >> 1) * 16 + swz / 64; C = (st & 1) * 32 + (swz % 64) / 2; }
__host__ __device__ __forceinline__ int perm32(int rho) { const int n = rho >> 4, i = rho & 15; return 8 * (i >> 2) + 4 * n + (i & 3); }

struct Unit { int pm, pn; };
struct Gemm { const bf16_t* A; const bf16_t* Bt; int M, N, K; };

struct StaticOrder {
    int nM, nN, nwg, G, c, wgm;
    __host__ __device__ void init(int M, int N, int G_, int c_, int wgm_ = WGM) { nM = M / BM; nN = N / BM; nwg = nM * nN; G = G_; c = c_; wgm = wgm_; }
    __host__ __device__ bool next(int i, Unit& u) const {
        const long L = (long)i * G + c; if (L >= nwg) return false;
        int wgid = (int)L; { const int q = nwg / NXCD, r = nwg % NXCD, xcd = wgid % NXCD, off = wgid / NXCD; wgid = (xcd < r ? xcd * (q + 1) : r * (q + 1) + (xcd - r) * q) + off; }
        const int nig = wgm * nN, gid = wgid / nig, fm = gid * wgm, gsz = (nM - fm) < wgm ? (nM - fm) : wgm;
        u.pm = fm + ((wgid % nig) % gsz); u.pn = (wgid % nig) / gsz; return true;
    }
    __device__ __forceinline__ long a_row(const Unit& u) const { return (long)u.pm * BM; }
    __device__ __forceinline__ void a_ready(const Unit&) const {}
    __device__ __forceinline__ void done(const Unit&) const {}
};

typedef float f32x2c_t __attribute__((ext_vector_type(2))); typedef __bf16 bf16x2c_t __attribute__((ext_vector_type(2)));
__device__ __forceinline__ unsigned cvt_pk_bf16(float lo, float hi) { f32x2c_t v = {lo, hi}; bf16x2c_t b = __builtin_convertvector(v, bf16x2c_t); return __builtin_bit_cast(unsigned, b); }
typedef unsigned u32x2 __attribute__((ext_vector_type(2)));
__device__ __forceinline__ float row_rs(const float* ssq, int row) { return rsqrtf(ssq[row] * (1.0f / 1024.0f) + 1e-6f); }

struct EpiRowScale {
    static constexpr bool PERM = true, AFTER_DRAIN = false, PREFETCH = false;
    bf16_t* O; int ldc; const float* ssq;
    __device__ __forceinline__ void operator()(const f32x4 (&acc)[2][2][4][2], const Unit& u, int wr, int wc, int fr, int fq) const {
        const int row0 = u.pm * BM + wr * 64 + fr, col0 = u.pn * BM + wc * 32 + 8 * fq;
        float rsv[2][4];
#pragma unroll
        for (int ai = 0; ai < 2; ++ai)
#pragma unroll
            for (int m = 0; m < 4; ++m) rsv[ai][m] = ssq[row0 + ai * HALF + m * 16];
#pragma unroll
        for (int ai = 0; ai < 2; ++ai)
#pragma unroll
            for (int m = 0; m < 4; ++m) { const int row = row0 + ai * HALF + m * 16; const float rs = rsqrtf(rsv[ai][m] * (1.0f / 1024.0f) + 1e-6f); bf16_t* rowp = O + (size_t)row * ldc + col0;
#pragma unroll
                for (int bj = 0; bj < 2; ++bj) { const f32x4 v0 = acc[ai][bj][m][0] * rs, v1 = acc[ai][bj][m][1] * rs;
                    u32x4 w; w.x = cvt_pk_bf16(v0[0], v0[1]); w.y = cvt_pk_bf16(v0[2], v0[3]); w.z = cvt_pk_bf16(v1[0], v1[1]); w.w = cvt_pk_bf16(v1[2], v1[3]);
                    *(u32x4*)(rowp + bj * HALF) = w; } }
    }
};

struct EpiProj {
    static constexpr bool PERM = true, AFTER_DRAIN = false, PREFETCH = false;
    bf16_t* O; const float* ssq;
    __device__ __forceinline__ void operator()(const f32x4 (&acc)[2][2][4][2], const Unit& u, int wr, int wc, int fr, int fq) const {
        const int row0 = u.pm * BM + wr * 64 + fr, colt = wc * 32 + 8 * fq;
        float rsv[2][4];
#pragma unroll
        for (int ai = 0; ai < 2; ++ai)
#pragma unroll
            for (int m = 0; m < 4; ++m) rsv[ai][m] = ssq[row0 + ai * HALF + m * 16];
        const bool prod = u.pn < 4;
#pragma unroll
        for (int ai = 0; ai < 2; ++ai)
#pragma unroll
            for (int m = 0; m < 4; ++m) { const int row = row0 + ai * HALF + m * 16; const float rs = rsqrtf(rsv[ai][m] * (1.0f / 1024.0f) + 1e-6f); bf16_t* rowp = O + (size_t)row * PW;
                if (prod) { const float r2 = rs * rs; const f32x4 v0 = acc[ai][0][m][0] * acc[ai][1][m][0] * r2, v1 = acc[ai][0][m][1] * acc[ai][1][m][1] * r2;
                    u32x4 w; w.x = cvt_pk_bf16(v0[0], v0[1]); w.y = cvt_pk_bf16(v0[2], v0[3]); w.z = cvt_pk_bf16(v1[0], v1[1]); w.w = cvt_pk_bf16(v1[2], v1[3]);
                    *(u32x4*)(rowp + 128 * u.pn + colt) = w; }
                else {
#pragma unroll
                    for (int bj = 0; bj < 2; ++bj) { const f32x4 v0 = acc[ai][bj][m][0] * rs, v1 = acc[ai][bj][m][1] * rs;
                        u32x4 w; w.x = cvt_pk_bf16(v0[0], v0[1]); w.y = cvt_pk_bf16(v0[2], v0[3]); w.z = cvt_pk_bf16(v1[0], v1[1]); w.w = cvt_pk_bf16(v1[2], v1[3]);
                        *(u32x4*)(rowp + 512 + 256 * (u.pn - 4) + bj * HALF + colt) = w; } } }
    }
};

constexpr int BASE_SPARE_OFF = 131072 + 1024;
__host__ __device__ constexpr int BASE_BOFF(int h) { return h == 0 ? 4 * HTB : h == 1 ? 5 * HTB : h == 2 ? 0 : h == 3 ? HTB : h == 4 ? 6 * HTB : h == 5 ? 7 * HTB : h == 6 ? 2 * HTB : BASE_SPARE_OFF; }
template <bool BASE_F32, bool OUT_F32, bool OUT_XB, bool SSQ, bool BASE_LDS = false>
struct EpiResidual {
    static constexpr bool PERM = true, AFTER_DRAIN = BASE_LDS, PREFETCH = false;
    const float* basef; const bf16_t* baseb; float* outf; bf16_t* xbo; float* ssq_next;
    template <int H> __device__ __forceinline__ void stage_base(PG8_LAS unsigned char* lds, int bufoff, const Unit& u, int tid, unsigned ldsw) const {
        const char* gb = (const char*)(baseb + ((size_t)(u.pm * BM + (H >> 2) * HALF) * 1024 + u.pn * BM + (H & 3) * 64));
        asm volatile("" : "+v"(tid));
#pragma unroll
        for (int i = 0; i < 2; ++i) { int R, C; stage_rc(tid * 16 + i * 8192, R, C);
            __builtin_amdgcn_global_load_lds((const unsigned*)(gb + (unsigned)(R * 1024 + C) * 2u), (PG8_LAS unsigned*)(lds + bufoff + ldsw + i * 8192), 16, 0, 0); }
    }
    __device__ __forceinline__ void fused(const f32x4 (&acc)[2][2][4][2], const Unit& u, int wr, int wc, int fr, int fq, PG8_LAS unsigned char* lds, int wid, int lane) const {
        const int row0 = u.pm * BM + wr * 64 + fr, col0 = u.pn * BM + wc * 32 + 8 * fq;
        const PG8_LAS unsigned char* lb = lds + (((fr * 64 + 16 * fq) ^ (((fr >> 3) & 1) << 5)) + (8 * wr + (wc & 1)) * 1024);
        const bool hi = (wc >> 1) != 0; float ss[2][4];
#pragma unroll
        for (int ai = 0; ai < 2; ++ai)
#pragma unroll
            for (int m = 0; m < 4; ++m) { const int row = row0 + ai * HALF + m * 16; const size_t off = (size_t)row * 1024 + col0; float s = 0.f;
#pragma unroll
                for (int bj = 0; bj < 2; ++bj) { const size_t o = off + bj * HALF;
                    const int bo = hi ? BASE_BOFF(ai * 4 + 2 * bj + 1) : BASE_BOFF(ai * 4 + 2 * bj);
                    const u32x4 w = *(const PG8_LAS u32x4*)(lb + bo + m * 2048);
                    f32x4 v0 = (f32x4){__uint_as_float(w.x << 16), __uint_as_float(w.x & 0xffff0000u), __uint_as_float(w.y << 16), __uint_as_float(w.y & 0xffff0000u)};
                    f32x4 v1 = (f32x4){__uint_as_float(w.z << 16), __uint_as_float(w.z & 0xffff0000u), __uint_as_float(w.w << 16), __uint_as_float(w.w & 0xffff0000u)};
                    v0 = v0 + acc[ai][bj][m][0]; v1 = v1 + acc[ai][bj][m][1];
                    if (OUT_F32) { __builtin_nontemporal_store(v0, (f32x4*)(outf + o)); __builtin_nontemporal_store(v1, (f32x4*)(outf + o + 4)); }
                    if (OUT_XB) { u32x4 wo; wo.x = cvt_pk_bf16(v0[0], v0[1]); wo.y = cvt_pk_bf16(v0[2], v0[3]); wo.z = cvt_pk_bf16(v1[0], v1[1]); wo.w = cvt_pk_bf16(v1[2], v1[3]); *(u32x4*)(xbo + o) = wo; }
                    s += (v0[0] * v0[0] + v0[1] * v0[1]) + (v0[2] * v0[2] + v0[3] * v0[3]) + (v1[0] * v1[0] + v1[1] * v1[1]) + (v1[2] * v1[2] + v1[3] * v1[3]); }
                if (SSQ) { s += __shfl_xor(s, 16); s += __shfl_xor(s, 32); }
                ss[ai][m] = s; }
        if (SSQ) { if (fq == 0) {
#pragma unroll
            for (int ai = 0; ai < 2; ++ai)
#pragma unroll
                for (int m = 0; m < 4; ++m) atomicAdd(ssq_next + row0 + ai * HALF + m * 16, ss[ai][m]); } }
    }
    __device__ __forceinline__ void operator()(const f32x4 (&acc)[2][2][4][2], const Unit& u, int wr, int wc, int fr, int fq) const {
        const int row0 = u.pm * BM + wr * 64 + fr, col0 = u.pn * BM + wc * 32 + 8 * fq;
        if constexpr (!BASE_F32) {
            u32x4 bw[2][4][2]; float ss[2][4];
#pragma unroll
            for (int ai = 0; ai < 2; ++ai)
#pragma unroll
                for (int m = 0; m < 4; ++m)
#pragma unroll
                    for (int bj = 0; bj < 2; ++bj) bw[ai][m][bj] = *(const u32x4*)(baseb + (size_t)(row0 + ai * HALF + m * 16) * 1024 + col0 + bj * HALF);
#pragma unroll
            for (int ai = 0; ai < 2; ++ai)
#pragma unroll
                for (int m = 0; m < 4; ++m) { const int row = row0 + ai * HALF + m * 16; const size_t off = (size_t)row * 1024 + col0; float s = 0.f;
#pragma unroll
                    for (int bj = 0; bj < 2; ++bj) { const size_t o = off + bj * HALF; const u32x4 w = bw[ai][m][bj];
                        f32x4 v0 = (f32x4){__uint_as_float(w.x << 16), __uint_as_float(w.x & 0xffff0000u), __uint_as_float(w.y << 16), __uint_as_float(w.y & 0xffff0000u)};
                        f32x4 v1 = (f32x4){__uint_as_float(w.z << 16), __uint_as_float(w.z & 0xffff0000u), __uint_as_float(w.w << 16), __uint_as_float(w.w & 0xffff0000u)};
                        v0 = v0 + acc[ai][bj][m][0]; v1 = v1 + acc[ai][bj][m][1];
                        if (OUT_F32) { __builtin_nontemporal_store(v0, (f32x4*)(outf + o)); __builtin_nontemporal_store(v1, (f32x4*)(outf + o + 4)); }
                        if (OUT_XB) { u32x4 wo; wo.x = cvt_pk_bf16(v0[0], v0[1]); wo.y = cvt_pk_bf16(v0[2], v0[3]); wo.z = cvt_pk_bf16(v1[0], v1[1]); wo.w = cvt_pk_bf16(v1[2], v1[3]); *(u32x4*)(xbo + o) = wo; }
                        s += (v0[0] * v0[0] + v0[1] * v0[1]) + (v0[2] * v0[2] + v0[3] * v0[3]) + (v1[0] * v1[0] + v1[1] * v1[1]) + (v1[2] * v1[2] + v1[3] * v1[3]); }
                    if (SSQ) { s += __shfl_xor(s, 16); s += __shfl_xor(s, 32); }
                    ss[ai][m] = s; }
            if (SSQ) { if (fq == 0) {
#pragma unroll
                for (int ai = 0; ai < 2; ++ai)
#pragma unroll
                    for (int m = 0; m < 4; ++m) atomicAdd(ssq_next + row0 + ai * HALF + m * 16, ss[ai][m]); } }
        } else {
#pragma unroll
        for (int ai = 0; ai < 2; ++ai)
#pragma unroll
            for (int m = 0; m < 4; ++m) { const int row = row0 + ai * HALF + m * 16; const size_t off = (size_t)row * 1024 + col0; float s = 0.f;
#pragma unroll
                for (int bj = 0; bj < 2; ++bj) { const size_t o = off + bj * HALF; f32x4 v0, v1;
                    v0 = *(const f32x4*)(basef + o); v1 = *(const f32x4*)(basef + o + 4);
                    v0 = v0 + acc[ai][bj][m][0]; v1 = v1 + acc[ai][bj][m][1];
                    if (OUT_F32) { *(f32x4*)(outf + o) = v0; *(f32x4*)(outf + o + 4) = v1; }
                    if (OUT_XB) { u32x4 w; w.x = cvt_pk_bf16(v0[0], v0[1]); w.y = cvt_pk_bf16(v0[2], v0[3]); w.z = cvt_pk_bf16(v1[0], v1[1]); w.w = cvt_pk_bf16(v1[2], v1[3]); *(u32x4*)(xbo + o) = w; }
                    s += (v0[0] * v0[0] + v0[1] * v0[1]) + (v0[2] * v0[2] + v0[3] * v0[3]) + (v1[0] * v1[0] + v1[1] * v1[1]) + (v1[2] * v1[2] + v1[3] * v1[3]); }
                if (SSQ) { s += __shfl_xor(s, 16); s += __shfl_xor(s, 32); if (fq == 0) atomicAdd(ssq_next + row, s); }
                if (m & 1) asm volatile("" ::: "memory"); }
        }
    }
};

struct EpiQkv {
    static constexpr bool PERM = true, AFTER_DRAIN = false, PREFETCH = false;
    bf16_t* O; const float* ssq; const float* gq; const float* gk;
    __device__ __forceinline__ void operator()(const f32x4 (&acc)[2][2][4][2], const Unit& u, int wr, int wc, int fr, int fq) const {
        const int row0 = u.pm * BM + wr * 64 + fr; const int part = (u.pn * BM) >> 10;
        float rsv[2][4];
#pragma unroll
        for (int ai = 0; ai < 2; ++ai)
#pragma unroll
            for (int m = 0; m < 4; ++m) rsv[ai][m] = ssq[row0 + ai * HALF + m * 16];
        const float* gp = (part == 1 ? gk : gq) + 8 * fq; const float sc0 = part == 0 ? 0.125f * 1.4426950408889634f : 1.0f; const bool nrm = part < 2;
        f32x4 gv[2][2];
#pragma unroll
        for (int bj = 0; bj < 2; ++bj)
#pragma unroll
            for (int n = 0; n < 2; ++n) gv[bj][n] = *(const f32x4*)(gp + 32 * bj + 4 * n);
#pragma unroll
        for (int bj = 0; bj < 2; ++bj)
#pragma unroll
            for (int n = 0; n < 2; ++n)
#pragma unroll
                for (int j = 0; j < 4; ++j) gv[bj][n][j] = nrm ? gv[bj][n][j] * sc0 : 1.0f;
#pragma unroll
        for (int ai = 0; ai < 2; ++ai)
#pragma unroll
            for (int m = 0; m < 4; ++m) { const int row = row0 + ai * HALF + m * 16; const float rs = rsqrtf(rsv[ai][m] * (1.0f / 1024.0f) + 1e-6f);
                f32x4 y[2][2]; float ss = 0.f;
#pragma unroll
                for (int bj = 0; bj < 2; ++bj)
#pragma unroll
                    for (int n = 0; n < 2; ++n) { y[bj][n] = acc[ai][bj][m][n] * rs; const f32x4 t = y[bj][n]; ss += (t[0] * t[0] + t[1] * t[1]) + (t[2] * t[2] + t[3] * t[3]); }
                ss += __shfl_xor(ss, 16); ss += __shfl_xor(ss, 32); const float sc1 = rsqrtf(ss * (1.0f / 64.0f) + 1e-6f), sc = nrm ? sc1 : 1.0f;
#pragma unroll
                for (int bj = 0; bj < 2; ++bj)
#pragma unroll
                    for (int n = 0; n < 2; ++n) y[bj][n] = y[bj][n] * sc * gv[bj][n];
                const int hh = ((u.pn & 3) << 2) + wc;
                bf16_t* rowp = O + (size_t)part * (16384u * 1024u) + ((size_t)((row >> 12) * 16 + hh) * 4096 + (row & 4095)) * 64 + 8 * fq;
#pragma unroll
                for (int bj = 0; bj < 2; ++bj) { u32x4 w; w.x = cvt_pk_bf16(y[bj][0][0], y[bj][0][1]); w.y = cvt_pk_bf16(y[bj][0][2], y[bj][0][3]); w.z = cvt_pk_bf16(y[bj][1][0], y[bj][1][1]); w.w = cvt_pk_bf16(y[bj][1][2], y[bj][1][3]);
                    *(u32x4*)(rowp + 32 * bj) = w; } }
    }
};

template <int CTRL> __device__ __forceinline__ float dppf(float o, float s) { return __int_as_float(__builtin_amdgcn_update_dpp(__float_as_int(o), __float_as_int(s), CTRL, 0xf, 0xf, false)); }
template <int CTRL> __device__ __forceinline__ f32x4 dpp4(f32x4 o, f32x4 s) { f32x4 r; r[0] = dppf<CTRL>(o[0], s[0]); r[1] = dppf<CTRL>(o[1], s[1]); r[2] = dppf<CTRL>(o[2], s[2]); r[3] = dppf<CTRL>(o[3], s[3]); return r; }
__device__ __forceinline__ f32x4 dpp4_shr1(f32x4 o, f32x4 s) { return dpp4<0x111>(o, s); }
__device__ __forceinline__ f32x4 dpp4_shr2(f32x4 o, f32x4 s) { return dpp4<0x112>(o, s); }
__device__ __forceinline__ f32x4 dpp4_shl15(f32x4 o, f32x4 s) { return dpp4<0x10f>(o, s); }
__device__ __forceinline__ f32x4 dpp4_shl14(f32x4 o, f32x4 s) { return dpp4<0x10e>(o, s); }
#define PIN4(x) asm volatile("" : "+v"(x))
#define DPPM " row_mask:0xf bank_mask:0xf bound_ctrl:1\n\t"
__device__ __forceinline__ void conv_taps_cur(f32x4& nv, const f32x4 cur, const f32x4 w1, const f32x4 w0) {
    float n0 = nv[0], n1 = nv[1], n2 = nv[2], n3 = nv[3];
    asm volatile("s_nop 1\n\t"
        "v_fmac_f32_dpp %0, %4, %8 row_shr:1" DPPM "v_fmac_f32_dpp %1, %5, %9 row_shr:1" DPPM "v_fmac_f32_dpp %2, %6, %10 row_shr:1" DPPM "v_fmac_f32_dpp %3, %7, %11 row_shr:1" DPPM
        "v_fmac_f32_dpp %0, %4, %12 row_shr:2" DPPM "v_fmac_f32_dpp %1, %5, %13 row_shr:2" DPPM "v_fmac_f32_dpp %2, %6, %14 row_shr:2" DPPM "v_fmac_f32_dpp %3, %7, %15 row_shr:2" DPPM
        : "+v"(n0), "+v"(n1), "+v"(n2), "+v"(n3)
        : "v"(cur[0]), "v"(cur[1]), "v"(cur[2]), "v"(cur[3]), "v"(w1[0]), "v"(w1[1]), "v"(w1[2]), "v"(w1[3]), "v"(w0[0]), "v"(w0[1]), "v"(w0[2]), "v"(w0[3]));
    nv = (f32x4){n0, n1, n2, n3};
}
__device__ __forceinline__ void conv_taps_prev(f32x4& nv, const f32x4 pv, const f32x4 w1, const f32x4 w0) {
    float n0 = nv[0], n1 = nv[1], n2 = nv[2], n3 = nv[3];
    asm volatile("s_nop 1\n\t"
        "v_fmac_f32_dpp %0, %4, %8 row_shl:15" DPPM "v_fmac_f32_dpp %1, %5, %9 row_shl:15" DPPM "v_fmac_f32_dpp %2, %6, %10 row_shl:15" DPPM "v_fmac_f32_dpp %3, %7, %11 row_shl:15" DPPM
        "v_fmac_f32_dpp %0, %4, %12 row_shl:14" DPPM "v_fmac_f32_dpp %1, %5, %13 row_shl:14" DPPM "v_fmac_f32_dpp %2, %6, %14 row_shl:14" DPPM "v_fmac_f32_dpp %3, %7, %15 row_shl:14" DPPM
        : "+v"(n0), "+v"(n1), "+v"(n2), "+v"(n3)
        : "v"(pv[0]), "v"(pv[1]), "v"(pv[2]), "v"(pv[3]), "v"(w1[0]), "v"(w1[1]), "v"(w1[2]), "v"(w1[3]), "v"(w0[0]), "v"(w0[1]), "v"(w0[2]), "v"(w0[3]));
    nv = (f32x4){n0, n1, n2, n3};
}
struct EpiConvGlu {
    static constexpr bool PERM = true, AFTER_DRAIN = false, PREFETCH = true;
    bf16_t* act; const float* ssq; const float* cw; const float* cb; PG8_LAS float* halo;
    __device__ __forceinline__ void prefetch(const Unit& u, int wid, int lane, int par) const {
        PG8_LAS unsigned char* pf = (PG8_LAS unsigned char*)halo + 12288 + par * 5120;
        if (wid < 4) { const int b = u.pm / 17, it = u.pm - b * 17; int tl = 254 * it - 2 + wid * 64 + lane; tl = tl < 0 ? 0 : (tl > 4095 ? 4095 : tl);
            __builtin_amdgcn_global_load_lds((const unsigned*)(ssq + b * 4096 + tl), (PG8_LAS unsigned*)(pf + 4096 + wid * 256), 4, 0, 0); }
        else { const int seg = (wid - 4) * 2 + (lane >> 5), j = seg >> 1, bj = seg & 1; const float* src = (j < 3 ? cw + j * 5632 : cb) + u.pn * HALF + bj * 2816 + (lane & 31) * 4;
            __builtin_amdgcn_global_load_lds((const unsigned*)src, (PG8_LAS unsigned*)(pf + (wid - 4) * 1024), 16, 0, 0); }
    }
    __device__ __forceinline__ void operator()(f32x4 (&acc)[2][2][4][2], const Unit& u, int wr, int wc, int fr, int fq, int par) const {
        const int b = u.pm / 17, it = u.pm - b * 17; const int tl0 = 254 * it - 2 + wr * 64 + fr;
        const int colg = u.pn * HALF + wc * 32 + 8 * fq;
        float rsv[2][4];
        const PG8_LAS float* pfs = (const PG8_LAS float*)((const PG8_LAS unsigned char*)halo + 12288 + par * 5120 + 4096) + wr * 64 + fr;
        const PG8_LAS unsigned char* pfw = (const PG8_LAS unsigned char*)halo + 12288 + par * 5120 + (wc * 32 + 8 * fq) * 4;
#pragma unroll
        for (int ai = 0; ai < 2; ++ai)
#pragma unroll
            for (int m = 0; m < 4; ++m) rsv[ai][m] = pfs[ai * HALF + m * 16];
#pragma unroll
        for (int ai = 0; ai < 2; ++ai)
#pragma unroll
            for (int m = 0; m < 4; ++m) { const int tl = tl0 + ai * HALF + m * 16; const bool ok = (tl >= 0) && (tl < 4096); const float r0 = rsqrtf(rsv[ai][m] * (1.0f / 1024.0f) + 1e-6f); const float rs = ok ? r0 : 0.f;
#pragma unroll
                for (int bj = 0; bj < 2; ++bj)
#pragma unroll
                    for (int n = 0; n < 2; ++n) { acc[ai][bj][m][n] = acc[ai][bj][m][n] * rs; PIN4(acc[ai][bj][m][n]); } }
        PG8_LAS f32x4* H = (PG8_LAS f32x4*)halo;
        { PG8_LAS f32x4* Hw = H + ((wr ^ 1) * 16 + wc * 4 + fq) + wr * 256 + (fr & 1) * 128;
          if (fr >= 14) {
#pragma unroll
            for (int ai = 0; ai < 2; ++ai)
#pragma unroll
                for (int bj = 0; bj < 2; ++bj)
#pragma unroll
                    for (int n = 0; n < 2; ++n) Hw[ai * 256 + bj * 64 + n * 32] = acc[ai][bj][3][n]; } }
        asm volatile("s_waitcnt lgkmcnt(0)" ::: "memory"); __builtin_amdgcn_s_barrier(); asm volatile("" ::: "memory"); __builtin_amdgcn_sched_barrier(0);
        const PG8_LAS f32x4* Hr = H + (wr * 16 + wc * 4 + fq);
#pragma unroll
        for (int bj = 0; bj < 2; ++bj)
#pragma unroll
            for (int n = 0; n < 2; ++n) { const int c = colg + bj * 2816 + 4 * n;
                f32x4 w0 = *(const PG8_LAS f32x4*)(pfw + (0 + bj) * 512 + n * 16), w1 = *(const PG8_LAS f32x4*)(pfw + (2 + bj) * 512 + n * 16), w2 = *(const PG8_LAS f32x4*)(pfw + (4 + bj) * 512 + n * 16), bb = *(const PG8_LAS f32x4*)(pfw + (6 + bj) * 512 + n * 16);
                { const float sc = (bj == 0) ? -1.4426950408889634f : -0.6931471805599453f; w0 = w0 * sc; w1 = w1 * sc; w2 = w2 * sc; bb = bb * sc; }
                PIN4(w0); PIN4(w1); PIN4(w2); PIN4(bb);
#pragma unroll
                for (int ai = 0; ai < 2; ++ai) { const int s = 2 * ai + wr;
                    f32x4 h1 = (f32x4){0.f, 0.f, 0.f, 0.f}, h2 = h1;
                    if (s > 0) { h2 = Hr[ai * 256 + bj * 64 + n * 32]; h1 = Hr[ai * 256 + 128 + bj * 64 + n * 32]; }
                    PIN4(h1); PIN4(h2);
#pragma unroll
                    for (int m = 3; m >= 0; --m) { f32x4 cur = acc[ai][bj][m][n]; PIN4(cur); f32x4 o1, o2;
#ifdef X_SHFL
                        const int ln = (int)(threadIdx.x & 63); f32x4 p1, p2;
                        if (m > 0) { const f32x4 pv = acc[ai][bj][m - 1][n];
                            for (int j = 0; j < 4; ++j) { const float a1 = __shfl(cur[j], ln - 1, 64), b1 = __shfl(pv[j], ln + 15, 64), a2 = __shfl(cur[j], ln - 2, 64), b2 = __shfl(pv[j], ln + 14, 64);
                                p1[j] = fr >= 1 ? a1 : b1; p2[j] = fr >= 2 ? a2 : b2; } }
                        else { for (int j = 0; j < 4; ++j) { const float a1 = __shfl(cur[j], ln - 1, 64), a2 = __shfl(cur[j], ln - 2, 64);
                                p1[j] = fr >= 1 ? a1 : h1[j]; p2[j] = fr >= 2 ? a2 : (fr == 0 ? h2[j] : h1[j]); } }
                        f32x4 nv = w2 * cur + w1 * p1 + w0 * p2 + bb; PIN4(nv);
#elif !defined(X_DPPMOV)
                        f32x4 nv = w2 * cur + bb;
                        if (m > 0) { const f32x4 pv = acc[ai][bj][m - 1][n]; conv_taps_prev(nv, pv, w1, w0); }
                        else { const f32x4 hz = (f32x4){0.f, 0.f, 0.f, 0.f}; const f32x4 t1 = (fr == 0) ? h1 : hz, t2 = (fr == 0) ? h2 : ((fr == 1) ? h1 : hz); nv = nv + w1 * t1 + w0 * t2; }
                        conv_taps_cur(nv, cur, w1, w0);
#else
                        if (m > 0) { const f32x4 pv = acc[ai][bj][m - 1][n]; o1 = dpp4_shl15(pv, pv); o2 = dpp4_shl14(pv, pv); }
                        else { o1 = h1; o2 = (fr == 0) ? h2 : h1; }
                        const f32x4 p1 = dpp4_shr1(o1, cur), p2 = dpp4_shr2(o2, cur);
                        f32x4 nv = w2 * cur + w1 * p1 + w0 * p2 + bb; PIN4(nv);
#endif
                        acc[ai][bj][m][n] = nv; } } }
        __builtin_amdgcn_sched_barrier(0);
#pragma unroll
        for (int ai = 0; ai < 2; ++ai)
#pragma unroll
            for (int m = 0; m < 4; ++m) { const int rl = ai * HALF + wr * 64 + m * 16 + fr; const int tl = 254 * it - 2 + rl;
                f32x4 r[2];
#pragma unroll
                for (int n = 0; n < 2; ++n) { const f32x4 g = acc[ai][0][m][n], up = acc[ai][1][m][n];
#pragma unroll
                    for (int j = 0; j < 4; ++j) { const float e = __builtin_amdgcn_exp2f(g[j]); r[n][j] = g[j] * __builtin_amdgcn_rcpf(1.0f + e) * up[j]; } }
                if (rl >= 2 && tl < 4096) { u32x4 w; w.x = cvt_pk_bf16(r[0][0], r[0][1]); w.y = cvt_pk_bf16(r[0][2], r[0][3]); w.z = cvt_pk_bf16(r[1][0], r[1][1]); w.w = cvt_pk_bf16(r[1][2], r[1][3]);
                    *(u32x4*)(act + (size_t)(b * 4096 + tl) * 2816 + colg) = w; }
                asm volatile("" ::: "memory"); }
    }
};
struct EpiProj2 {
    static constexpr bool PERM = true, AFTER_DRAIN = false, PREFETCH = false;
    bf16_t* mixo; bf16_t* zo; const float* ssq; const float* cw; float* side; PG8_LAS float* halo;
    __device__ __forceinline__ void operator()(f32x4 (&acc)[2][2][4][2], const Unit& u, int wr, int wc, int fr, int fq) const {
        const int row0 = u.pm * BM + wr * 64 + fr, ch0 = 64 * u.pn + 16 * wc + 4 * fq;
        float rsv[2][4];
#pragma unroll
        for (int ai = 0; ai < 2; ++ai)
#pragma unroll
            for (int m = 0; m < 4; ++m) rsv[ai][m] = ssq[row0 + ai * HALF + m * 16];
        const f32x4 w0 = *(const f32x4*)(cw + ch0), w1 = *(const f32x4*)(cw + AW + ch0), w2 = *(const f32x4*)(cw + 2 * AW + ch0);
#pragma unroll
        for (int ai = 0; ai < 2; ++ai)
#pragma unroll
            for (int m = 0; m < 4; ++m) { const float rs = rsqrtf(rsv[ai][m] * (1.0f / 1024.0f) + 1e-6f);
                acc[ai][0][m][0] = acc[ai][0][m][0] * acc[ai][0][m][1] * (rs * rs); acc[ai][1][m][0] = acc[ai][1][m][0] * rs; acc[ai][1][m][1] = acc[ai][1][m][1] * rs;
                PIN4(acc[ai][0][m][0]); }
        { float* sp = side + (size_t)u.pm * 6 * 512 + ch0;
          if (wr == 0 && fr < 2) { *(f32x4*)(sp + fr * 512) = acc[0][0][0][0]; *(f32x4*)(sp + (4 + fr) * 512) = acc[0][1][0][0]; }
          if (wr == 1 && fr >= 14) *(f32x4*)(sp + (fr - 12) * 512) = acc[1][0][3][0]; }
        PG8_LAS f32x4* H = (PG8_LAS f32x4*)halo;
        { PG8_LAS f32x4* Hw = H + ((wr ^ 1) * 16 + wc * 4 + fq) + wr * 256 + (fr & 1) * 128;
          if (fr >= 14) {
#pragma unroll
            for (int ai = 0; ai < 2; ++ai) Hw[ai * 256] = acc[ai][0][3][0]; } }
        asm volatile("s_waitcnt lgkmcnt(0)" ::: "memory"); __builtin_amdgcn_s_barrier(); asm volatile("" ::: "memory"); __builtin_amdgcn_sched_barrier(0);
        const PG8_LAS f32x4* Hr = H + (wr * 16 + wc * 4 + fq);
        f32x4 w0p = w0, w1p = w1, w2p = w2; PIN4(w0p); PIN4(w1p); PIN4(w2p);
#pragma unroll
        for (int ai = 0; ai < 2; ++ai) { const int sl = 2 * ai + wr;
            f32x4 h1 = (f32x4){0.f, 0.f, 0.f, 0.f}, h2 = h1;
            if (sl > 0) { h2 = Hr[ai * 256]; h1 = Hr[ai * 256 + 128]; }
            PIN4(h1); PIN4(h2);
#pragma unroll
            for (int m = 3; m >= 0; --m) { f32x4 cur = acc[ai][0][m][0]; PIN4(cur);
                f32x4 nv = w2p * cur;
                if (m > 0) { const f32x4 pv = acc[ai][0][m - 1][0]; conv_taps_prev(nv, pv, w1p, w0p); }
                else { const f32x4 hz = (f32x4){0.f, 0.f, 0.f, 0.f}; const f32x4 t1 = (fr == 0) ? h1 : hz, t2 = (fr == 0) ? h2 : ((fr == 1) ? h1 : hz); nv = nv + w1p * t1 + w0p * t2; }
                conv_taps_cur(nv, cur, w1p, w0p);
                acc[ai][0][m][0] = nv; } }
        __builtin_amdgcn_sched_barrier(0);
#pragma unroll
        for (int ai = 0; ai < 2; ++ai)
#pragma unroll
            for (int m = 0; m < 4; ++m) { const int row = row0 + ai * HALF + m * 16; const f32x4 ya = acc[ai][1][m][0] * acc[ai][0][m][0], z = acc[ai][1][m][1];
                u32x2 wy, wz; wy.x = cvt_pk_bf16(ya[0], ya[1]); wy.y = cvt_pk_bf16(ya[2], ya[3]); wz.x = cvt_pk_bf16(z[0], z[1]); wz.y = cvt_pk_bf16(z[2], z[3]);
                const auto s0 = __builtin_amdgcn_permlane16_swap(wy.x, wz.x, false, false); const auto s1 = __builtin_amdgcn_permlane16_swap(wy.y, wz.y, false, false);
                u32x4 o; o.x = s0[0]; o.y = s1[0]; o.z = s0[1]; o.w = s1[1];
                bf16_t* dp = (fq & 1) ? zo + (size_t)row * 512 + ch0 - 4 : mixo + (size_t)row * 1024 + ch0;
                *(u32x4*)dp = o; }
    }
};
struct OverlapOrder : StaticOrder {
    __device__ __forceinline__ long a_row(const Unit& u) const { const int b = u.pm / 17, it = u.pm - b * 17; return (long)b * 4096 + 254 * it - 2; }
};

template <class Epi, class Sched, bool ALIGN_EPI = false, bool SP2 = false>
__device__ __forceinline__ void gemm_phase(PG8_LAS unsigned char* lds, const Gemm g, const Sched& S, const Epi& E) {
    const int tid = threadIdx.x, wid = __builtin_amdgcn_readfirstlane(tid >> 6), lane = tid & 63, wr = wid >> 2, wc = wid & 3, fr = lane & 15, fq = lane >> 4;
    const int K = g.K, nt = K / BK;
    unsigned voffA[2], voffB[2];
#pragma unroll
    for (int i = 0; i < 2; ++i) { int R, C; stage_rc(tid * 16 + i * 8192, R, C); const int Rb = Epi::PERM ? ((R & ~31) + perm32(R & 31)) : R;
        voffA[i] = (unsigned)(R * K + C) * 2u; voffB[i] = (unsigned)(Rb * K + C) * 2u; }
    const size_t kstep = (size_t)(BK * 2);
    const size_t hstep = (size_t)HALF * K * 2;
    const size_t tstep = 2 * hstep;
    const unsigned ldsw = (unsigned)wid * 1024u;
    const int aoff = lds_byte(wr * 64 + fr, fq * 8), boff = lds_byte(wc * 32 + fr, fq * 8);
#define PG8_SA(b, h) (((b) * 2 + (h)) * HTB)
#define PG8_SB(b, h) ((4 + (b) * 2 + (h)) * HTB)
#define PG8_STAGE(bufoff, gbase, voff) do { _Pragma("unroll") for (int _i = 0; _i < 2; ++_i) \
        __builtin_amdgcn_global_load_lds((const unsigned*)((const char*)(gbase) + (voff)[_i]), (PG8_LAS unsigned*)(lds + (bufoff) + ldsw + _i * 8192), 16, 0, 0); } while (0)
#define PG8_LDA(dst, b, h) do { _Pragma("unroll") for (int m = 0; m < 4; ++m) _Pragma("unroll") for (int k = 0; k < 2; ++k) dst[m][k] = *(const PG8_LAS bf16x8*)(lds + PG8_SA(b, h) + aoff + m * 2048 + k * 1024); } while (0)
#define PG8_LDB(dst, b, h) do { _Pragma("unroll") for (int n = 0; n < 2; ++n) _Pragma("unroll") for (int k = 0; k < 2; ++k) dst[n][k] = *(const PG8_LAS bf16x8*)(lds + PG8_SB(b, h) + boff + n * 2048 + k * 1024); } while (0)
#define PG8_MMA(ai, bj, At, Bt) do { __builtin_amdgcn_s_setprio(1); _Pragma("unroll") for (int m = 0; m < 4; ++m) _Pragma("unroll") for (int n = 0; n < 2; ++n) _Pragma("unroll") for (int k = 0; k < 2; ++k) \
        acc[ai][bj][m][n] = __builtin_amdgcn_mfma_f32_16x16x32_bf16(Bt[n][k], At[m][k], acc[ai][bj][m][n], 0, 0, 0); __builtin_amdgcn_s_setprio(0); } while (0)
#define PG8_WAIT_V(n) asm volatile("s_waitcnt vmcnt(" #n ")" ::: "memory")
#define PG8_WAIT_L(n) asm volatile("s_waitcnt lgkmcnt(" #n ")" ::: "memory")
#define PG8_BAR __builtin_amdgcn_s_barrier()
#define PG8_SCHED __builtin_amdgcn_sched_barrier(0)
    Unit cur, nxt; int ui = 0;
    if (!S.next(0, cur)) return;
    f32x4 acc[2][2][4][2];
#pragma unroll
    for (int a = 0; a < 2; ++a)
#pragma unroll
        for (int b = 0; b < 2; ++b)
#pragma unroll
            for (int m = 0; m < 4; ++m)
#pragma unroll
                for (int n = 0; n < 2; ++n) acc[a][b][m][n] = (f32x4){0.f, 0.f, 0.f, 0.f};
    bf16x8 At[4][2], B0[2][2], B1[2][2];
    const char* cA = (const char*)g.A + (long)S.a_row(cur) * (long)(K * 2); const char* cB = (const char*)g.Bt + (size_t)cur.pn * tstep;
    S.a_ready(cur);
    if constexpr (Epi::PREFETCH) E.prefetch(cur, wid, lane, 0);
    if constexpr (SP2) {
        PG8_STAGE(PG8_SB(0, 0), cB, voffB); PG8_STAGE(PG8_SB(0, 1), cB + hstep, voffB); PG8_STAGE(PG8_SA(0, 0), cA, voffA); PG8_STAGE(PG8_SA(0, 1), cA + hstep, voffA);
        if (wr == 1) PG8_BAR;
        PG8_WAIT_V(2); PG8_BAR;
        PG8_STAGE(PG8_SB(1, 0), cB + kstep, voffB); PG8_STAGE(PG8_SA(1, 0), cA + kstep, voffA); PG8_STAGE(PG8_SB(1, 1), cB + hstep + kstep, voffB);
        PG8_WAIT_V(6); PG8_BAR;
    } else {
        PG8_STAGE(PG8_SB(0, 0), cB, voffB); PG8_STAGE(PG8_SA(0, 0), cA, voffA); PG8_STAGE(PG8_SB(0, 1), cB + hstep, voffB); PG8_STAGE(PG8_SA(0, 1), cA + hstep, voffA);
        if (wr == 1) PG8_BAR;
        PG8_WAIT_V(4); PG8_BAR;
        PG8_STAGE(PG8_SB(1, 0), cB + kstep, voffB); PG8_STAGE(PG8_SA(1, 0), cA + kstep, voffA); PG8_STAGE(PG8_SB(1, 1), cB + hstep + kstep, voffB);
        PG8_WAIT_V(6); PG8_BAR;
    }
    for (;;) {
        const bool has_next = S.next(ui + 1, nxt);
        const char* nA = has_next ? (const char*)g.A + (long)S.a_row(nxt) * (long)(K * 2) : cA; const char* nB = has_next ? (const char*)g.Bt + (size_t)nxt.pn * tstep : cB;
        for (int t = 0; t < nt; t += 2) {
            const bool last = (t == nt - 2);
            const char* a1 = cA + (size_t)(t + 1) * kstep;
            const char* a2 = last ? nA : cA + (size_t)(t + 2) * kstep; const char* b2 = last ? nB : cB + (size_t)(t + 2) * kstep;
            const char* a3 = a2 + kstep; const char* b3 = b2 + kstep;
            if (last && has_next) S.a_ready(nxt);
            bool fin = false;
            if constexpr (Epi::AFTER_DRAIN) { fin = last && !has_next; if (fin) E.template stage_base<7>(lds, BASE_SPARE_OFF, cur, tid, ldsw); }
#define PG8_STG(buf, ptr, voff, H) do { if constexpr (Epi::AFTER_DRAIN) { if (fin) E.template stage_base<H>(lds, (buf), cur, tid, ldsw); else PG8_STAGE((buf), (ptr), voff); } else PG8_STAGE((buf), (ptr), voff); } while (0)
            if constexpr (SP2) {
            PG8_LDB(B0, 0, 0); PG8_LDB(B1, 0, 1); PG8_SCHED; PG8_LDA(At, 0, 0); PG8_STAGE(PG8_SA(1, 1), a1 + hstep, voffA);
            PG8_WAIT_V(8); PG8_WAIT_L(0); PG8_BAR; PG8_MMA(0, 0, At, B0); PG8_MMA(0, 1, At, B1); PG8_BAR; PG8_SCHED;
            PG8_LDA(At, 0, 1); PG8_STG(PG8_SB(0, 0), b2, voffB, 0); PG8_STG(PG8_SB(0, 1), b2 + hstep, voffB, 1); PG8_STG(PG8_SA(0, 0), a2, voffA, 2);
            PG8_WAIT_V(8); PG8_WAIT_L(0); PG8_BAR; PG8_MMA(1, 0, At, B0); PG8_MMA(1, 1, At, B1); PG8_BAR; PG8_SCHED;
            PG8_LDB(B0, 1, 0); PG8_LDB(B1, 1, 1); PG8_SCHED; PG8_LDA(At, 1, 0); PG8_STG(PG8_SA(0, 1), a2 + hstep, voffA, 3);
            PG8_WAIT_V(8); PG8_WAIT_L(0); PG8_BAR; PG8_MMA(0, 0, At, B0); PG8_MMA(0, 1, At, B1); PG8_BAR; PG8_SCHED;
            PG8_LDA(At, 1, 1); PG8_STG(PG8_SB(1, 0), b3, voffB, 4); PG8_STG(PG8_SB(1, 1), b3 + hstep, voffB, 5); PG8_STG(PG8_SA(1, 0), a3, voffA, 6);
            PG8_WAIT_V(8); PG8_WAIT_L(0); PG8_BAR; PG8_MMA(1, 0, At, B0); PG8_MMA(1, 1, At, B1); PG8_BAR; PG8_SCHED;
            } else {
            PG8_LDB(B0, 0, 0); PG8_SCHED; PG8_LDA(At, 0, 0); PG8_STAGE(PG8_SA(1, 1), a1 + hstep, voffA);
            PG8_WAIT_L(8); PG8_BAR; PG8_WAIT_L(0); PG8_MMA(0, 0, At, B0); PG8_BAR; PG8_SCHED;
            PG8_LDB(B1, 0, 1); PG8_STAGE(PG8_SB(0, 0), b2, voffB);
            PG8_BAR; PG8_WAIT_L(0); PG8_MMA(0, 1, At, B1); PG8_BAR;
            PG8_LDA(At, 0, 1); PG8_STAGE(PG8_SA(0, 0), a2, voffA);
            PG8_BAR; PG8_WAIT_L(0); PG8_MMA(1, 0, At, B0); PG8_BAR; PG8_SCHED;
            PG8_STAGE(PG8_SB(0, 1), b2 + hstep, voffB);
            PG8_WAIT_V(6); PG8_BAR; PG8_MMA(1, 1, At, B1); PG8_BAR;
            PG8_LDB(B0, 1, 0); PG8_SCHED; PG8_LDA(At, 1, 0); PG8_STAGE(PG8_SA(0, 1), a2 + hstep, voffA);
            PG8_WAIT_L(8); PG8_BAR; PG8_WAIT_L(0); PG8_MMA(0, 0, At, B0); PG8_BAR; PG8_SCHED;
            PG8_LDB(B1, 1, 1); PG8_STAGE(PG8_SB(1, 0), b3, voffB);
            PG8_BAR; PG8_WAIT_L(0); PG8_MMA(0, 1, At, B1); PG8_BAR;
            PG8_LDA(At, 1, 1); PG8_STAGE(PG8_SA(1, 0), a3, voffA);
            PG8_BAR; PG8_WAIT_L(0); PG8_MMA(1, 0, At, B0); PG8_BAR; PG8_SCHED;
            PG8_STAGE(PG8_SB(1, 1), b3 + hstep, voffB);
            PG8_WAIT_V(6); PG8_BAR; PG8_MMA(1, 1, At, B1); PG8_BAR;
            }
        }
        if constexpr (ALIGN_EPI) { if (wr == 0) PG8_BAR; }
        if constexpr (Epi::PREFETCH) { E(acc, cur, wr, wc, fr, fq, ui & 1); if (has_next) E.prefetch(nxt, wid, lane, (ui + 1) & 1); S.done(cur); }
        else if constexpr (!Epi::AFTER_DRAIN) { E(acc, cur, wr, wc, fr, fq); S.done(cur); }
        else { if (has_next) { E(acc, cur, wr, wc, fr, fq); S.done(cur); } }
        if (!has_next) break;
#pragma unroll
        for (int a = 0; a < 2; ++a)
#pragma unroll
            for (int b = 0; b < 2; ++b)
#pragma unroll
                for (int m = 0; m < 4; ++m)
#pragma unroll
                    for (int n = 0; n < 2; ++n) acc[a][b][m][n] = (f32x4){0.f, 0.f, 0.f, 0.f};
        cur = nxt; cA = nA; cB = nB; ++ui;
        if constexpr (ALIGN_EPI) { if (wr == 1) PG8_BAR; }
    }
    PG8_WAIT_V(0);
    if constexpr (!ALIGN_EPI) { if (wr == 0) PG8_BAR; }
    PG8_BAR;
    if constexpr (Epi::AFTER_DRAIN) { E.fused(acc, cur, wr, wc, fr, fq, lds, wid, lane); S.done(cur); }
#undef PG8_SA
#undef PG8_SB
#undef PG8_STAGE
#undef PG8_STG
#undef PG8_LDA
#undef PG8_LDB
#undef PG8_MMA
#undef PG8_WAIT_V
#undef PG8_WAIT_L
#undef PG8_BAR
#undef PG8_SCHED
}
}

#define GAS __attribute__((address_space(1)))
#define LAS __attribute__((address_space(3)))
typedef unsigned short bf16;
typedef unsigned v4u __attribute__((ext_vector_type(4)));
typedef float f32x4 __attribute__((ext_vector_type(4)));
typedef short bf16x8 __attribute__((ext_vector_type(8)));
typedef GAS unsigned gu32;
typedef GAS unsigned long long gu64;
#define RLX_AGENT __ATOMIC_RELAXED, __HIP_MEMORY_SCOPE_AGENT
#define LDS_WAIT() asm volatile("s_waitcnt lgkmcnt(0)" ::: "memory")
#define VM_WAIT() asm volatile("s_waitcnt vmcnt(0)" ::: "memory")
__device__ __forceinline__ unsigned long long rt() { return __builtin_amdgcn_s_memrealtime(); }
__device__ __forceinline__ unsigned pk2(float lo, float hi) { return (unsigned)f2bf(lo) | ((unsigned)f2bf(hi) << 16); }
#define XB_TMO      128
#define XB_XCNT(j)  (256  + 64 * (j))
#define XB_XSUB(j)  (1280 + 64 * (j))
#define XB_XGEN(j)  (2304 + 64 * (j))
#define XB_TOP      3328
#define XB_TOPGEN   3392
#define XCD_BAR_WORDS 3456
#define XB_SPIN_CAP (1u << 18)

__device__ __forceinline__ unsigned xb_ld(unsigned* p)              { return __hip_atomic_load(p, __ATOMIC_RELAXED, __HIP_MEMORY_SCOPE_AGENT); }
__device__ __forceinline__ unsigned xb_add(unsigned* p, unsigned v) { return __hip_atomic_fetch_add(p, v, __ATOMIC_RELAXED, __HIP_MEMORY_SCOPE_AGENT); }
__device__ __forceinline__ unsigned xb_xcc_id() { return (unsigned)__builtin_amdgcn_s_getreg((3 << 11) | 20) & 0xFu; }
#define XB_SPIN(cond, bar) do { unsigned _sp = 0; while (cond) { __builtin_amdgcn_s_sleep(1); \
    if ((++_sp & 255u) == 0u) { if (xb_ld(&(bar)[XB_TMO])) break; if (_sp > XB_SPIN_CAP) { atomicAdd(&(bar)[XB_TMO], 1u); break; } } } } while (0)

struct XcdBarrier {
    unsigned* bar; unsigned x;
    volatile LAS unsigned* st;
};

__device__ __forceinline__ XcdBarrier xcd_barrier_post(unsigned* bar, volatile LAS unsigned* st) {
    XcdBarrier b; b.bar = bar; b.x = xb_xcc_id(); b.st = st;
    if (threadIdx.x == 0) (void)xb_add(&bar[XB_XCNT(b.x)], 1u);
    return b;
}
__device__ __forceinline__ void xcd_barrier_complete(unsigned* bar, unsigned x, unsigned& nloc, unsigned& nx) {
    const unsigned G = gridDim.x * gridDim.y * gridDim.z;
    unsigned sum, cnt, mine, sp = 0u;
    for (;;) {
        sum = 0u; cnt = 0u; mine = 0u;
#pragma unroll
        for (unsigned j = 0; j < 16; ++j) { const unsigned c = xb_ld(&bar[XB_XCNT(j)]); sum += c; cnt += (c > 0u) ? 1u : 0u; mine = (j == x) ? c : mine; }
        if (sum == G) break;
        __builtin_amdgcn_s_sleep(1);
        if ((++sp & 255u) == 0u) { if (xb_ld(&bar[XB_TMO])) break; if (sp > XB_SPIN_CAP) { atomicAdd(&bar[XB_TMO], 1u); break; } }
    }
    nloc = mine > 0u ? mine : 1u; nx = cnt > 0u ? cnt : 1u;
}

__device__ __forceinline__ void xcd_barrier_protocol(const XcdBarrier& b) {
        unsigned* bar = b.bar;
        __builtin_amdgcn_s_waitcnt(0);
        unsigned nloc = b.st[0], nx = b.st[1];
        if (nloc == 0u) { xcd_barrier_complete(bar, b.x, nloc, nx); b.st[0] = nloc; b.st[1] = nx; }
        const unsigned old = xb_add(&bar[XB_XSUB(b.x)], 1u);
        const unsigned gen = old / nloc;
        if (old + 1u == (gen + 1u) * nloc) {
            __builtin_amdgcn_fence(__ATOMIC_RELEASE, "agent");
            asm volatile("s_waitcnt vmcnt(0)" ::: "memory");
            const unsigned og = xb_add(&bar[XB_TOP], 1u);
            const unsigned tg = og / nx;
            if (og + 1u == (tg + 1u) * nx) xb_add(&bar[XB_TOPGEN], 1u);
            else XB_SPIN(xb_ld(&bar[XB_TOPGEN]) == tg, bar);
            __builtin_amdgcn_fence(__ATOMIC_ACQUIRE, "agent");
            asm volatile("s_waitcnt vmcnt(0)" ::: "memory");
        } else {
            XB_SPIN(xb_ld(&bar[XB_TOPGEN]) == gen, bar);
            __builtin_amdgcn_fence(__ATOMIC_ACQUIRE, "agent");
            asm volatile("s_waitcnt vmcnt(0)" ::: "memory");
        }
}
__device__ __forceinline__ void xcd_barrier(const XcdBarrier& b) {
    asm volatile("s_waitcnt vmcnt(0)" ::: "memory");
    __syncthreads();
    if (threadIdx.x == 0) xcd_barrier_protocol(b);
    __syncthreads();
}
template <class Work>
__device__ __forceinline__ void xcd_barrier_work(const XcdBarrier& b, int wave, const Work& work) {
    asm volatile("s_waitcnt vmcnt(0)" ::: "memory");
    __syncthreads();
    if (wave == 0) { if (threadIdx.x == 0) xcd_barrier_protocol(b); }
    else work(wave - 1);
    __syncthreads();
}

constexpr int NWAVES = 8;
constexpr int CW_BAR = 163840;
constexpr size_t WS_MH = 540 * 1024;
constexpr size_t WS_RT = 544 * 1024;
constexpr size_t WS_WIN = 1 * MiB, WS_WOUT = 5 * MiB, WS_WQKV = 7 * MiB, WS_WO = 13 * MiB, WS_WUP = 15 * MiB  , WS_WDN = 37 * MiB  , WS_WPOOL = 48 * MiB;
static_assert(WS_WPOOL + 131072 <= WS_XB - 4096 && WS_XB + (size_t)T * D * 2 + 512 * 1024 <= WS_R && WS_END <= 256 * MiB, "d_ws map");
constexpr int RING_OFF = 0, RING_BYTES = 131072, LDSCTL_OFF = RING_BYTES, MISC_OFF = LDSCTL_OFF + 320, HALO_OFF = RING_BYTES + 1024, LDS_BYTES = 154624;
static_assert(pg8::BASE_SPARE_OFF == HALO_OFF && HALO_OFF + 16384 <= LDS_BYTES, "base-tile spare buffer");
static_assert(HALO_OFF + 12288 + 2 * 5120 <= LDS_BYTES, "LDS map");
static_assert(WS_BIAS + 3 * 129 * 16 * 4 <= WS_MH && WS_MH + 64 <= WS_RT && WS_RT + 16 * 3 * 256 * 4 <= (size_t)CW_BAR * 4 && (size_t)CW_BAR * 4 + 11 * 3456 * 4 <= MiB && WS_SSQ + 4 * T * 4 <= WS_BIAS, "control region map");

struct Frame {
    LAS unsigned char* lds; volatile LAS unsigned* MISC; gu32* ctl;
    int tid, lane, wave, vcu, G;
};
struct Args { const float* in[18]; float* out; unsigned char* ws; int ph_lo, ph_hi, li, pad; };

__device__ __forceinline__ int t5_bucket(int dist) {
    if (dist < 16) return dist;
    int b = 16;
    b += dist >= 22; b += dist >= 30; b += dist >= 40; b += dist >= 54; b += dist >= 73; b += dist >= 99; b += dist >= 134; b += dist >= 182;
    b += dist >= 246; b += dist >= 332; b += dist >= 450; b += dist >= 609; b += dist >= 825; b += dist >= 1117; b += dist >= 1513;
    return b;
}
template <bool HAS_K, bool HAS_N, class DstRow>
__device__ __forceinline__ void p0_item(const float* __restrict__ W, int K, int N, bf16* WT, const float* __restrict__ ksc, const float* __restrict__ nsc, LAS float* scr, int item, int lane, DstRow dst) {
    const int nblk = N / 32, kb = item / nblk, nb = item % nblk, k0 = 64 * kb, n0 = 32 * nb;
    const int c = lane & 7;
    const float* wp = W + (size_t)(k0 + (lane >> 5)) * N + n0 + (lane & 31);
    float v[32];
#pragma unroll
    for (int i = 0; i < 32; ++i) v[i] = __builtin_nontemporal_load(wp + (size_t)(2 * i) * N);
    float ns = 1.f; f32x4 ka = {1.f, 1.f, 1.f, 1.f}, kb4 = ka;
    if (HAS_N) ns = nsc[n0 + (lane & 31)];
    if (HAS_K) { ka = *(const f32x4*)(ksc + k0 + 8 * c); kb4 = *(const f32x4*)(ksc + k0 + 8 * c + 4); }
#pragma unroll
    for (int i = 0; i < 32; ++i) scr[(2 * i + (lane >> 5)) * 33 + (lane & 31)] = HAS_N ? v[i] * ns : v[i];
    LDS_WAIT(); asm volatile("" ::: "memory");
#pragma unroll
    for (int j = 0; j < 4; ++j) { const int n = (lane >> 3) + 8 * j; const LAS float* s = scr + (8 * c) * 33 + n;
        v4u o; o.x = pk2(s[0 * 33] * ka[0], s[1 * 33] * ka[1]); o.y = pk2(s[2 * 33] * ka[2], s[3 * 33] * ka[3]); o.z = pk2(s[4 * 33] * kb4[0], s[5 * 33] * kb4[1]); o.w = pk2(s[6 * 33] * kb4[2], s[7 * 33] * kb4[3]);
        *(GAS v4u*)(WT + (size_t)dst(n0 + n) * K + k0 + 8 * c) = o; }
    LDS_WAIT(); asm volatile("" ::: "memory");
}
struct DstId { __device__ __forceinline__ int operator()(int n) const { return n; } };
__host__ __device__ __forceinline__ int win_row(int bj, int nn, int ch) { return 256 * (ch >> 6) + 128 * bj + 32 * ((ch >> 4) & 3) + 8 * ((ch >> 2) & 3) + 4 * nn + (ch & 3); }
struct DstIn2 { __device__ __forceinline__ int operator()(int n) const { const int ty = n >> 9, ch = n & 511; return ty == 0 ? win_row(0, 0, ch) : ty == 1 ? win_row(1, 0, ch) : ty == 2 ? win_row(0, 1, ch) : win_row(1, 1, ch); } };
struct DstIn { __device__ __forceinline__ int operator()(int n) const { if (n < 512) return 256 * (n >> 7) + (n & 127); if (n < 1024) return 512 + n; if (n < 1536) { const int m = n - 1024; return 256 * (m >> 7) + 128 + (m & 127); } return n; } };
struct DstQkv { __device__ __forceinline__ int operator()(int c) const { const int cl = c & 255; return (c & ~255) + 128 * ((cl & 63) >> 5) + 32 * (cl >> 6) + (cl & 31); } };
struct DstUp { __device__ __forceinline__ int operator()(int c) const { return c < DFF ? 256 * (c >> 7) + (c & 127) : 256 * ((c - DFF) >> 7) + 128 + ((c - DFF) & 127); } };

constexpr int I_IN = 16 * 64, I_OUT = 16 * 32, I_QKV = 16 * 96, I_O = 16 * 32, I_UP = 16 * 176, I_DN = 44 * 32, I_POOL = 2 * 4;
constexpr int IT_POOL = I_IN, IT_OUT = IT_POOL + 4 * I_POOL, IT_UP0 = IT_OUT + I_OUT, IT_DN0 = IT_UP0 + I_UP, IT_QKV = IT_DN0 + I_DN, IT_O = IT_QKV + I_QKV, IT_UP1 = IT_O + I_O, IT_DN1 = IT_UP1 + I_UP, IT_END = IT_DN1 + I_DN;
__device__ __forceinline__ void p0_prod_item(const Args& a, int kb, int nb, int lane) {
    const float* W = a.in[3]; const float* ksc = a.in[2]; bf16* WT = (bf16*)(a.ws + WS_WIN);
    const int k0 = 64 * kb, np0 = 32 * nb, g = np0 >> 7, nn0 = np0 & 127, i = lane & 15, g4 = lane >> 4;
    const float* Wk = W + (size_t)(k0 + i) * EVEN_IN + 3 * AW + 128 * g + 8 * g4;
    const float* Wp = a.in[5] + (size_t)g * 128 * 128 + (size_t)(8 * g4) * 128 + nn0 + i;
    f32x4 ar[4][4][2]; float br[2][4][8];
#pragma unroll
    for (int kt = 0; kt < 4; ++kt)
#pragma unroll
        for (int js = 0; js < 4; ++js) { ar[kt][js][0] = *(const f32x4*)(Wk + (size_t)(16 * kt) * EVEN_IN + 32 * js); ar[kt][js][1] = *(const f32x4*)(Wk + (size_t)(16 * kt) * EVEN_IN + 32 * js + 4); }
#pragma unroll
    for (int nt = 0; nt < 2; ++nt)
#pragma unroll
        for (int js = 0; js < 4; ++js)
#pragma unroll
            for (int e = 0; e < 8; ++e) br[nt][js][e] = Wp[(size_t)(32 * js + e) * 128 + 16 * nt];
    pg8::f32x4 acc[4][2];
#pragma unroll
    for (int kt = 0; kt < 4; ++kt)
#pragma unroll
        for (int nt = 0; nt < 2; ++nt) acc[kt][nt] = (pg8::f32x4){0.f, 0.f, 0.f, 0.f};
#pragma unroll
    for (int js = 0; js < 4; ++js) { pg8::bf16x8 bf[2], af[4];
#pragma unroll
        for (int nt = 0; nt < 2; ++nt) { v4u w; w.x = pk2(br[nt][js][0], br[nt][js][1]); w.y = pk2(br[nt][js][2], br[nt][js][3]); w.z = pk2(br[nt][js][4], br[nt][js][5]); w.w = pk2(br[nt][js][6], br[nt][js][7]); bf[nt] = __builtin_bit_cast(pg8::bf16x8, w); }
#pragma unroll
        for (int kt = 0; kt < 4; ++kt) { const f32x4 lo = ar[kt][js][0], hi = ar[kt][js][1]; v4u w; w.x = pk2(lo.x, lo.y); w.y = pk2(lo.z, lo.w); w.z = pk2(hi.x, hi.y); w.w = pk2(hi.z, hi.w); af[kt] = __builtin_bit_cast(pg8::bf16x8, w); }
#pragma unroll
        for (int kt = 0; kt < 4; ++kt)
#pragma unroll
            for (int nt = 0; nt < 2; ++nt) acc[kt][nt] = __builtin_amdgcn_mfma_f32_16x16x32_bf16(af[kt], bf[nt], acc[kt][nt], 0, 0, 0); }
#pragma unroll
    for (int nt = 0; nt < 2; ++nt) { const float sc = a.in[6][g * 128 + nn0 + 16 * nt + i]; bf16* rowp = WT + (size_t)win_row(1, 1, np0 + 16 * nt + i) * D + k0 + 4 * g4;
#pragma unroll
        for (int kt = 0; kt < 4; ++kt) { const f32x4 kg = *(const f32x4*)(ksc + k0 + 16 * kt + 4 * g4); const pg8::f32x4 v = acc[kt][nt];
            unsigned long long o = (unsigned long long)pk2(v[0] * kg.x * sc, v[1] * kg.y * sc) | ((unsigned long long)pk2(v[2] * kg.z * sc, v[3] * kg.w * sc) << 32);
            *(GAS unsigned long long*)(rowp + 16 * kt) = o; } }
}
__device__ __forceinline__ void convert_item(const Args& a, LAS float* scr, int it, int lane) {
    unsigned char* ws = a.ws;
    if (it < IT_POOL) { if ((it & 63) >= 48) p0_prod_item(a, it >> 6, (it & 63) - 48, lane); else p0_item<true, false>(a.in[3], D, EVEN_IN, (bf16*)(ws + WS_WIN), a.in[2], nullptr, scr, it, lane, DstIn2()); return; }
    if (it < IT_OUT) return;
    if (it < IT_OUT) { const int r = it - IT_POOL, g = r / I_POOL; p0_item<false, true>(a.in[5] + (size_t)g * 128 * 128, 128, 128, (bf16*)(ws + WS_WPOOL) + (size_t)g * 128 * 128, nullptr, a.in[6] + g * 128, scr, r - g * I_POOL, lane, DstId()); return; }
    if (it < IT_UP0) { p0_item<false, false>(a.in[7], D, D, (bf16*)(ws + WS_WOUT), nullptr, nullptr, scr, it - IT_OUT, lane, DstId()); return; }
    if (it < IT_DN0) { p0_item<true, false>(a.in[14], D, DFF2, (bf16*)(ws + WS_WUP), a.in[13], nullptr, scr, it - IT_UP0, lane, DstUp()); return; }
    if (it < IT_QKV) { p0_item<false, false>(a.in[17], DFF, D, (bf16*)(ws + WS_WDN), nullptr, nullptr, scr, it - IT_DN0, lane, DstId()); return; }
    if (it < IT_O) { p0_item<true, false>(a.in[9], D, NQKV, (bf16*)(ws + WS_WQKV), a.in[8], nullptr, scr, it - IT_QKV, lane, DstQkv()); return; }
    if (it < IT_UP1) { p0_item<false, false>(a.in[12], D, D, (bf16*)(ws + WS_WO), nullptr, nullptr, scr, it - IT_O, lane, DstId()); return; }
    if (it < IT_DN1) { p0_item<true, false>(a.in[14] + (size_t)D * DFF2, D, DFF2, (bf16*)(ws + WS_WUP) + (size_t)DFF2 * D, a.in[13] + D, nullptr, scr, it - IT_UP1, lane, DstUp()); return; }
    p0_item<false, false>(a.in[17] + (size_t)DFF * D, DFF, D, (bf16*)(ws + WS_WDN) + (size_t)D * DFF, nullptr, nullptr, scr, it - IT_DN1, lane, DstId());
}
struct ConvertWork { const Args* a; LAS unsigned char* lds; int vcu, G, lane, lo, hi;
    __device__ __forceinline__ void operator()(int w7) const { LAS float* scr = (LAS float*)(lds + (w7 + 1) * 16384);
        for (int it = lo + vcu * 7 + w7; it < hi; it += G * 7) convert_item(*a, scr, it, lane); } };
#ifndef CONVERT_IN_SEAMS
#define CONVERT_IN_SEAMS 1
#endif
__device__ __forceinline__ void p0_prologue(Frame& F, const Args& a) {
    unsigned char* ws = a.ws;
    LAS float* scr = (LAS float*)(F.lds + RING_OFF + F.wave * 16384);
    const int gw = F.vcu * NWAVES + F.wave, NGW = F.G * NWAVES;
    const float* x = a.in[0];
    for (int it = gw; it < (CONVERT_IN_SEAMS ? IT_OUT : IT_END); it += NGW) convert_item(a, scr, it, F.lane);
    float* ssq = (float*)(ws + WS_SSQ); bf16* xb = (bf16*)(ws + WS_XB);
    for (int m = gw; m < T; m += NGW) {
        const GAS f32x4* xr = (const GAS f32x4*)(x + (size_t)m * D) + F.lane; f32x4 v[4]; float s = 0.f;
#pragma unroll
        for (int j = 0; j < 4; ++j) { v[j] = __builtin_nontemporal_load(xr + 64 * j); s += (v[j].x * v[j].x + v[j].y * v[j].y) + (v[j].z * v[j].z + v[j].w * v[j].w); }
        s = wave_sum(s);
        GAS unsigned long long* o8 = (GAS unsigned long long*)(xb + (size_t)m * D) + F.lane;
#pragma unroll
        for (int j = 0; j < 4; ++j) o8[64 * j] = (unsigned long long)pk2(v[j].x, v[j].y) | ((unsigned long long)pk2(v[j].z, v[j].w) << 32);
        if (F.lane == 0) ssq[m] = s;
    }
    if (gw == NGW - 1) { GAS v4u* p = (GAS v4u*)(ws + WS_XB - 4096); for (int i = F.lane; i < 256; i += 64) p[i] = (v4u){0u, 0u, 0u, 0u}; }
    if (gw < NH) {
        const int h = gw; const float* rel = a.in[1];
        float gqm = fabsf(a.in[10][F.lane]), gkm = fabsf(a.in[11][F.lane]), rb = F.lane < 32 ? rel[F.lane * 16 + h] : -1e30f;
#pragma unroll
        for (int o = 1; o < 64; o <<= 1) { gqm = fmaxf(gqm, __shfl_xor(gqm, o)); gkm = fmaxf(gkm, __shfl_xor(gkm, o)); rb = fmaxf(rb, __shfl_xor(rb, o)); }
        const float Mh = 8.0f * gqm * gkm * LOG2E * 1.02f + rb * LOG2E;
        if (F.lane == 0) ((float*)(ws + WS_MH))[h] = Mh;
        float* rtab = (float*)(ws + WS_RT) + h * 3 * 256;
        for (int i = F.lane; i < 3 * 256; i += 64) { const int br = i / 256, xx = i % 256, jrel = 191 - xx, dil = br == 0 ? 1 : (br == 1 ? 4 : 16);
            rtab[i] = (jrel >= 0 && jrel <= 128) ? rel[t5_bucket(jrel * dil) * 16 + h] * LOG2E - Mh : -1e30f; }
        float* bias = (float*)(ws + WS_BIAS);
        for (int i = F.lane; i < 3 * 129; i += 64) { const int br = i / 129, j = i % 129, dil = br == 0 ? 1 : (br == 1 ? 4 : 16); bias[(br * 129 + j) * 16 + h] = rel[t5_bucket(j * dil) * 16 + h] * LOG2E; }
    }
}


typedef unsigned u32x4_t __attribute__((ext_vector_type(4)));
typedef float f32x2_t __attribute__((ext_vector_type(2))); typedef __bf16 bf16x2_t __attribute__((ext_vector_type(2)));
__device__ __forceinline__ unsigned cvtpk_c(float lo, float hi) { f32x2_t v = {lo, hi}; bf16x2_t b = __builtin_convertvector(v, bf16x2_t); return __builtin_bit_cast(unsigned, b); }
typedef unsigned u32x2_t __attribute__((ext_vector_type(2)));
__device__ __forceinline__ void ld8(const bf16* p, float (&f)[8]) { const u32x4_t v = *(const u32x4_t*)p;
#pragma unroll
    for (int i = 0; i < 4; ++i) { f[2 * i] = __uint_as_float(v[i] << 16); f[2 * i + 1] = __uint_as_float(v[i] & 0xffff0000u); } }
__device__ __forceinline__ u32x4_t pk8(const float (&f)[8]) { u32x4_t w; w.x = pg8::cvt_pk_bf16(f[0], f[1]); w.y = pg8::cvt_pk_bf16(f[2], f[3]); w.z = pg8::cvt_pk_bf16(f[4], f[5]); w.w = pg8::cvt_pk_bf16(f[6], f[7]); return w; }
__device__ __forceinline__ void unpk8(const u32x4_t v, float (&f)[8]) {
#pragma unroll
    for (int i = 0; i < 4; ++i) { f[2 * i] = __uint_as_float(v[i] << 16); f[2 * i + 1] = __uint_as_float(v[i] & 0xffff0000u); } }
template <int K>
__device__ __forceinline__ void pooled_part(const bf16* __restrict__ pin, int tl0, bf16* dst) {
    constexpr int ZP = 512;
    u32x4_t hraw[K - 1], araw[8];
#pragma unroll
    for (int j = 1; j < K; ++j) hraw[j - 1] = *(const u32x4_t*)(pin - (size_t)((tl0 - j >= 0) ? j : 0) * ZP);
#pragma unroll
    for (int i = 0; i < 8; ++i) araw[i] = *(const u32x4_t*)(pin + (size_t)i * ZP);
    float sm[8];
#pragma unroll
    for (int e = 0; e < 8; ++e) sm[e] = 0.f;
#pragma unroll
    for (int j = 1; j < K; ++j) { const bool ok = tl0 - j >= 0;
#pragma unroll
        for (int q = 0; q < 4; ++q) hraw[j - 1][q] = ok ? hraw[j - 1][q] : 0u;
        float a[8]; unpk8(hraw[j - 1], a);
#pragma unroll
        for (int e = 0; e < 8; ++e) sm[e] += a[e]; }
#pragma unroll
    for (int i = 0; i < 8; ++i) { const int tl = tl0 + i; float a[8], y[8]; unpk8(araw[i], a);
#pragma unroll
        for (int e = 0; e < 8; ++e) sm[e] += a[e];
        const float inv = (tl + 1 >= K) ? (1.0f / (float)K) : __builtin_amdgcn_rcpf((float)(tl + 1));
#pragma unroll
        for (int e = 0; e < 8; ++e) y[e] = sm[e] * inv - a[e];
        *(u32x4_t*)(dst + (size_t)i * D) = pk8(y);
        if (i < 7) { float r[8]; if (i + 1 - K >= 0) unpk8(araw[i + 1 - K >= 0 ? i + 1 - K : 0], r); else unpk8(hraw[(K - 2 - i) >= 0 ? (K - 2 - i) : 0], r);
#pragma unroll
            for (int e = 0; e < 8; ++e) sm[e] -= r[e]; } }
}
__device__ __forceinline__ void mixer_phase(Frame& F, const bf16* __restrict__ zbuf, const float* __restrict__ cw, const float* __restrict__ side, bf16* mix) {
    for (int w = F.vcu * (NWAVES * 64) + F.tid; w < 64 * 2 * 128; w += F.G * NWAVES * 64) {
        const int pm = w >> 8, rr = (w >> 7) & 1, c4 = 4 * (w & 127);
        if ((pm & 15) != 0) {
            const float* sp = side + (size_t)pm * 6 * 512 + c4; const float* spp = sp - 6 * 512;
            const pg8::f32x4 p0 = *(const pg8::f32x4*)(sp + rr * 512), gb = *(const pg8::f32x4*)(sp + (4 + rr) * 512);
            const pg8::f32x4 p1 = rr ? *(const pg8::f32x4*)(sp) : *(const pg8::f32x4*)(spp + 3 * 512), p2 = rr ? *(const pg8::f32x4*)(spp + 3 * 512) : *(const pg8::f32x4*)(spp + 2 * 512);
            const pg8::f32x4 w0 = *(const pg8::f32x4*)(cw + c4), w1 = *(const pg8::f32x4*)(cw + AW + c4), w2 = *(const pg8::f32x4*)(cw + 2 * AW + c4);
            const pg8::f32x4 y = gb * (w0 * p2 + w1 * p1 + w2 * p0);
            u32x2_t o; o.x = pg8::cvt_pk_bf16(y[0], y[1]); o.y = pg8::cvt_pk_bf16(y[2], y[3]);
            *(u32x2_t*)(mix + (size_t)(pm * 256 + rr) * D + c4) = o; }
    }
    for (int u = F.vcu; u < T / 64; u += F.G) {
        const int g = F.wave >> 1, tgp = (F.wave & 1) * 4 + (F.lane >> 4), c0p = 8 * (16 * g + (F.lane & 15));
        const int t0p = u * 64 + 8 * tgp, tl0p = t0p & (SEQ - 1);
        const bf16* pin = zbuf + (size_t)t0p * 512 + c0p; bf16* dst = mix + (size_t)t0p * D + AW + c0p;
        if (g == 0) pooled_part<2>(pin, tl0p, dst); else if (g == 1) pooled_part<4>(pin, tl0p, dst); else if (g == 2) pooled_part<8>(pin, tl0p, dst); else pooled_part<16>(pin, tl0p, dst);
    }
}

namespace att {
constexpr int OPB = 136, VP = 160, NTAB = 256;
constexpr int LDS_TAB = 0, LDS_V = 2 * 3 * NTAB * 4  , V_BYTES = 32 * VP, LDS_L = LDS_V + 8 * V_BYTES, LDS_O = LDS_L + 2048, LDS_END = LDS_O + 512 * OPB;
static_assert(LDS_V % 16 == 0 && LDS_O % 16 == 0 && LDS_END <= RING_BYTES, "attention LDS map");
typedef short v4i16_t __attribute__((ext_vector_type(4)));
__device__ __forceinline__ v4i16_t vtr(const LAS unsigned char* p) { return __builtin_amdgcn_ds_read_tr16_b64_v4i16((LAS v4i16_t*)p); }
struct KV { pg8::bf16x8 k[2][2]; u32x4_t v[4]; };
__device__ __forceinline__ pg8::f32x4 bf4_to_f32(u32x2_t w) { return (pg8::f32x4){__uint_as_float(w.x << 16), __uint_as_float(w.x & 0xffff0000u), __uint_as_float(w.y << 16), __uint_as_float(w.y & 0xffff0000u)}; }
template <int MODE, int SH, bool CLAMP, int NT>
__device__ __forceinline__ void item(const bf16* __restrict__ qkv, bf16* __restrict__ ao, LAS unsigned char* lds, int wave, int lane, int b, int h, int p0, int rel, bool dosync, int tsel) {
    constexpr int DIL = 1 << SH, NS = 4 + NT / 2;
    { int l_ = threadIdx.x & 63; asm volatile("" : "+v"(l_)); lane = l_; }
    const int q = lane & 15, g4 = lane >> 4;
    const int base_pos = p0 + rel, res = base_pos & (DIL - 1), i0 = base_pos >> SH, kmin = 128 - i0;
    const size_t rowbase = (size_t)b * SEQ;
    const bf16* hq = qkv + (size_t)(b * NH + h) * SEQ * HD;
    const bf16* qp = hq + (size_t)(base_pos + DIL * q) * HD + 8 * g4;
    pg8::bf16x8 qf[NT][2];
#pragma unroll
    for (int t = 0; t < NT; ++t) { qf[t][0] = *(const pg8::bf16x8*)(qp + (size_t)t * 16 * DIL * HD); qf[t][1] = *(const pg8::bf16x8*)(qp + (size_t)t * 16 * DIL * HD + 32); }
    const bf16* kbase = hq + (size_t)T * D + 8 * g4;
    const bf16* vbase = hq + (size_t)2 * T * D + 8 * (lane & 7);
    LAS unsigned char* vbuf = lds + LDS_V + wave * V_BYTES;
    LAS unsigned char* vw = vbuf + (lane >> 3) * VP + (lane & 7) * 16;
    const LAS unsigned char* vr = vbuf + (4 * g4 + (q >> 2)) * VP + (q & 3) * 8;
    const LAS float* tab = (const LAS float*)(lds + LDS_TAB) + tsel * 3 * NTAB + (SH == 4 ? 2 : (SH == 2 ? 1 : 0)) * NTAB + (15 - q + 4 * g4);
    asm volatile("" : "+v"(tab), "+v"(vw), "+v"(vr));
    pg8::f32x4 o[NT][4]; float lsum[NT];
#pragma unroll
    for (int t = 0; t < NT; ++t) { lsum[t] = 0.f;
#pragma unroll
        for (int dt = 0; dt < 4; ++dt) o[t][dt] = (pg8::f32x4){0.f, 0.f, 0.f, 0.f}; }
    const char* kb_u = (const char*)(hq + (size_t)T * D); const char* vb_u = (const char*)(hq + (size_t)2 * T * D);
    const unsigned koff0 = (unsigned)(((res + ((i0 - 128 + q) << SH)) * HD + 8 * g4) * 2);
    const unsigned voff0 = (unsigned)(((res + ((i0 - 128 + (lane >> 3)) << SH)) * HD + 8 * (lane & 7)) * 2);
    auto load = [&](int st, KV& d) {
#pragma unroll
        for (int j = 0; j < 2; ++j) { const char* kp;
            if (CLAMP) { int ik = i0 - 128 + 32 * st + 16 * j + q; ik = ik < 0 ? 0 : ik; kp = kb_u + (size_t)(unsigned)(((res + (ik << SH)) * HD + 8 * g4) * 2); }
            else kp = kb_u + (size_t)(((32 * st + 16 * j) << SH) * HD * 2) + (size_t)koff0;
            d.k[j][0] = *(const pg8::bf16x8*)kp; d.k[j][1] = *(const pg8::bf16x8*)(kp + 64); }
#pragma unroll
        for (int i = 0; i < 4; ++i) { const char* vp;
            if (CLAMP) { int ik = i0 - 128 + 32 * st + 8 * i + (lane >> 3); ik = ik < 0 ? 0 : ik; vp = vb_u + (size_t)(unsigned)(((res + (ik << SH)) * HD + 8 * (lane & 7)) * 2); }
            else vp = vb_u + (size_t)(((32 * st + 8 * i) << SH) * HD * 2) + (size_t)voff0;
            d.v[i] = *(const u32x4_t*)vp; }
    };
    KV cur; load(0, cur);
    if (dosync) { asm volatile("s_waitcnt lgkmcnt(0)" ::: "memory"); __builtin_amdgcn_s_barrier(); asm volatile("" ::: "memory"); }
#pragma unroll
    for (int st = 0; st < NS; ++st) {
#pragma unroll
        for (int i = 0; i < 4; ++i) *(LAS u32x4_t*)(vw + 8 * i * VP) = cur.v[i];
        asm volatile("" ::: "memory");
        KV nxt; if (st < NS - 1) { load(st + 1, nxt); __builtin_amdgcn_sched_barrier(0); }
        pg8::bf16x8 pb[NT];
        const LAS float* tabs = tab + 32 * st; asm volatile("" : "+v"(tabs));
        pg8::f32x4 bq[2] = {(pg8::f32x4){0.f, 0.f, 0.f, 0.f}, (pg8::f32x4){0.f, 0.f, 0.f, 0.f}};
        { const LAS float* tabt = tabs + 16 * 3; if (NT > 2) asm volatile("" : "+v"(tabt));
#pragma unroll
          for (int j = 0; j < 2; ++j) if (2 * st + j >= 0 && 2 * st + j <= 8) bq[j] = (pg8::f32x4){tabt[16 * j], tabt[16 * j + 1], tabt[16 * j + 2], tabt[16 * j + 3]}; }
#pragma unroll
        for (int t = 0; t < NT; ++t) { pg8::f32x4 sT[2], bc[2]; bc[0] = bq[0]; bc[1] = bq[1];
            if (t + 1 < NT) { const LAS float* tabt = tabs + 16 * (3 - (t + 1)); if (NT > 2) asm volatile("" : "+v"(tabt));
#pragma unroll
                for (int j = 0; j < 2; ++j) if (2 * st + j >= t + 1 && 2 * st + j <= t + 9) bq[j] = (pg8::f32x4){tabt[16 * j], tabt[16 * j + 1], tabt[16 * j + 2], tabt[16 * j + 3]}; }
#pragma unroll
            for (int j = 0; j < 2; ++j) { if (2 * st + j >= t && 2 * st + j <= t + 8) {
                sT[j] = __builtin_amdgcn_mfma_f32_16x16x32_bf16(cur.k[j][0], qf[t][0], bc[j], 0, 0, 0);
                sT[j] = __builtin_amdgcn_mfma_f32_16x16x32_bf16(cur.k[j][1], qf[t][1], sT[j], 0, 0, 0); } }
            float p[2][4];
#pragma unroll
            for (int j = 0; j < 2; ++j)
#pragma unroll
                for (int r = 0; r < 4; ++r) { if (2 * st + j >= t && 2 * st + j <= t + 8) { const int kk = 32 * st + 16 * j + 4 * g4 + r; float sv = sT[j][r]; if (CLAMP) sv = kk < kmin ? -1e30f : sv;
                    p[j][r] = __builtin_amdgcn_exp2f(sv); lsum[t] += p[j][r]; } else p[j][r] = 0.f; }
            u32x4_t pw; pw.x = cvtpk_c(p[0][0], p[0][1]); pw.y = cvtpk_c(p[0][2], p[0][3]); pw.z = cvtpk_c(p[1][0], p[1][1]); pw.w = cvtpk_c(p[1][2], p[1][3]);
            pb[t] = __builtin_bit_cast(pg8::bf16x8, pw); if (NT > 2) { asm volatile("" : "+v"(lsum[t])); if (t & 1) __builtin_amdgcn_sched_barrier(0); } }
#pragma unroll
        for (int dt = 0; dt < 4; ++dt) { const v4i16_t lo = vtr(vr + dt * 32), hi = vtr(vr + 16 * VP + dt * 32);
            const pg8::bf16x8 va = (pg8::bf16x8){lo[0], lo[1], lo[2], lo[3], hi[0], hi[1], hi[2], hi[3]};
#pragma unroll
            for (int t = 0; t < NT; ++t) if (2 * st + 1 >= t && 2 * st <= t + 8) o[t][dt] = __builtin_amdgcn_mfma_f32_16x16x32_bf16(va, pb[t], o[t][dt], 0, 0, 0); }
        asm volatile("" ::: "memory"); __builtin_amdgcn_sched_barrier(0);
        if (st < NS - 1) cur = nxt;
    }
#pragma unroll
    for (int t = 0; t < NT; ++t) { float ls = lsum[t]; ls += __shfl_xor(ls, 16); ls += __shfl_xor(ls, 32);
        const int posu = rel + DIL * (16 * t + q), slot = (posu & ~0xF) | ((posu ^ (posu >> 4)) & 0xF);
        LAS unsigned char* Ol = lds + LDS_O + slot * OPB + 8 * g4; LAS float* Ll = (LAS float*)(lds + LDS_L) + slot;
        if (MODE == 0) {
#pragma unroll
            for (int dt = 0; dt < 4; ++dt) { u32x2_t w; w.x = cvtpk_c(o[t][dt][0], o[t][dt][1]); w.y = cvtpk_c(o[t][dt][2], o[t][dt][3]); *(LAS u32x2_t*)(Ol + 32 * dt) = w; }
            if (g4 == 0) *Ll = ls;
        } else if (MODE == 1) {
#pragma unroll
            for (int dt = 0; dt < 4; ++dt) { const pg8::f32x4 v = bf4_to_f32(*(LAS u32x2_t*)(Ol + 32 * dt)) + o[t][dt]; u32x2_t w; w.x = cvtpk_c(v[0], v[1]); w.y = cvtpk_c(v[2], v[3]); *(LAS u32x2_t*)(Ol + 32 * dt) = w; }
            if (g4 == 0) *Ll = *Ll + ls;
        } else {
            const float inv = 1.0f / (*Ll + ls);
            bf16* op = ao + (rowbase + p0 + posu) * D + h * HD;
            u32x2_t w[4];
#pragma unroll
            for (int dt = 0; dt < 4; ++dt) { const pg8::f32x4 v = (bf4_to_f32(*(LAS u32x2_t*)(Ol + 32 * dt)) + o[t][dt]) * inv; w[dt].x = cvtpk_c(v[0], v[1]); w[dt].y = cvtpk_c(v[2], v[3]); }
#pragma unroll
            for (int dp = 0; dp < 4; dp += 2) { const auto s0 = __builtin_amdgcn_permlane16_swap(w[dp].x, w[dp + 1].x, false, false); const auto s1 = __builtin_amdgcn_permlane16_swap(w[dp].y, w[dp + 1].y, false, false);
                u32x4_t o4; o4.x = s0[0]; o4.y = s1[0]; o4.z = s0[1]; o4.w = s1[1];
                *(u32x4_t*)(op + ((g4 & 1) ? 16 * (dp + 1) + 4 * (g4 - 1) : 16 * dp + 4 * g4)) = o4; }
        }
    }
}
}
__device__ __forceinline__ void attn_phase(Frame& F, const bf16* qkv, const float* rt, bf16* ao) {
    LAS unsigned char* lds = F.lds + RING_OFF;
    const int nunits = BATCH * NH * (SEQ / 512);
    const bool two = (F.G == 256);
    if (two) { const int x = F.vcu >> 5, loc = F.vcu & 31;
        for (int j = F.tid; j < 2 * 3 * att::NTAB; j += NWAVES * 64) { const int i2 = j / (3 * att::NTAB), jj = j - i2 * 3 * att::NTAB, hh = (8 * x + 4 * i2 + (loc >> 3)) % NH;
            ((LAS float*)(lds + att::LDS_TAB))[j] = rt[hh * 3 * att::NTAB + jj]; } }
    for (int i = 0; i * F.G < nunits; ++i) {
        int bh, blk;
        if (F.G == 256) { const int x = F.vcu >> 5, loc = F.vcu & 31; bh = 8 * x + 4 * i + (loc >> 3); blk = loc & 7; }
        else { const int u = i * F.G + F.vcu; if (u >= nunits) break; bh = u >> 3; blk = u & 7; }
        const int b = bh / NH, h = bh % NH, p0 = blk * 512;
        const int tsel = two ? i : 0;
        if (!two) for (int j = F.tid; j < 3 * att::NTAB; j += NWAVES * 64) ((LAS float*)(lds + att::LDS_TAB))[j] = rt[h * 3 * att::NTAB + j];
#pragma unroll 1
        for (int k = 0; k < 2; ++k) { const int g = 2 * F.wave + k;
            if (((p0 + g) >> 4) < 128) att::item<0, 4, true, 2>(qkv, ao, lds, F.wave, F.lane, b, h, p0, g, k == 0, tsel); else att::item<0, 4, false, 2>(qkv, ao, lds, F.wave, F.lane, b, h, p0, g, k == 0, tsel); }
        { const int g = F.wave; const int rel = 256 * (g >> 2) + (g & 3);
            if (((p0 + rel) >> 2) < 128) { att::item<1, 2, true, 2>(qkv, ao, lds, F.wave, F.lane, b, h, p0, rel, true, tsel); att::item<1, 2, true, 2>(qkv, ao, lds, F.wave, F.lane, b, h, p0, rel + 128, false, tsel); }
            else att::item<1, 2, false, 4>(qkv, ao, lds, F.wave, F.lane, b, h, p0, rel, true, tsel); }
        { const int rel = 64 * F.wave;
            if ((p0 + rel) < 128) { att::item<2, 0, true, 2>(qkv, ao, lds, F.wave, F.lane, b, h, p0, rel, true, tsel); att::item<2, 0, true, 2>(qkv, ao, lds, F.wave, F.lane, b, h, p0, rel + 32, false, tsel); }
            else att::item<2, 0, false, 4>(qkv, ao, lds, F.wave, F.lane, b, h, p0, rel, true, tsel); }
        if (!two) __syncthreads();
    }
}

__global__ void __launch_bounds__(NWAVES * 64, 2) mega_fwd(Args args) {
    extern __shared__ __attribute__((aligned(16))) unsigned char lds[];
    Frame F;
    F.lds = (LAS unsigned char*)lds; F.MISC = (volatile LAS unsigned*)(F.lds + MISC_OFF);
    F.tid = threadIdx.x; F.lane = F.tid & 63; F.wave = __builtin_amdgcn_readfirstlane(F.tid >> 6);
    F.G = gridDim.x; { const int bx = blockIdx.x; F.vcu = (F.G % 8 == 0) ? (bx % 8) * (F.G / 8) + bx / 8 : bx; }
    unsigned char* ws = args.ws; F.ctl = (gu32*)(ws + WS_CTL);
    for (int u = F.tid; u < (LDS_BYTES - LDSCTL_OFF) / 4; u += NWAVES * 64) ((LAS unsigned*)(F.lds + LDSCTL_OFF))[u] = 0u;
    __syncthreads();
    const int lo = args.ph_lo, hi = args.ph_hi; const bool use_bar = (hi - lo) > 1;
    XcdBarrier bar; bar.bar = (unsigned*)(F.ctl + CW_BAR) + args.li * XCD_BAR_WORDS; bar.x = 0; bar.st = nullptr;
    if (use_bar) bar = xcd_barrier_post((unsigned*)(F.ctl + CW_BAR) + args.li * XCD_BAR_WORDS, F.MISC + 8);
#ifndef PHASES_COMPILED
#define PHASES_COMPILED 0x7FF
#endif
#define IN(k) ((((PHASES_COMPILED) >> (k)) & 1) && lo <= (k) && (k) < hi)
#ifndef REP_MASK
#define REP_MASK 0
#endif
#define REPS(k) for (int rep_ = 0; rep_ < ((((REP_MASK) >> (k)) & 1) ? 2 : 1); ++rep_)
#ifndef SEAM_REPS
#define SEAM_REPS 1
#endif
#define SEAM_WORK(k, lo_, hi_) do { if (IN(k) && IN((k) + 1)) { if (CONVERT_IN_SEAMS) { ConvertWork cw_{&args, F.lds + RING_OFF, F.vcu, F.G, F.lane, (lo_), (hi_)}; xcd_barrier_work(bar, F.wave, cw_); } else xcd_barrier(bar); } } while (0)
#define SEAM_PLAIN(k) do { if (IN(k) && IN((k) + 1)) { for (int sr_ = 0; sr_ < SEAM_REPS; ++sr_) xcd_barrier(bar); } } while (0)
constexpr int CHUNK = (IT_END - IT_OUT + 7) / 8;
static_assert(IT_UP0 <= IT_OUT + 2 * CHUNK && IT_DN0 <= IT_OUT + 3 * CHUNK && IT_QKV <= IT_OUT + 4 * CHUNK && IT_O <= IT_OUT + 5 * CHUNK && IT_UP1 <= IT_OUT + 7 * CHUNK && IT_DN1 <= IT_OUT + 8 * CHUNK, "conversion deadlines");
#define SEAM(k) do { if ((k) < 8) SEAM_WORK(k, IT_OUT + (k) * CHUNK, (IT_OUT + ((k) + 1) * CHUNK) < IT_END ? (IT_OUT + ((k) + 1) * CHUNK) : IT_END); else SEAM_PLAIN(k); } while (0)
    float* ssq = (float*)(ws + WS_SSQ); float* out = args.out;
    bf16* xb = (bf16*)(ws + WS_XB); bf16* proj = (bf16*)(ws + WS_PROJ); bf16* mix = (bf16*)(ws + WS_MIX); bf16* qkv = (bf16*)(ws + WS_QKV); bf16* ao = (bf16*)(ws + WS_AO); bf16* act = (bf16*)(ws + WS_ACT);
    PG8_LAS unsigned char* ring = F.lds + RING_OFF;

    if (IN(0)) REPS(0) { p0_prologue(F, args); } SEAM(0);
    if (IN(1)) REPS(1) { pg8::Gemm g{xb, (const bf16*)(ws + WS_WIN), T, EVEN_IN, D}; pg8::StaticOrder S; S.init(T, EVEN_IN, F.G, (int)blockIdx.x);
        pg8::EpiProj2 E{mix, proj, ssq, args.in[4], (float*)(ws + WS_SIDE), (PG8_LAS float*)(F.lds + HALO_OFF)};
        pg8::gemm_phase<pg8::EpiProj2, pg8::StaticOrder, true, true>(ring, g, S, E); } SEAM(1);
    if (IN(2)) REPS(2) { mixer_phase(F, proj, args.in[4], (const float*)(ws + WS_SIDE), mix); } SEAM(2);
#ifndef UP_WGM
#define UP_WGM 8
#endif
#define PHASE_UP(pu, l) do { if (IN(pu)) REPS(pu) { pg8::Gemm g{xb, (const bf16*)(ws + WS_WUP) + (size_t)(l) * DFF2 * D, 68 * 256, DFF2, D}; pg8::OverlapOrder S; S.init(68 * 256, DFF2, F.G, (int)blockIdx.x, UP_WGM); \
        pg8::EpiConvGlu E{act, ssq + ((l) == 0 ? T : 3 * T), args.in[15] + (size_t)(l) * 3 * DFF2, args.in[16] + (size_t)(l) * DFF2, (PG8_LAS float*)(F.lds + HALO_OFF)}; \
        pg8::gemm_phase<pg8::EpiConvGlu, pg8::OverlapOrder, true, true>(ring, g, S, E); } SEAM(pu); } while (0)
#define PHASE_RES(p, BF, OF, OX, SQ, Aptr, Wptr, Kdim, basefptr, outfptr, xbptr, ssqptr) do { if (IN(p)) { pg8::Gemm g{(Aptr), (Wptr), T, D, (Kdim)}; pg8::StaticOrder S; S.init(T, D, F.G, (int)blockIdx.x); \
        typedef pg8::EpiResidual<BF, OF, OX, SQ, true> Epi_; Epi_ E{(basefptr), xb, (outfptr), (xbptr), (ssqptr)}; \
        pg8::gemm_phase<Epi_, pg8::StaticOrder, false, true>(ring, g, S, E); } SEAM(p); } while (0)
    PHASE_RES(3, false, false, true, true, mix, (const bf16*)(ws + WS_WOUT), D, (const float*)nullptr, (float*)nullptr, xb, ssq + T);
    PHASE_UP(4, 0);
    PHASE_RES(5, false, false, true, true, act, (const bf16*)(ws + WS_WDN), DFF, (const float*)nullptr, (float*)nullptr, xb, ssq + 2 * T);
    if (IN(6)) REPS(6) { pg8::Gemm g{xb, (const bf16*)(ws + WS_WQKV), T, NQKV, D}; pg8::StaticOrder S; S.init(T, NQKV, F.G, (int)blockIdx.x, 2);
        pg8::EpiQkv E{qkv, ssq + 2 * T, args.in[10], args.in[11]};
        pg8::gemm_phase<pg8::EpiQkv, pg8::StaticOrder, true, true>(ring, g, S, E); } SEAM(6);
    if (IN(7)) REPS(7) { attn_phase(F, qkv, (const float*)(ws + WS_RT), ao); } SEAM(7);
    PHASE_RES(8, false, false, true, true, ao, (const bf16*)(ws + WS_WO), D, (const float*)nullptr, (float*)nullptr, xb, ssq + 3 * T);
    PHASE_UP(9, 1);
    PHASE_RES(10, false, true, false, false, act, (const bf16*)(ws + WS_WDN) + (size_t)D * DFF, DFF, (const float*)nullptr, out, (bf16*)nullptr, (float*)nullptr);
#undef IN
#undef SEAM
}

#ifndef FAST_MASK
#define FAST_MASK 0x7FF
#endif
extern "C" void kernel_launch(void* const* d_in, const int* in_sizes, int n_in, void* d_out, int out_size, void* d_ws, size_t ws_size, hipStream_t stream) {
    static int grid = 0;
    if (grid == 0) {
        if (n_in != 18 || out_size != T * D || ws_size < WS_END) { fprintf(stderr, "kernel_launch: unexpected shapes n_in %d out %d ws %zu\n", n_in, out_size, ws_size); grid = -1; return; }
        int dev = 0, cus = 0;
        if (hipGetDevice(&dev) != hipSuccess || hipDeviceGetAttribute(&cus, hipDeviceAttributeMultiprocessorCount, dev) != hipSuccess) { grid = -1; return; }
        if (hipFuncSetAttribute((const void*)mega_fwd, hipFuncAttributeMaxDynamicSharedMemorySize, LDS_BYTES) != hipSuccess) { fprintf(stderr, "kernel_launch: hipFuncSetAttribute failed\n"); grid = -1; return; }
        (void)hipFuncSetAttribute((const void*)n_gemm_rowscale, hipFuncAttributeMaxDynamicSharedMemorySize, 18 * 4096);
        (void)hipFuncSetAttribute((const void*)n_gemm_residual, hipFuncAttributeMaxDynamicSharedMemorySize, 18 * 4096);
        (void)hipFuncSetAttribute((const void*)n_ffn_up, hipFuncAttributeMaxDynamicSharedMemorySize, 18 * 4096);
        (void)hipFuncSetAttribute((const void*)n_qkv, hipFuncAttributeMaxDynamicSharedMemorySize, 18 * 4096);
        (void)hipGetLastError();
        grid = cus;
    }
    if (grid < 0) return;
    const float* x = (const float*)d_in[0];
    const float* even_norm = (const float*)d_in[2]; const float* w_in = (const float*)d_in[3]; const float* even_cw = (const float*)d_in[4];
    const float* pool_w = (const float*)d_in[5]; const float* pool_s = (const float*)d_in[6]; const float* w_out = (const float*)d_in[7];
    const float* odd_norm = (const float*)d_in[8]; const float* w_qkv = (const float*)d_in[9]; const float* gq = (const float*)d_in[10]; const float* gk = (const float*)d_in[11];
    const float* w_o = (const float*)d_in[12]; const float* ffn_norm = (const float*)d_in[13]; const float* w_up = (const float*)d_in[14];
    const float* ffn_cw = (const float*)d_in[15]; const float* ffn_cb = (const float*)d_in[16]; const float* w_dn = (const float*)d_in[17];
    unsigned char* ws = (unsigned char*)d_ws; float* out = (float*)d_out;
    float* ssq = (float*)(ws + WS_SSQ); float* bias = (float*)(ws + WS_BIAS);
    bf16_t* xb = (bf16_t*)(ws + WS_XB); bf16_t* proj = (bf16_t*)(ws + WS_PROJ); bf16_t* mix = (bf16_t*)(ws + WS_MIX);
    bf16_t* qkv = (bf16_t*)(ws + WS_QKV); bf16_t* ao = (bf16_t*)(ws + WS_AO); bf16_t* act = (bf16_t*)(ws + WS_ACT);
    const size_t LDSB = 18 * 4096;
    (void)hipMemsetAsync(ws + WS_CTL, 0, 1 * MiB, stream);
    Args a{};
    for (int i = 0; i < 18; ++i) a.in[i] = (const float*)d_in[i];
    a.out = out; a.ws = ws;
    const unsigned fast = FAST_MASK;
    int p = 0, li = 0;
    while (p < 11) {
        if ((fast >> p) & 1u) {
            int q = p; while (q < 11 && ((fast >> q) & 1u)) ++q;
            a.ph_lo = p; a.ph_hi = q; a.li = li++;
            hipLaunchKernelGGL(mega_fwd, dim3(grid), dim3(NWAVES * 64), LDS_BYTES, stream, a);
            p = q; continue;
        }
        switch (p) {
            case 0: n_prologue<<<T / 4, 256, 0, stream>>>(x, ssq, xb); n_bias<<<(3 * 129 * 16 + 255) / 256, 256, 0, stream>>>((const float*)d_in[1], bias); break;
            case 1: n_gemm_rowscale<<<dim3(EVEN_IN / 256, T / 16), 256, LDSB, stream>>>(xb, even_norm, w_in, EVEN_IN, D, ssq, proj); break;
            case 2: n_mixer<<<T / 16, 512, 0, stream>>>(proj, even_cw, pool_w, pool_s, mix); break;
            case 3: n_gemm_residual<<<dim3(D / 256, T / 16), 256, LDSB, stream>>>(mix, w_out, D, x, out, xb, ssq + T); break;
            case 4: n_ffn_up<<<dim3(DFF / 256, T / 16), 256, LDSB, stream>>>(xb, ffn_norm, w_up, ssq + T, ffn_cw, ffn_cb, act); break;
            case 5: n_gemm_residual<<<dim3(D / 256, T / 16), 256, LDSB, stream>>>(act, w_dn, DFF, out, out, xb, ssq + 2 * T); break;
            case 6: n_qkv<<<dim3(NQKV / 256, T / 16), 256, LDSB, stream>>>(xb, odd_norm, w_qkv, ssq + 2 * T, gq, gk, qkv); break;
            case 7: n_attn<<<T * NH / 4, 256, 0, stream>>>(qkv, bias, ao); break;
            case 8: n_gemm_residual<<<dim3(D / 256, T / 16), 256, LDSB, stream>>>(ao, w_o, D, out, out, xb, ssq + 3 * T); break;
            case 9: n_ffn_up<<<dim3(DFF / 256, T / 16), 256, LDSB, stream>>>(xb, ffn_norm + D, w_up + (size_t)D * DFF2, ssq + 3 * T, ffn_cw + 3 * DFF2, ffn_cb + DFF2, act); break;
            case 10: n_gemm_residual<<<dim3(D / 256, T / 16), 256, LDSB, stream>>>(act, w_dn + (size_t)DFF * D, DFF, out, out, nullptr, nullptr); break;
        }
        ++p;
    }
}
```
